# Optimizing an MI355X kernel written in HIP

```python
import math
import jax
import jax.numpy as jnp
from jax import lax
import numpy as np

D_MODEL = 1024
BATCH = 1
SEQ = 16384
DEPTH = 2

N_BIAS_HEADS = 8
N_BUCKETS = 32
MAX_DISTANCE = 128
Q_BLOCK = 128
NEG = -1e30
EPS = 1e-6

N_HEADS_A = 8
HEAD_DIM_A = 64
MOBA_BLOCK = 256
MOBA_TOPK = 3

LRU_WIDTH = D_MODEL // 2
LRU_BLOCKS = 8
LRU_BLOCK = LRU_WIDTH // LRU_BLOCKS
CONV_WIDTH = 4
LRU_C = 8.0

N_HEADS_C = 8
HEAD_DIM_C = D_MODEL // N_HEADS_C
N_KV_GROUPS = 2
HEADS_PER_GROUP = N_HEADS_C // N_KV_GROUPS
CMP_LEN = 32
CMP_STRIDE = 16
CMP_HIDDEN = 256
SEL_BLOCK = 64
SEL_TOPK = 16
WINDOW = 512
SEL_FORCE = 1e4

D_FF = 4 * D_MODEL

N_EVEN = (DEPTH + 1) // 2
N_ODD = DEPTH // 2

AB_IN = 3 * N_HEADS_A * HEAD_DIM_A + 2 * LRU_WIDTH
AB_OUT = N_HEADS_A * HEAD_DIM_A + LRU_WIDTH
C_KV = N_KV_GROUPS * HEAD_DIM_C
C_IN = N_HEADS_C * HEAD_DIM_C + 6 * C_KV + 3 * N_HEADS_C
C_OUT = N_HEADS_C * HEAD_DIM_C

kernel_name = 'hybrid_moba_rglru_nsa_trunk'


def rmsnorm(x, g):
    xf = x.astype(jnp.float32)
    y = xf * lax.rsqrt(jnp.mean(xf * xf, axis=-1, keepdims=True) + EPS)
    return (y * g.astype(jnp.float32)).astype(x.dtype)


def masked_softmax(s, mask):
    s = jnp.where(mask, s.astype(jnp.float32), NEG)
    e = jnp.exp(s - jnp.max(s, axis=-1, keepdims=True)) * mask
    return e / jnp.maximum(jnp.sum(e, axis=-1, keepdims=True), 1e-30)


def rel_bucket(dist):
    n = jnp.maximum(dist, 0)
    exact = N_BUCKETS // 2
    nf = jnp.maximum(n, 1).astype(jnp.float32)
    large = exact + (jnp.log(nf / exact) / math.log(MAX_DISTANCE / exact)
                     * (N_BUCKETS - exact)).astype(jnp.int32)
    large = jnp.minimum(large, N_BUCKETS - 1)
    return jnp.where(n < exact, n, large)


def bias_shared(table, bucket):
    return table.T[:, bucket].astype(jnp.float32)


def bias_per_head(table, bucket):
    return jax.vmap(lambda tb, bk: tb[bk])(table.T, bucket).astype(jnp.float32)


def bias_per_group(table, bucket):
    tg = table.reshape(N_BUCKETS, N_KV_GROUPS, HEADS_PER_GROUP).transpose(1, 2, 0)
    return jax.vmap(lambda tb, bk: tb[:, bk])(tg, bucket).astype(jnp.float32)


def moba_attention(q, k, v, rel_bias):
    T, H, dh = q.shape
    scale = dh ** -0.5
    nb = -(-T // MOBA_BLOCK)
    pad = nb * MOBA_BLOCK - T
    q = q.transpose(1, 0, 2)
    kp = jnp.pad(k.transpose(1, 0, 2), ((0, 0), (0, pad), (0, 0)))
    vp = jnp.pad(v.transpose(1, 0, 2), ((0, 0), (0, pad), (0, 0)))
    kb = kp.reshape(H, nb, MOBA_BLOCK, dh)
    vb = vp.reshape(H, nb, MOBA_BLOCK, dh)
    kmean = jnp.mean(kb.astype(jnp.float32), axis=2)
    n_sel = min(MOBA_TOPK, nb)
    n_g = n_sel * MOBA_BLOCK
    blk = jnp.arange(nb)
    offs = jnp.arange(MOBA_BLOCK)

    def one_block(qi):
        start = qi * Q_BLOCK
        t = start + jnp.arange(Q_BLOCK)
        own = start // MOBA_BLOCK
        qb = lax.dynamic_slice_in_dim(q, start, Q_BLOCK, axis=1)
        route = jnp.einsum('hqd,hnd->hqn', qb.astype(jnp.float32), kmean)
        route = jnp.where((blk < own)[None, None, :], route, NEG)
        rval, idx = lax.top_k(route, n_sel)
        valid = rval > NEG / 2
        kg = jax.vmap(lambda kh, ih: kh[ih])(kb, idx)
        vg = jax.vmap(lambda vh, ih: vh[ih])(vb, idx)
        pos_s = idx[..., None] * MOBA_BLOCK + offs
        s_sel = jnp.einsum('hqd,hqnbd->hqnb', qb, kg,
                           preferred_element_type=jnp.float32) * scale
        s_sel = s_sel + bias_per_head(rel_bias, rel_bucket(t[None, :, None, None] - pos_s))
        m_sel = jnp.broadcast_to(valid[..., None], s_sel.shape)
        k_own = lax.dynamic_slice_in_dim(kp, own * MOBA_BLOCK, MOBA_BLOCK, axis=1)
        v_own = lax.dynamic_slice_in_dim(vp, own * MOBA_BLOCK, MOBA_BLOCK, axis=1)
        d_own = t[:, None] - (own * MOBA_BLOCK + offs)[None, :]
        s_own = jnp.einsum('hqd,hbd->hqb', qb, k_own,
                           preferred_element_type=jnp.float32) * scale
        s_own = s_own + bias_shared(rel_bias, rel_bucket(d_own))
        m_own = jnp.broadcast_to((d_own >= 0)[None], s_own.shape)
        s = jnp.concatenate([s_sel.reshape(H, Q_BLOCK, n_g), s_own], axis=-1)
        m = jnp.concatenate([m_sel.reshape(H, Q_BLOCK, n_g), m_own], axis=-1)
        p = masked_softmax(s, m).astype(v.dtype)
        return (jnp.einsum('hqn,hqnd->hqd', p[..., :n_g], vg.reshape(H, Q_BLOCK, n_g, dh))
                + jnp.einsum('hqb,hbd->hqd', p[..., n_g:], v_own))

    out = lax.map(one_block, jnp.arange(T // Q_BLOCK))
    return out.transpose(0, 2, 1, 3).reshape(T, H * dh)


def rglru(xr, conv_w, conv_b, w_rg, b_rg, w_ig, b_ig, lru_lambda):
    T, W = xr.shape
    xp = jnp.pad(xr, ((CONV_WIDTH - 1, 0), (0, 0)))
    xc = conv_b + sum(xp[j:j + T] * conv_w[j] for j in range(CONV_WIDTH))
    xblk = xc.reshape(T, LRU_BLOCKS, LRU_BLOCK)
    r = jax.nn.sigmoid((jnp.einsum('tbi,bij->tbj', xblk, w_rg).reshape(T, W) + b_rg)
                       .astype(jnp.float32))
    i = jax.nn.sigmoid((jnp.einsum('tbi,bij->tbj', xblk, w_ig).reshape(T, W) + b_ig)
                       .astype(jnp.float32))
    log_a = -LRU_C * r * jax.nn.softplus(-lru_lambda.astype(jnp.float32))
    a = jnp.exp(log_a)
    b = jnp.sqrt(-jnp.expm1(2.0 * log_a)) * i * xc.astype(jnp.float32)

    def combine(c1, c2):
        a1, b1 = c1
        a2, b2 = c2
        return a1 * a2, a2 * b1 + b2

    _, h = lax.associative_scan(combine, (a, b), axis=0)
    return h.astype(xr.dtype)


def compress(kt, pos_emb, w1, w2):
    T, G, dh = kt.shape
    nc = (T - CMP_LEN) // CMP_STRIDE + 1
    idx = jnp.arange(nc)[:, None] * CMP_STRIDE + jnp.arange(CMP_LEN)[None, :]
    blocks = kt[idx] + pos_emb[None, :, None, :]
    flat = blocks.transpose(0, 2, 1, 3).reshape(nc, G, CMP_LEN * dh)
    return jax.nn.gelu(flat @ w1) @ w2


def nsa_attention(q, kc_t, vc_t, ks_t, vs_t, kw_t, vw_t, g_logit,
                  cmp_pos_k, cmp_pos_v, cmp_k_w1, cmp_k_w2, cmp_v_w1, cmp_v_w2, rel_bias):
    T = q.shape[0]
    G, P, dh = N_KV_GROUPS, HEADS_PER_GROUP, HEAD_DIM_C
    scale = dh ** -0.5
    qg = q.reshape(T, G, P, dh).transpose(1, 2, 0, 3)
    kc = compress(kc_t, cmp_pos_k, cmp_k_w1, cmp_k_w2).transpose(1, 0, 2)
    vc = compress(vc_t, cmp_pos_v, cmp_v_w1, cmp_v_w2).transpose(1, 0, 2)
    nc = kc.shape[1]
    cmp_start = jnp.arange(nc) * CMP_STRIDE
    cmp_end = cmp_start + CMP_LEN - 1
    ns = T // SEL_BLOCK
    sblk = jnp.arange(ns)
    sel_start = sblk * SEL_BLOCK
    overlap = ((cmp_start[:, None] < sel_start[None, :] + SEL_BLOCK)
               & (cmp_start[:, None] + CMP_LEN > sel_start[None, :])).astype(jnp.float32)
    ks_b = ks_t.transpose(1, 0, 2).reshape(G, ns, SEL_BLOCK, dh)
    vs_b = vs_t.transpose(1, 0, 2).reshape(G, ns, SEL_BLOCK, dh)
    kw_p = jnp.pad(kw_t.transpose(1, 0, 2), ((0, 0), (WINDOW, 0), (0, 0)))
    vw_p = jnp.pad(vw_t.transpose(1, 0, 2), ((0, 0), (WINDOW, 0), (0, 0)))
    gates = jax.nn.sigmoid(g_logit.astype(jnp.float32)).reshape(T, G, P, 3).transpose(1, 2, 0, 3)
    n_sel = min(SEL_TOPK, ns)
    n_g = n_sel * SEL_BLOCK
    offs_s = jnp.arange(SEL_BLOCK)
    n_w = WINDOW + Q_BLOCK

    def one_block(qi):
        start = qi * Q_BLOCK
        t = start + jnp.arange(Q_BLOCK)
        qb = lax.dynamic_slice_in_dim(qg, start, Q_BLOCK, axis=2)
        d_c = t[:, None] - cmp_end[None, :]
        s_c = jnp.einsum('gpqd,gnd->gpqn', qb, kc, preferred_element_type=jnp.float32) * scale
        s_c = s_c + bias_shared(rel_bias, rel_bucket(d_c)).reshape(G, P, Q_BLOCK, nc)
        p_c = masked_softmax(s_c, d_c >= 0)
        o_c = jnp.einsum('gpqn,gnd->gpqd', p_c.astype(vc.dtype), vc)
        imp = jnp.einsum('gpqn,nj->gqj', p_c, overlap)
        cur = t // SEL_BLOCK
        forced = ((sblk[None, :] == 0) | (sblk[None, :] == cur[:, None])
                  | (sblk[None, :] == cur[:, None] - 1))
        imp = jnp.where(forced[None], imp + SEL_FORCE, imp)
        imp = jnp.where((sblk[None, :] > cur[:, None])[None], NEG, imp)
        sval, idx = lax.top_k(imp, n_sel)
        valid = sval > NEG / 2
        kg = jax.vmap(lambda kb_, ib: kb_[ib])(ks_b, idx)
        vg = jax.vmap(lambda vb_, ib: vb_[ib])(vs_b, idx)
        pos_s = idx[..., None] * SEL_BLOCK + offs_s
        d_s = t[None, :, None, None] - pos_s
        s_s = jnp.einsum('gpqd,gqnbd->gpqnb', qb, kg, preferred_element_type=jnp.float32) * scale
        s_s = s_s + bias_per_group(rel_bias, rel_bucket(d_s))
        m_s = (valid[..., None] & (d_s >= 0))[:, None]
        p_s = masked_softmax(s_s.reshape(G, P, Q_BLOCK, n_g), m_s.reshape(G, 1, Q_BLOCK, n_g))
        o_s = jnp.einsum('gpqn,gqnd->gpqd', p_s.astype(vs_b.dtype),
                         vg.reshape(G, Q_BLOCK, n_g, dh))
        kwb = lax.dynamic_slice_in_dim(kw_p, start, n_w, axis=1)
        vwb = lax.dynamic_slice_in_dim(vw_p, start, n_w, axis=1)
        pos_w = start - WINDOW + jnp.arange(n_w)
        d_w = t[:, None] - pos_w[None, :]
        m_w = (pos_w[None, :] >= 0) & (d_w >= 0) & (d_w < WINDOW)
        s_w = jnp.einsum('gpqd,gkd->gpqk', qb, kwb, preferred_element_type=jnp.float32) * scale
        s_w = s_w + bias_shared(rel_bias, rel_bucket(d_w)).reshape(G, P, Q_BLOCK, n_w)
        p_w = masked_softmax(s_w, m_w)
        o_w = jnp.einsum('gpqk,gkd->gpqd', p_w.astype(vwb.dtype), vwb)
        gb = lax.dynamic_slice_in_dim(gates, start, Q_BLOCK, axis=2)
        return (gb[..., 0:1] * o_c + gb[..., 1:2] * o_s + gb[..., 2:3] * o_w).astype(q.dtype)

    out = lax.map(one_block, jnp.arange(T // Q_BLOCK))
    return out.transpose(0, 3, 1, 2, 4).reshape(T, G * P * dh)


def mixer_ab(h, w_in, conv_w, conv_b, w_rg, b_rg, w_ig, b_ig, lru_lambda, w_out, rel_bias):
    Bt, T, _ = h.shape
    dA = N_HEADS_A * HEAD_DIM_A
    proj = h @ w_in
    q, k, v, xr, gr = jnp.split(proj, [dA, 2 * dA, 3 * dA, 3 * dA + LRU_WIDTH], axis=-1)
    shp = (Bt, T, N_HEADS_A, HEAD_DIM_A)
    o_a = jax.vmap(moba_attention, in_axes=(0, 0, 0, None))(
        q.reshape(shp), k.reshape(shp), v.reshape(shp), rel_bias)
    o_b = jax.vmap(rglru, in_axes=(0, None, None, None, None, None, None, None))(
        xr, conv_w, conv_b, w_rg, b_rg, w_ig, b_ig, lru_lambda)
    o_b = o_b * jax.nn.gelu(gr)
    return jnp.concatenate([o_a, o_b], axis=-1) @ w_out


def mixer_c(h, w_in, cmp_pos_k, cmp_pos_v, cmp_k_w1, cmp_k_w2, cmp_v_w1, cmp_v_w2,
            w_out, rel_bias):
    Bt, T, _ = h.shape
    dq = N_HEADS_C * HEAD_DIM_C
    proj = h @ w_in
    pieces = jnp.split(proj, [dq + j * C_KV for j in range(7)], axis=-1)
    q = pieces[0].reshape(Bt, T, N_HEADS_C, HEAD_DIM_C)
    kv = [p.reshape(Bt, T, N_KV_GROUPS, HEAD_DIM_C) for p in pieces[1:7]]
    gl = pieces[7].reshape(Bt, T, N_HEADS_C, 3)
    o = jax.vmap(nsa_attention, in_axes=(0,) * 8 + (None,) * 7)(
        q, kv[0], kv[1], kv[2], kv[3], kv[4], kv[5], gl,
        cmp_pos_k, cmp_pos_v, cmp_k_w1, cmp_k_w2, cmp_v_w1, cmp_v_w2, rel_bias)
    return o @ w_out


def setup_inputs(seed: int = 0) -> dict:
    key = jax.random.key(seed)
    ks = jax.random.split(key, 26)
    f32 = jnp.float32

    def nrm(k, shape, fan_in):
        return jax.random.normal(k, shape, f32) * fan_in ** -0.5

    def gain(k, shape):
        return 1.0 + 0.05 * jax.random.normal(k, shape, f32)

    u = jax.random.uniform(ks[8], (N_EVEN, LRU_WIDTH), f32, 0.9, 0.999)
    a = u ** (1.0 / LRU_C)
    lam = jnp.log(a) - jnp.log1p(-a)
    return {
        'x': jax.random.normal(ks[0], (BATCH, SEQ, D_MODEL), f32),
        'rel_bias': 0.3 * jax.random.normal(ks[1], (N_BUCKETS, N_BIAS_HEADS), f32),
        'ab_w_in': nrm(ks[2], (N_EVEN, D_MODEL, AB_IN), D_MODEL),
        'ab_conv_w': nrm(ks[3], (N_EVEN, CONV_WIDTH, LRU_WIDTH), CONV_WIDTH),
        'ab_conv_b': 0.02 * jax.random.normal(ks[4], (N_EVEN, LRU_WIDTH), f32),
        'ab_w_rg': nrm(ks[5], (N_EVEN, LRU_BLOCKS, LRU_BLOCK, LRU_BLOCK), LRU_BLOCK),
        'ab_b_rg': 0.1 * jax.random.normal(ks[6], (N_EVEN, LRU_WIDTH), f32),
        'ab_w_ig': nrm(ks[7], (N_EVEN, LRU_BLOCKS, LRU_BLOCK, LRU_BLOCK), LRU_BLOCK),
        'ab_b_ig': 0.1 * jax.random.normal(ks[9], (N_EVEN, LRU_WIDTH), f32),
        'ab_lru_lambda': lam,
        'ab_w_out': nrm(ks[10], (N_EVEN, AB_OUT, D_MODEL), AB_OUT),
        'c_w_in': nrm(ks[11], (N_ODD, D_MODEL, C_IN), D_MODEL),
        'c_cmp_pos_k': 0.1 * jax.random.normal(ks[12], (N_ODD, CMP_LEN, HEAD_DIM_C), f32),
        'c_cmp_pos_v': 0.1 * jax.random.normal(ks[13], (N_ODD, CMP_LEN, HEAD_DIM_C), f32),
        'c_cmp_k_w1': nrm(ks[14], (N_ODD, CMP_LEN * HEAD_DIM_C, CMP_HIDDEN), CMP_LEN * HEAD_DIM_C),
        'c_cmp_k_w2': nrm(ks[15], (N_ODD, CMP_HIDDEN, HEAD_DIM_C), CMP_HIDDEN),
        'c_cmp_v_w1': nrm(ks[16], (N_ODD, CMP_LEN * HEAD_DIM_C, CMP_HIDDEN), CMP_LEN * HEAD_DIM_C),
        'c_cmp_v_w2': nrm(ks[17], (N_ODD, CMP_HIDDEN, HEAD_DIM_C), CMP_HIDDEN),
        'c_w_out': nrm(ks[18], (N_ODD, C_OUT, D_MODEL), C_OUT),
        'norm_mix_pre': gain(ks[19], (DEPTH, D_MODEL)),
        'norm_mix_post': gain(ks[20], (DEPTH, D_MODEL)),
        'norm_mlp_pre': gain(ks[21], (DEPTH, D_MODEL)),
        'norm_mlp_post': gain(ks[22], (DEPTH, D_MODEL)),
        'w_up': nrm(ks[23], (DEPTH, D_MODEL, D_FF), D_MODEL),
        'w_down': nrm(ks[24], (DEPTH, D_FF, D_MODEL), D_FF),
    }


def reference(x, rel_bias,
              ab_w_in, ab_conv_w, ab_conv_b, ab_w_rg, ab_b_rg, ab_w_ig, ab_b_ig,
              ab_lru_lambda, ab_w_out,
              c_w_in, c_cmp_pos_k, c_cmp_pos_v, c_cmp_k_w1, c_cmp_k_w2, c_cmp_v_w1,
              c_cmp_v_w2, c_w_out,
              norm_mix_pre, norm_mix_post, norm_mlp_pre, norm_mlp_post, w_up, w_down):
    for layer in range(DEPTH):
        i = layer // 2
        h = rmsnorm(x, norm_mix_pre[layer])
        if layer % 2 == 0:
            m = mixer_ab(h, ab_w_in[i], ab_conv_w[i], ab_conv_b[i], ab_w_rg[i], ab_b_rg[i],
                         ab_w_ig[i], ab_b_ig[i], ab_lru_lambda[i], ab_w_out[i], rel_bias)
        else:
            m = mixer_c(h, c_w_in[i], c_cmp_pos_k[i], c_cmp_pos_v[i], c_cmp_k_w1[i],
                        c_cmp_k_w2[i], c_cmp_v_w1[i], c_cmp_v_w2[i], c_w_out[i], rel_bias)
        x = x + rmsnorm(m, norm_mix_post[layer])
        h = rmsnorm(x, norm_mlp_pre[layer])
        f = jnp.square(jax.nn.relu(h @ w_up[layer])) @ w_down[layer]
        x = x + rmsnorm(f, norm_mlp_post[layer])
    return x
```

```cpp
#include <hip/hip_runtime.h>
#include <cstdio>
#include <cstdint>
#ifndef MK_ONE_LAUNCH
#define MK_ONE_LAUNCH 1
#endif
#define GAS __attribute__((address_space(1)))
#define LAS __attribute__((address_space(3)))
namespace pg8 {
#define PG8_LAS __attribute__((address_space(3)))
typedef unsigned short bf16_t;
typedef short bf16x8 __attribute__((ext_vector_type(8)));
typedef float f32x4 __attribute__((ext_vector_type(4)));
typedef unsigned u32x4 __attribute__((ext_vector_type(4)));
constexpr int BM = 256, BK = 64, HALF = 128, HTB = HALF * BK * 2  , STAGE_BYTES = 8 * HTB, NXCD = 8, WGM = 8;

__host__ __device__ __forceinline__ int lds_byte(int r, int c) { const int st = (r >> 4) * 2 + (c >> 5), rr = r & 15, cc = c & 31, ob = rr * 64 + cc * 2; return st * 1024 + (ob ^ (((ob >> 9) & 1) << 5)); }
__host__ __device__ __forceinline__ void stage_rc(int b, int& R, int& C) { const int st = b / 1024, sb = b % 1024, swz = sb ^ (((sb >> 9) & 1) << 5); R = (st >> 1) * 16 + swz / 64; C = (st & 1) * 32 + (swz % 64) / 2; }
__host__ __device__ __forceinline__ int perm32(int rho) { const int n = rho >> 4, i = rho & 15; return 8 * (i >> 2) + 4 * n + (i & 3); }

struct Unit { int pm, pn; };
struct Gemm { const bf16_t* A; const bf16_t* Bt; int M, N, K, lda, ldb; };

struct StaticOrder {
    int nM, nN, nwg, G, c;
    __host__ __device__ void init(int M, int N, int G_, int c_) { nM = M / BM; nN = N / BM; nwg = nM * nN; G = G_; c = c_; }
    __host__ __device__ bool next(int i, Unit& u) const {
        const long L = (long)i * G + c; if (L >= nwg) return false;
        int wgid = (int)L; { const int q = nwg / NXCD, r = nwg % NXCD, xcd = wgid % NXCD, off = wgid / NXCD; wgid = (xcd < r ? xcd * (q + 1) : r * (q + 1) + (xcd - r) * q) + off; }
        const int nig = WGM * nN, gid = wgid / nig, fm = gid * WGM, gsz = (nM - fm) < WGM ? (nM - fm) : WGM;
        u.pm = fm + ((wgid % nig) % gsz); u.pn = (wgid % nig) / gsz; return true;
    }
    __device__ __forceinline__ void a_ready(const Unit&) const {}
    __device__ __forceinline__ void done(const Unit&) const {}
};

__device__ __forceinline__ unsigned cvt_pk_bf16(float lo, float hi) { unsigned r; asm volatile("v_cvt_pk_bf16_f32 %0, %1, %2" : "=v"(r) : "v"(lo), "v"(hi)); return r; }
template <class Epi, class Sched, bool ALIGN_EPI = false, bool SP2 = false>
__device__ __forceinline__ void gemm_phase(PG8_LAS unsigned char* lds, const Gemm g, const Sched& S, const Epi& E) {
    const int tid = threadIdx.x, wid = __builtin_amdgcn_readfirstlane(tid >> 6), lane = tid & 63, wr = wid >> 2, wc = wid & 3, fr = lane & 15, fq = lane >> 4;
    const int K = g.K, nt = K / BK;
    unsigned voffA[2], voffB[2];
#pragma unroll
    for (int i = 0; i < 2; ++i) { int R, C; stage_rc(tid * 16 + i * 8192, R, C); const int Rb = Epi::PERM ? ((R & ~31) + perm32(R & 31)) : R;
        voffA[i] = (unsigned)(R * g.lda + C) * 2u; voffB[i] = (unsigned)(Rb * g.ldb + C) * 2u; }
    const size_t kstep = (size_t)(BK * 2);
    const size_t hstepA = (size_t)HALF * g.lda * 2, hstepB = (size_t)HALF * g.ldb * 2;
    const size_t tstepA = 2 * hstepA, tstepB = 2 * hstepB;
    const unsigned ldsw = (unsigned)wid * 1024u;
    const int aoff = lds_byte(wr * 64 + fr, fq * 8), boff = lds_byte(wc * 32 + fr, fq * 8);
#define PG8_SA(b, h) (((b) * 2 + (h)) * HTB)
#define PG8_SB(b, h) ((4 + (b) * 2 + (h)) * HTB)
#define PG8_STAGE(bufoff, gbase, voff) do { _Pragma("unroll") for (int _i = 0; _i < 2; ++_i) \
        __builtin_amdgcn_global_load_lds((const unsigned*)((const char*)(gbase) + (voff)[_i]), (PG8_LAS unsigned*)(lds + (bufoff) + ldsw + _i * 8192), 16, 0, 0); } while (0)
#define PG8_LDA(dst, b, h) do { _Pragma("unroll") for (int m = 0; m < 4; ++m) _Pragma("unroll") for (int k = 0; k < 2; ++k) dst[m][k] = *(const PG8_LAS bf16x8*)(lds + PG8_SA(b, h) + aoff + m * 2048 + k * 1024); } while (0)
#define PG8_LDB(dst, b, h) do { _Pragma("unroll") for (int n = 0; n < 2; ++n) _Pragma("unroll") for (int k = 0; k < 2; ++k) dst[n][k] = *(const PG8_LAS bf16x8*)(lds + PG8_SB(b, h) + boff + n * 2048 + k * 1024); } while (0)
#define PG8_MMA(ai, bj, At, Bt) do { __builtin_amdgcn_s_setprio(1); _Pragma("unroll") for (int m = 0; m < 4; ++m) _Pragma("unroll") for (int n = 0; n < 2; ++n) _Pragma("unroll") for (int k = 0; k < 2; ++k) \
        acc[ai][bj][m][n] = __builtin_amdgcn_mfma_f32_16x16x32_bf16(Bt[n][k], At[m][k], acc[ai][bj][m][n], 0, 0, 0); __builtin_amdgcn_s_setprio(0); } while (0)
#define PG8_WAIT_V(n) asm volatile("s_waitcnt vmcnt(" #n ")" ::: "memory")
#define PG8_WAIT_L(n) asm volatile("s_waitcnt lgkmcnt(" #n ")" ::: "memory")
#define PG8_BAR __builtin_amdgcn_s_barrier()
#define PG8_SCHED __builtin_amdgcn_sched_barrier(0)
    Unit cur, nxt; int ui = 0;
    if (!S.next(0, cur)) return;
    f32x4 acc[2][2][4][2];
#pragma unroll
    for (int a = 0; a < 2; ++a)
#pragma unroll
        for (int b = 0; b < 2; ++b)
#pragma unroll
            for (int m = 0; m < 4; ++m)
#pragma unroll
                for (int n = 0; n < 2; ++n) acc[a][b][m][n] = (f32x4){0.f, 0.f, 0.f, 0.f};
    bf16x8 At[4][2], B0[2][2], B1[2][2];
    const char* cA = (const char*)g.A + (size_t)cur.pm * tstepA; const char* cB = (const char*)g.Bt + (size_t)cur.pn * tstepB;
    S.a_ready(cur);
    if constexpr (SP2) {
        PG8_STAGE(PG8_SB(0, 0), cB, voffB); PG8_STAGE(PG8_SB(0, 1), cB + hstepB, voffB); PG8_STAGE(PG8_SA(0, 0), cA, voffA); PG8_STAGE(PG8_SA(0, 1), cA + hstepA, voffA);
        if (wr == 1) PG8_BAR;
        PG8_WAIT_V(2); PG8_BAR;
        PG8_STAGE(PG8_SB(1, 0), cB + kstep, voffB); PG8_STAGE(PG8_SA(1, 0), cA + kstep, voffA); PG8_STAGE(PG8_SB(1, 1), cB + hstepB + kstep, voffB);
        PG8_WAIT_V(6); PG8_BAR;
    } else {
        PG8_STAGE(PG8_SB(0, 0), cB, voffB); PG8_STAGE(PG8_SA(0, 0), cA, voffA); PG8_STAGE(PG8_SB(0, 1), cB + hstepB, voffB); PG8_STAGE(PG8_SA(0, 1), cA + hstepA, voffA);
        if (wr == 1) PG8_BAR;
        PG8_WAIT_V(4); PG8_BAR;
        PG8_STAGE(PG8_SB(1, 0), cB + kstep, voffB); PG8_STAGE(PG8_SA(1, 0), cA + kstep, voffA); PG8_STAGE(PG8_SB(1, 1), cB + hstepB + kstep, voffB);
        PG8_WAIT_V(6); PG8_BAR;
    }
    for (;;) {
        const bool has_next = S.next(ui + 1, nxt);
        const char* nA = has_next ? (const char*)g.A + (size_t)nxt.pm * tstepA : cA; const char* nB = has_next ? (const char*)g.Bt + (size_t)nxt.pn * tstepB : cB;
        for (int t = 0; t < nt; t += 2) {
            const bool last = (t == nt - 2);
            const char* a1 = cA + (size_t)(t + 1) * kstep;
            const char* a2 = last ? nA : cA + (size_t)(t + 2) * kstep; const char* b2 = last ? nB : cB + (size_t)(t + 2) * kstep;
            const char* a3 = a2 + kstep; const char* b3 = b2 + kstep;
            if (last && has_next) S.a_ready(nxt);
            if constexpr (SP2) {
            PG8_LDB(B0, 0, 0); PG8_LDB(B1, 0, 1); PG8_SCHED; PG8_LDA(At, 0, 0); PG8_STAGE(PG8_SA(1, 1), a1 + hstepA, voffA);
            PG8_WAIT_V(8); PG8_WAIT_L(0); PG8_BAR; PG8_MMA(0, 0, At, B0); PG8_MMA(0, 1, At, B1); PG8_BAR; PG8_SCHED;
            PG8_LDA(At, 0, 1); PG8_STAGE(PG8_SB(0, 0), b2, voffB); PG8_STAGE(PG8_SB(0, 1), b2 + hstepB, voffB); PG8_STAGE(PG8_SA(0, 0), a2, voffA);
            PG8_WAIT_V(8); PG8_WAIT_L(0); PG8_BAR; PG8_MMA(1, 0, At, B0); PG8_MMA(1, 1, At, B1); PG8_BAR; PG8_SCHED;
            PG8_LDB(B0, 1, 0); PG8_LDB(B1, 1, 1); PG8_SCHED; PG8_LDA(At, 1, 0); PG8_STAGE(PG8_SA(0, 1), a2 + hstepA, voffA);
            PG8_WAIT_V(8); PG8_WAIT_L(0); PG8_BAR; PG8_MMA(0, 0, At, B0); PG8_MMA(0, 1, At, B1); PG8_BAR; PG8_SCHED;
            PG8_LDA(At, 1, 1); PG8_STAGE(PG8_SB(1, 0), b3, voffB); PG8_STAGE(PG8_SB(1, 1), b3 + hstepB, voffB); PG8_STAGE(PG8_SA(1, 0), a3, voffA);
            PG8_WAIT_V(8); PG8_WAIT_L(0); PG8_BAR; PG8_MMA(1, 0, At, B0); PG8_MMA(1, 1, At, B1); PG8_BAR; PG8_SCHED;
            } else {
            PG8_LDB(B0, 0, 0); PG8_SCHED; PG8_LDA(At, 0, 0); PG8_STAGE(PG8_SA(1, 1), a1 + hstepA, voffA);
            PG8_WAIT_L(8); PG8_BAR; PG8_WAIT_L(0); PG8_MMA(0, 0, At, B0); PG8_BAR; PG8_SCHED;
            PG8_LDB(B1, 0, 1); PG8_STAGE(PG8_SB(0, 0), b2, voffB);
            PG8_BAR; PG8_WAIT_L(0); PG8_MMA(0, 1, At, B1); PG8_BAR;
            PG8_LDA(At, 0, 1); PG8_STAGE(PG8_SA(0, 0), a2, voffA);
            PG8_BAR; PG8_WAIT_L(0); PG8_MMA(1, 0, At, B0); PG8_BAR; PG8_SCHED;
            PG8_STAGE(PG8_SB(0, 1), b2 + hstepB, voffB);
            PG8_WAIT_V(6); PG8_BAR; PG8_MMA(1, 1, At, B1); PG8_BAR;
            PG8_LDB(B0, 1, 0); PG8_SCHED; PG8_LDA(At, 1, 0); PG8_STAGE(PG8_SA(0, 1), a2 + hstepA, voffA);
            PG8_WAIT_L(8); PG8_BAR; PG8_WAIT_L(0); PG8_MMA(0, 0, At, B0); PG8_BAR; PG8_SCHED;
            PG8_LDB(B1, 1, 1); PG8_STAGE(PG8_SB(1, 0), b3, voffB);
            PG8_BAR; PG8_WAIT_L(0); PG8_MMA(0, 1, At, B1); PG8_BAR;
            PG8_LDA(At, 1, 1); PG8_STAGE(PG8_SA(1, 0), a3, voffA);
            PG8_BAR; PG8_WAIT_L(0); PG8_MMA(1, 0, At, B0); PG8_BAR; PG8_SCHED;
            PG8_STAGE(PG8_SB(1, 1), b3 + hstepB, voffB);
            PG8_WAIT_V(6); PG8_BAR; PG8_MMA(1, 1, At, B1); PG8_BAR;
            }
        }
        if constexpr (ALIGN_EPI) { if (wr == 0) PG8_BAR; }
        if constexpr (!Epi::AFTER_DRAIN) { E(acc, cur, wr, wc, fr, fq); S.done(cur); }
        if (!has_next) break;
#pragma unroll
        for (int a = 0; a < 2; ++a)
#pragma unroll
            for (int b = 0; b < 2; ++b)
#pragma unroll
                for (int m = 0; m < 4; ++m)
#pragma unroll
                    for (int n = 0; n < 2; ++n) acc[a][b][m][n] = (f32x4){0.f, 0.f, 0.f, 0.f};
        cur = nxt; cA = nA; cB = nB; ++ui;
        if constexpr (ALIGN_EPI) { if (wr == 1) PG8_BAR; }
    }
    PG8_WAIT_V(0);
    if constexpr (!ALIGN_EPI) { if (wr == 0) PG8_BAR; }
    PG8_BAR;
    if constexpr (Epi::AFTER_DRAIN) { E.fused(acc, cur, wr, wc, fr, fq, lds, wid, lane); S.done(cur); }
#undef PG8_SA
#undef PG8_SB
#undef PG8_STAGE
#undef PG8_LDA
#undef PG8_LDB
#undef PG8_MMA
#undef PG8_WAIT_V
#undef PG8_WAIT_L
#undef PG8_BAR
#undef PG8_SCHED
}
}
#define XB_TMO      128
#define XB_XCNT(j)  (256  + 64 * (j))
#define XB_XSUB(j)  (1280 + 64 * (j))
#define XB_XGEN(j)  (2304 + 64 * (j))
#define XB_TOP      3328
#define XB_TOPGEN   3392
#define XCD_BAR_WORDS 3456
#define XB_SPIN_CAP (1u << 22)

__device__ __forceinline__ unsigned xb_ld(unsigned* p)              { return __hip_atomic_load(p, __ATOMIC_RELAXED, __HIP_MEMORY_SCOPE_AGENT); }
__device__ __forceinline__ unsigned xb_add(unsigned* p, unsigned v) { return __hip_atomic_fetch_add(p, v, __ATOMIC_RELAXED, __HIP_MEMORY_SCOPE_AGENT); }
__device__ __forceinline__ unsigned xb_xcc_id() { return (unsigned)__builtin_amdgcn_s_getreg((3 << 11) | 20) & 0xFu; }
#define XB_SPIN(cond, bar) do { unsigned _sp = 0; while (cond) { __builtin_amdgcn_s_sleep(1); \
    if ((++_sp & 255u) == 0u) { if (xb_ld(&(bar)[XB_TMO])) break; if (_sp > XB_SPIN_CAP) { atomicAdd(&(bar)[XB_TMO], 1u); break; } } } } while (0)

struct XcdBarrier {
    unsigned* bar; unsigned x;
    volatile LAS unsigned* st;
};

__device__ __forceinline__ XcdBarrier xcd_barrier_post(unsigned* bar, volatile LAS unsigned* st) {
    XcdBarrier b; b.bar = bar; b.x = xb_xcc_id(); b.st = st;
    if (threadIdx.x == 0) (void)xb_add(&bar[XB_XCNT(b.x)], 1u);
    return b;
}
__device__ __forceinline__ void xcd_barrier_complete(unsigned* bar, unsigned x, unsigned& nloc, unsigned& nx) {
    const unsigned G = gridDim.x * gridDim.y * gridDim.z;
    unsigned sum, cnt, mine, sp = 0u;
    for (;;) {
        sum = 0u; cnt = 0u; mine = 0u;
#pragma unroll
        for (unsigned j = 0; j < 16; ++j) { const unsigned c = xb_ld(&bar[XB_XCNT(j)]); sum += c; cnt += (c > 0u) ? 1u : 0u; mine = (j == x) ? c : mine; }
        if (sum == G) break;
        __builtin_amdgcn_s_sleep(1);
        if ((++sp & 255u) == 0u) { if (xb_ld(&bar[XB_TMO])) break; if (sp > XB_SPIN_CAP) { atomicAdd(&bar[XB_TMO], 1u); break; } }
    }
    nloc = mine > 0u ? mine : 1u; nx = cnt > 0u ? cnt : 1u;
}

__device__ __forceinline__ void xcd_barrier(const XcdBarrier& b) {
    asm volatile("s_waitcnt vmcnt(0)" ::: "memory");
    __syncthreads();
    if (threadIdx.x == 0) {
        unsigned* bar = b.bar;
        __builtin_amdgcn_s_waitcnt(0);
        unsigned nloc = b.st[0], nx = b.st[1];
        if (nloc == 0u) { xcd_barrier_complete(bar, b.x, nloc, nx); b.st[0] = nloc; b.st[1] = nx; }
        const unsigned old = xb_add(&bar[XB_XSUB(b.x)], 1u);
        const unsigned gen = old / nloc;
        if (old + 1u == (gen + 1u) * nloc) {
            __builtin_amdgcn_fence(__ATOMIC_RELEASE, "agent");
            asm volatile("s_waitcnt vmcnt(0)" ::: "memory");
            const unsigned og = xb_add(&bar[XB_TOP], 1u);
            const unsigned tg = og / nx;
            if (og + 1u == (tg + 1u) * nx) xb_add(&bar[XB_TOPGEN], 1u);
            else XB_SPIN(xb_ld(&bar[XB_TOPGEN]) == tg, bar);
            __builtin_amdgcn_fence(__ATOMIC_ACQUIRE, "agent");
            xb_add(&bar[XB_XGEN(b.x)], 1u);
            asm volatile("s_waitcnt vmcnt(0)" ::: "memory");
        } else {
            XB_SPIN(xb_ld(&bar[XB_XGEN(b.x)]) == gen, bar);
            __builtin_amdgcn_fence(__ATOMIC_ACQUIRE, "agent");
            asm volatile("s_waitcnt vmcnt(0)" ::: "memory");
        }
    }
    __syncthreads();
}

constexpr int T = 16384, D = 1024, FF = 4096;
constexpr int NWAVES = 8, NTHR = 512;
constexpr float EPS = 1e-6f;
constexpr int N0IN = 2560, N1IN = 2816, C_IN = 2584;
enum { I_X = 0, I_RELB, I_ABWIN, I_CONVW, I_CONVB, I_WRG, I_BRG, I_WIG, I_BIG, I_LAM, I_ABWOUT, I_CWIN, I_POSK, I_POSV, I_K1, I_K2, I_V1, I_V2, I_CWOUT,
       I_NMIXPRE, I_NMIXPOST, I_NMLPPRE, I_NMLPPOST, I_WUP, I_WDN, N_IN };

constexpr size_t MiB = 1u << 20;
constexpr size_t WS_CTL = 0, CTL_ZERO_BYTES = 1 * MiB;
constexpr size_t WS_BT = 1 * MiB;
constexpr size_t WS_KMEAN = 1 * MiB + 65536;
constexpr size_t WS_CARRY = 2 * MiB;
constexpr size_t WS_SELMASK = 3 * MiB;
constexpr size_t WS_SELQ = 4 * MiB;
constexpr size_t WS_SELT = 5 * MiB;
constexpr size_t WS_PO = 172 * MiB;
constexpr size_t WS_PML = 236 * MiB;
constexpr int CW_QUEUE = 8192;
constexpr size_t WS_W0IN = 8 * MiB, WS_W0OUT = 13 * MiB, WS_W0UP = 15 * MiB, WS_W0DN = 23 * MiB;
constexpr size_t WS_W1IN = 31 * MiB, WS_W1OUT = 37 * MiB, WS_W1UP = 39 * MiB, WS_W1DN = 47 * MiB;
constexpr size_t WS_CW1K = 55 * MiB, WS_CW1V = 57 * MiB;
constexpr size_t WS_CPART = 60 * MiB;
constexpr size_t WS_POSP = 76 * MiB;
constexpr size_t WS_XN = 60 * MiB;
constexpr size_t WS_PROJ = 92 * MiB;
constexpr size_t WS_HLOC = 172 * MiB;
constexpr size_t WS_OCW = 180 * MiB;
constexpr size_t WS_HID = 244 * MiB;
constexpr size_t WS_KCMP = 250 * MiB;
constexpr size_t WS_MB = 92 * MiB;
constexpr size_t WS_U = 124 * MiB;
constexpr size_t WS_X3 = 1 * MiB;
constexpr size_t WS_END = 256 * MiB;
constexpr int CW_BAR = 4096;

constexpr int SCR_BYTES = 131072;
constexpr int MISC_OFF = SCR_BYTES + 320;
constexpr int LDS_BYTES = 147456;

typedef unsigned short bf16;
typedef float f4 __attribute__((ext_vector_type(4)));
#define LDS_WAIT() asm volatile("s_waitcnt lgkmcnt(0)" ::: "memory")
#define VM_WAIT() asm volatile("s_waitcnt vmcnt(0)" ::: "memory")
__device__ __forceinline__ unsigned f2bf(float f) { unsigned u = __builtin_bit_cast(unsigned, f); return (u + 0x7fffu + ((u >> 16) & 1u)) >> 16; }
__device__ __forceinline__ unsigned pk2(float lo, float hi) { return f2bf(lo) | (f2bf(hi) << 16); }
__device__ __forceinline__ float bf2f(bf16 b) { return __builtin_bit_cast(float, ((unsigned)b) << 16); }
__device__ __forceinline__ float bflo(unsigned w) { return __builtin_bit_cast(float, w << 16); }
__device__ __forceinline__ float bfhi(unsigned w) { return __builtin_bit_cast(float, w & 0xffff0000u); }
__device__ __forceinline__ float wave_sum(float v) {
#pragma unroll
    for (int o = 1; o < 64; o <<= 1) v += __shfl_xor(v, o);
    return v;
}
__device__ __forceinline__ float wave_max(float v) {
#pragma unroll
    for (int o = 1; o < 64; o <<= 1) v = fmaxf(v, __shfl_xor(v, o));
    return v;
}
__device__ __forceinline__ void wave_argmax(float& v, int& i) {
#pragma unroll
    for (int o = 1; o < 64; o <<= 1) { const float ov = __shfl_xor(v, o); const int oi = __shfl_xor(i, o); if (ov > v || (ov == v && oi < i)) { v = ov; i = oi; } }
}
__device__ __forceinline__ float gelu_tanh(float x) { return 0.5f * x * (1.f + tanhf(0.7978845608028654f * (x + 0.044715f * x * x * x))); }
__device__ __forceinline__ float sigmoidf_(float x) { return 1.f / (1.f + __expf(-x)); }
__device__ __forceinline__ int t5_bucket(int d) {
    if (d < 16) return d;
    return 16 + (d >= 19) + (d >= 21) + (d >= 24) + (d >= 27) + (d >= 31) + (d >= 35) + (d >= 40) + (d >= 46) + (d >= 52) + (d >= 59) + (d >= 67) + (d >= 77) + (d >= 87) + (d >= 99) + (d >= 113);
}

#ifndef MOBA_MFMA
#define MOBA_MFMA 1
#endif
struct Params { const float* in[N_IN]; float* out; unsigned char* ws; int ph_lo, ph_hi; };

typedef unsigned v4u_t __attribute__((ext_vector_type(4)));
template <int ACT  > struct EpiT {
    static constexpr bool PERM = true, AFTER_DRAIN = false;
    bf16* O; int tcols; size_t tstride;
    __device__ __forceinline__ void operator()(const pg8::f32x4 (&acc)[2][2][4][2], const pg8::Unit& u, int wr, int wc, int fr, int fq) const {
        const int row0 = u.pm * 256 + wr * 64 + fr;
        const __amdgpu_buffer_rsrc_t rs = __builtin_amdgcn_make_buffer_rsrc((void*)O, 0, 0x7FFFFFF0, 0x00020000);
#pragma unroll
        for (int bj = 0; bj < 2; ++bj) {
            const int c0 = u.pn * 256 + bj * 128; const int tt = c0 / tcols; const int cw = c0 - tt * tcols;
            const unsigned base = (unsigned)(((size_t)tt * tstride + cw + wc * 32 + 8 * fq) * 2);
#pragma unroll
            for (int ai = 0; ai < 2; ++ai)
#pragma unroll
                for (int m = 0; m < 4; ++m) {
                    pg8::f32x4 v0 = acc[ai][bj][m][0], v1 = acc[ai][bj][m][1];
                    if (ACT == 1) {
#pragma unroll
                        for (int j = 0; j < 4; ++j) { const float a = fmaxf(v0[j], 0.f), b = fmaxf(v1[j], 0.f); v0[j] = a * a; v1[j] = b * b; } }
                    pg8::u32x4 w; w.x = pg8::cvt_pk_bf16(v0[0], v0[1]); w.y = pg8::cvt_pk_bf16(v0[2], v0[3]); w.z = pg8::cvt_pk_bf16(v1[0], v1[1]); w.w = pg8::cvt_pk_bf16(v1[2], v1[3]);
                    __builtin_amdgcn_raw_buffer_store_b128(__builtin_bit_cast(v4u_t, w), rs, base + (unsigned)((row0 + ai * 128 + m * 16) * tcols * 2), 0, 16);
                }
        }
    }
};
template <int ACT> __device__ __forceinline__ void run_gemm(LAS unsigned char* lds, const bf16* A, const bf16* Bt, int M, int N, int K, bf16* O, int tcols, size_t tstride, int G, int wg) {
    pg8::Gemm g{A, Bt, M, N, K, K, K}; pg8::StaticOrder S; S.init(M, N, G, wg); EpiT<ACT> E{O, tcols, tstride};
    pg8::gemm_phase<EpiT<ACT>, pg8::StaticOrder, true, true>((PG8_LAS unsigned char*)lds, g, S, E);
}

__device__ __forceinline__ void tr_load(const float* __restrict__ W, int K, int N, int item, int nblk, float (&wv)[32], int lane) {
    const int kb = item / nblk, nb = item % nblk, k0 = 64 * kb, n0 = 32 * nb;
    const int nn = n0 + (lane & 31); const bool ok = nn < N;
#pragma unroll
    for (int i = 0; i < 32; ++i) { const int kk = 2 * i + (lane >> 5); wv[i] = ok ? W[(size_t)(k0 + kk) * N + nn] : 0.f; }
}
__device__ __forceinline__ void tr_finish(int K, bf16* __restrict__ WT, int item, int nblk, const float (&wv)[32], LAS float* scr, int lane) {
    const int kb = item / nblk, nb = item % nblk, k0 = 64 * kb, n0 = 32 * nb;
#pragma unroll
    for (int i = 0; i < 32; ++i) { const int kk = 2 * i + (lane >> 5); scr[kk * 33 + (lane & 31)] = wv[i]; }
    LDS_WAIT(); asm volatile("" ::: "memory");
    const int c = lane & 7;
#pragma unroll
    for (int j = 0; j < 4; ++j) { const int n = (lane >> 3) + 8 * j; const LAS float* s = scr + (8 * c) * 33 + n;
        uint4 o; o.x = pk2(s[0 * 33], s[1 * 33]); o.y = pk2(s[2 * 33], s[3 * 33]); o.z = pk2(s[4 * 33], s[5 * 33]); o.w = pk2(s[6 * 33], s[7 * 33]);
        *(uint4*)(WT + (size_t)(n0 + n) * K + k0 + 8 * c) = o; }
    LDS_WAIT(); asm volatile("" ::: "memory");
}
struct WSel { const float* src; bf16* dst; int K, N, nblk, r; };
__device__ __forceinline__ WSel w_select(const Params& P, unsigned char* ws, int it) {
    WSel w; int r = it;
#define TRY_W(src_, K_, N_, NP_, dst_) { constexpr int cnt = ((K_) / 64) * ((NP_) / 32); if (r < cnt) { w.src = (src_); w.dst = (bf16*)(ws + (dst_)); w.K = (K_); w.N = (N_); w.nblk = (NP_) / 32; w.r = r; return w; } r -= cnt; }
    TRY_W(P.in[I_ABWIN], 1024, 2560, 2560, WS_W0IN)
    TRY_W(P.in[I_ABWOUT], 1024, 1024, 1024, WS_W0OUT)
    TRY_W(P.in[I_WUP], 1024, 4096, 4096, WS_W0UP)
    TRY_W(P.in[I_WDN], 4096, 1024, 1024, WS_W0DN)
    TRY_W(P.in[I_CWIN], 1024, C_IN, N1IN, WS_W1IN)
    TRY_W(P.in[I_CWOUT], 1024, 1024, 1024, WS_W1OUT)
    TRY_W(P.in[I_WUP] + (size_t)1024 * 4096, 1024, 4096, 4096, WS_W1UP)
    TRY_W(P.in[I_WDN] + (size_t)4096 * 1024, 4096, 1024, 1024, WS_W1DN)
    TRY_W(P.in[I_K1], 4096, 256, 256, WS_CW1K)
#undef TRY_W
    w.src = P.in[I_V1]; w.dst = (bf16*)(ws + WS_CW1V); w.K = 4096; w.N = 256; w.nblk = 8; w.r = r; return w;
}
__device__ __forceinline__ void rms_to_bf16(const float4 (&v)[4], const float* __restrict__ g, bf16* __restrict__ orow, int lane) {
    float ss = 0.f;
#pragma unroll
    for (int j = 0; j < 4; ++j) ss += (v[j].x * v[j].x + v[j].y * v[j].y) + (v[j].z * v[j].z + v[j].w * v[j].w);
    const float r = 1.f / sqrtf(wave_sum(ss) * (1.f / D) + EPS);
#pragma unroll
    for (int j = 0; j < 4; ++j) { const float4 gg = ((const float4*)g)[lane + 64 * j];
        uint2 o; o.x = pk2(v[j].x * r * gg.x, v[j].y * r * gg.y); o.y = pk2(v[j].z * r * gg.z, v[j].w * r * gg.w);
        ((uint2*)orow)[lane + 64 * j] = o; }
}
__device__ __forceinline__ void p0_prologue(const Params& P, LAS unsigned char* lds, int tid, int lane, int wave, int wg, int G) {
    unsigned char* ws = P.ws;
    LAS float* scr = (LAS float*)(lds + wave * 16384);
    const int gw = wg * NWAVES + wave, NGW = G * NWAVES;
    constexpr int NITEMS = 16 * 80 + 16 * 32 + 16 * 128 + 64 * 32 + 16 * 88 + 16 * 32 + 16 * 128 + 64 * 32 + 2 * 64 * 8;
    {
        float wa[32], wb[32];
        int it = gw;
        WSel cur = w_select(P, ws, it < NITEMS ? it : 0);
        if (it < NITEMS) tr_load(cur.src, cur.K, cur.N, cur.r, cur.nblk, wa, lane);
        while (it < NITEMS) {
            const int itn = it + NGW; WSel nx = w_select(P, ws, itn < NITEMS ? itn : 0);
            if (itn < NITEMS) tr_load(nx.src, nx.K, nx.N, nx.r, nx.nblk, wb, lane);
            tr_finish(cur.K, cur.dst, cur.r, cur.nblk, wa, scr, lane);
            if (itn >= NITEMS) break;
            const int it2 = itn + NGW; cur = w_select(P, ws, it2 < NITEMS ? it2 : 0);
            if (it2 < NITEMS) tr_load(cur.src, cur.K, cur.N, cur.r, cur.nblk, wa, lane);
            tr_finish(nx.K, nx.dst, nx.r, nx.nblk, wb, scr, lane);
            it = it2;
        }
    }
    if (wg == 0) { float* bt = (float*)(ws + WS_BT); for (int i = tid; i < 1024; i += NTHR) { const int h = i >> 7, d = i & 127; bt[i] = P.in[I_RELB][t5_bucket(d) * 8 + h]; } }
    for (int m = gw; m < T; m += 2 * NGW) {
        const float4* xr0 = (const float4*)(P.in[I_X] + (size_t)m * D); const float4* xr1 = (const float4*)(P.in[I_X] + (size_t)((m + NGW < T) ? (m + NGW) : m) * D); float4 v0[4], v1[4];
#pragma unroll
        for (int j = 0; j < 4; ++j) { v0[j] = xr0[lane + 64 * j]; v1[j] = xr1[lane + 64 * j]; }
        rms_to_bf16(v0, P.in[I_NMIXPRE], (bf16*)(ws + WS_XN) + (size_t)m * D, lane);
        if (m + NGW < T) rms_to_bf16(v1, P.in[I_NMIXPRE], (bf16*)(ws + WS_XN) + (size_t)(m + NGW) * D, lane);
    }
}

template <int XIN, int XOUT>
__device__ __forceinline__ void post_norm(const void* xin_, void* xout_, const bf16* __restrict__ y, const float* __restrict__ g1, const float* __restrict__ g2  ,
                                          bf16* __restrict__ xn, int lane, int gw, int NGW) {
    for (int m0 = gw; m0 < T; m0 += 2 * NGW) {
        const int m1 = (m0 + NGW < T) ? (m0 + NGW) : m0; const bool two = (m0 + NGW < T);
        const uint2* yr0 = (const uint2*)(y + (size_t)m0 * D); const uint2* yr1 = (const uint2*)(y + (size_t)m1 * D);
        uint2 yw0[4], yw1[4]; float4 xv0[4], xv1[4];
        if (XIN == 0) {
            const float4* xr0 = (const float4*)((const float*)xin_ + (size_t)m0 * D); const float4* xr1 = (const float4*)((const float*)xin_ + (size_t)m1 * D);
#pragma unroll
            for (int j = 0; j < 4; ++j) { yw0[j] = yr0[lane + 64 * j]; yw1[j] = yr1[lane + 64 * j]; xv0[j] = xr0[lane + 64 * j]; xv1[j] = xr1[lane + 64 * j]; }
        } else {
            const uint2* xr0 = (const uint2*)((const bf16*)xin_ + (size_t)m0 * D); const uint2* xr1 = (const uint2*)((const bf16*)xin_ + (size_t)m1 * D);
            uint2 xw0[4], xw1[4];
#pragma unroll
            for (int j = 0; j < 4; ++j) { yw0[j] = yr0[lane + 64 * j]; yw1[j] = yr1[lane + 64 * j]; xw0[j] = xr0[lane + 64 * j]; xw1[j] = xr1[lane + 64 * j]; }
#pragma unroll
            for (int j = 0; j < 4; ++j) { xv0[j] = make_float4(bflo(xw0[j].x), bfhi(xw0[j].x), bflo(xw0[j].y), bfhi(xw0[j].y)); xv1[j] = make_float4(bflo(xw1[j].x), bfhi(xw1[j].x), bflo(xw1[j].y), bfhi(xw1[j].y)); }
        }
#pragma unroll
        for (int rr = 0; rr < 2; ++rr) {
            if (rr == 1 && !two) break;
            const int m = rr ? m1 : m0; float4 yv[4]; float ss = 0.f;
#pragma unroll
            for (int j = 0; j < 4; ++j) { const uint2 w = rr ? yw1[j] : yw0[j]; yv[j] = make_float4(bflo(w.x), bfhi(w.x), bflo(w.y), bfhi(w.y));
                ss += (yv[j].x * yv[j].x + yv[j].y * yv[j].y) + (yv[j].z * yv[j].z + yv[j].w * yv[j].w); }
            const float r = 1.f / sqrtf(wave_sum(ss) * (1.f / D) + EPS);
            float4 v[4];
#pragma unroll
            for (int j = 0; j < 4; ++j) { const float4 xv = rr ? xv1[j] : xv0[j]; const float4 gg = ((const float4*)g1)[lane + 64 * j];
                v[j] = make_float4(xv.x + yv[j].x * r * gg.x, xv.y + yv[j].y * r * gg.y, xv.z + yv[j].z * r * gg.z, xv.w + yv[j].w * r * gg.w);
                if (XOUT == 0) ((float4*)((float*)xout_ + (size_t)m * D))[lane + 64 * j] = v[j];
                else { uint2 o; o.x = pk2(v[j].x, v[j].y); o.y = pk2(v[j].z, v[j].w); ((uint2*)((bf16*)xout_ + (size_t)m * D))[lane + 64 * j] = o; } }
            if (g2) rms_to_bf16(v, g2, xn + (size_t)m * D, lane);
        }
    }
}

template <int DH, int NP, int MODE>
__device__ __forceinline__ void wattn_tile(const bf16* __restrict__ Kt, const bf16* __restrict__ Vt, int ldk, int key0, int kend, int t, int posmul, int posadd, int dmax,
                                           const LAS float* qs, const float* __restrict__ btab, int h0, float scale,
                                           float (&m)[NP], float (&l)[NP], float (&o)[NP][DH / 64], LAS float* cs, int lane) {
    const int k = key0 + lane; const bool inb = k < kend; const int kc = inb ? k : (kend - 1);
    const int d = t - (posmul * kc + posadd);
    const bool valid = inb && d >= 0 && d < dmax;
    float s[NP];
#pragma unroll
    for (int p = 0; p < NP; ++p) s[p] = 0.f;
    const uint4* krow = (const uint4*)(Kt + (size_t)kc * ldk);
    uint4 kr[DH / 8];
#pragma unroll
    for (int c = 0; c < DH / 8; ++c) kr[c] = krow[c];
#pragma unroll
    for (int c = 0; c < DH / 8; ++c) {
        asm volatile("" ::: "memory");
        const uint4 kv = kr[c];
        const float k0 = bflo(kv.x), k1 = bfhi(kv.x), k2 = bflo(kv.y), k3 = bfhi(kv.y), k4 = bflo(kv.z), k5 = bfhi(kv.z), k6 = bflo(kv.w), k7 = bfhi(kv.w);
#pragma unroll
        for (int p = 0; p < NP; ++p) { const f4 qa = *(const volatile LAS f4*)(qs + p * DH + 8 * c), qb = *(const volatile LAS f4*)(qs + p * DH + 8 * c + 4);
            s[p] += (k0 * qa.x + k1 * qa.y) + (k2 * qa.z + k3 * qa.w) + (k4 * qb.x + k5 * qb.y) + (k6 * qb.z + k7 * qb.w);
            asm volatile("" : "+v"(s[p]) :: "memory"); }
    }
    const int dd = d < 0 ? 0 : (d > 127 ? 127 : d);
    float pe[NP];
#pragma unroll
    for (int p = 0; p < NP; ++p) {
        const float sc = valid ? s[p] * scale + btab[(h0 + p) * 128 + dd] : -INFINITY;
        if (MODE == 2) { pe[p] = valid ? __expf(sc - m[p]) * l[p] : 0.f; }
        else {
            const float tm = wave_max(sc); const float mn = fmaxf(m[p], tm);
            float alpha = 1.f; pe[p] = 0.f;
            if (mn != -INFINITY) { alpha = __expf(m[p] - mn); pe[p] = valid ? __expf(sc - mn) : 0.f; }
            l[p] = l[p] * alpha + wave_sum(pe[p]); m[p] = mn;
            if (MODE == 0) {
#pragma unroll
                for (int i = 0; i < DH / 64; ++i) o[p][i] *= alpha; }
        }
    }
    if (MODE == 2) { float csum = 0.f;
#pragma unroll
        for (int p = 0; p < NP; ++p) csum += pe[p];
        if (inb) cs[k] = csum; }
    if (MODE != 1) {
        const int nk = (kend - key0) < 64 ? (kend - key0) : 64;
        for (int kk = 0; kk < nk; ++kk) {
            const bf16* vrow = Vt + (size_t)(key0 + kk) * ldk;
            float v0, v1 = 0.f;
            if (DH == 128) { const unsigned w = ((const unsigned*)vrow)[lane]; v0 = bflo(w); v1 = bfhi(w); } else { v0 = bf2f(vrow[lane]); }
#pragma unroll
            for (int p = 0; p < NP; ++p) { const float pk = __builtin_bit_cast(float, __builtin_amdgcn_readlane(__builtin_bit_cast(int, pe[p]), kk));
                o[p][0] += pk * v0; if (DH == 128) o[p][DH / 64 - 1] += pk * v1; }
        }
    }
}

__device__ __forceinline__ void l0_stage_a(const Params& P, LAS unsigned char* lds, int tid, int lane, int wave, int wg, int G) {
    unsigned char* ws = P.ws;
    const bf16* proj = (const bf16*)(ws + WS_PROJ);
    const bf16* xr = proj + (size_t)3 * T * 512;
    LAS float* xc = (LAS float*)lds;
    unsigned* hp = (unsigned*)(ws + WS_HLOC);
    const int c = tid, b = c >> 6;
    LAS bf16* rp = (LAS bf16*)(lds + 65536); LAS bf16* ip = (LAS bf16*)(lds + 98304);
    const int r16 = lane & 15, gl = lane >> 4;
    pg8::bf16x8 wfr[4][2], wfi[4][2];
    {
        const float* Wr = P.in[I_WRG] + (size_t)b * 4096; const float* Wi = P.in[I_WIG] + (size_t)b * 4096;
#pragma unroll
        for (int nt = 0; nt < 4; ++nt)
#pragma unroll
            for (int ks = 0; ks < 2; ++ks) { float fr[8], fi[8];
#pragma unroll
                for (int j = 0; j < 8; ++j) { const int idx = (32 * ks + 8 * gl + j) * 64 + 16 * nt + r16; fr[j] = Wr[idx]; fi[j] = Wi[idx]; }
                pg8::u32x4 wr4, wi4; wr4.x = pk2(fr[0], fr[1]); wr4.y = pk2(fr[2], fr[3]); wr4.z = pk2(fr[4], fr[5]); wr4.w = pk2(fr[6], fr[7]);
                wi4.x = pk2(fi[0], fi[1]); wi4.y = pk2(fi[2], fi[3]); wi4.z = pk2(fi[4], fi[5]); wi4.w = pk2(fi[6], fi[7]);
                wfr[nt][ks] = __builtin_bit_cast(pg8::bf16x8, wr4); wfi[nt][ks] = __builtin_bit_cast(pg8::bf16x8, wi4); }
    }
    float brg4[4], big4[4];
#pragma unroll
    for (int nt = 0; nt < 4; ++nt) { brg4[nt] = P.in[I_BRG][64 * b + 16 * nt + r16]; big4[nt] = P.in[I_BIG][64 * b + 16 * nt + r16]; }
    const float sp = log1pf(expf(-P.in[I_LAM][c]));
    const float* cw = P.in[I_CONVW]; const float w0 = cw[c], w1 = cw[512 + c], w2 = cw[1024 + c], w3 = cw[1536 + c], cb = P.in[I_CONVB][c];
    for (int ch = wg; ch < T / 64; ch += G) {
        const int t0 = ch * 64;
        float xm3 = (t0 >= 3) ? bf2f(xr[(size_t)(t0 - 3) * 512 + c]) : 0.f, xm2 = (t0 >= 2) ? bf2f(xr[(size_t)(t0 - 2) * 512 + c]) : 0.f, xm1 = (t0 >= 1) ? bf2f(xr[(size_t)(t0 - 1) * 512 + c]) : 0.f;
        float h = 0.f, Pc = 1.f;
#pragma unroll 1
        for (int hf = 0; hf < 2; ++hf) {
            const int ts = t0 + 32 * hf;
            for (int t16 = 0; t16 < 32; t16 += 16) { bf16 xv[16];
#pragma unroll
                for (int i = 0; i < 16; ++i) xv[i] = xr[(size_t)(ts + t16 + i) * 512 + c];
#pragma unroll
                for (int i = 0; i < 16; ++i) { const float x0 = bf2f(xv[i]); xc[(t16 + i) * 512 + c] = cb + w0 * xm3 + w1 * xm2 + w2 * xm1 + w3 * x0; xm3 = xm2; xm2 = xm1; xm1 = x0; } }
            __syncthreads();
#pragma unroll
            for (int mt = 0; mt < 2; ++mt) {
                pg8::bf16x8 af[2];
#pragma unroll
                for (int ks = 0; ks < 2; ++ks) { const LAS f4* xp = (const LAS f4*)(xc + (16 * mt + r16) * 512 + 64 * b + 32 * ks + 8 * gl); const f4 x0 = xp[0], x1 = xp[1];
                    pg8::u32x4 w; w.x = pk2(x0.x, x0.y); w.y = pk2(x0.z, x0.w); w.z = pk2(x1.x, x1.y); w.w = pk2(x1.z, x1.w); af[ks] = __builtin_bit_cast(pg8::bf16x8, w); }
#pragma unroll
                for (int nt = 0; nt < 4; ++nt) {
                    pg8::f32x4 ar = {0.f, 0.f, 0.f, 0.f}, ai = {0.f, 0.f, 0.f, 0.f};
                    ar = __builtin_amdgcn_mfma_f32_16x16x32_bf16(af[0], wfr[nt][0], ar, 0, 0, 0); ar = __builtin_amdgcn_mfma_f32_16x16x32_bf16(af[1], wfr[nt][1], ar, 0, 0, 0);
                    ai = __builtin_amdgcn_mfma_f32_16x16x32_bf16(af[0], wfi[nt][0], ai, 0, 0, 0); ai = __builtin_amdgcn_mfma_f32_16x16x32_bf16(af[1], wfi[nt][1], ai, 0, 0, 0);
#pragma unroll
                    for (int i = 0; i < 4; ++i) { const int o_ = (16 * mt + 4 * gl + i) * 512 + 64 * b + 16 * nt + r16; rp[o_] = (bf16)f2bf(ar[i] + brg4[nt]); ip[o_] = (bf16)f2bf(ai[i] + big4[nt]); }
                }
            }
            __syncthreads();
#pragma unroll 4
            for (int t = 0; t < 32; ++t) {
                const float r = __builtin_amdgcn_rcpf(1.f + __builtin_amdgcn_exp2f(-1.4426950408889634f * bf2f(rp[t * 512 + c]))), ig = __builtin_amdgcn_rcpf(1.f + __builtin_amdgcn_exp2f(-1.4426950408889634f * bf2f(ip[t * 512 + c])));
                const float la = -8.f * r * sp; const float a = __builtin_amdgcn_exp2f(1.4426950408889634f * la); const float x2 = 2.f * la;
                const float em_s = -x2 * (1.f + x2 * 0.5f * (1.f + x2 * (1.f / 3.f) * (1.f + x2 * 0.25f * (1.f + x2 * 0.2f * (1.f + x2 * (1.f / 6.f))))));
                const float em = (x2 > -0.25f) ? em_s : 1.f - a * a;
                const float bb = __builtin_amdgcn_sqrtf(em) * ig * xc[t * 512 + c];
                h = a * h + bb; Pc *= a;
                hp[(size_t)(ts + t) * 512 + c] = pk2(h, Pc);
            }
            __syncthreads();
        }
        float* car = (float*)(ws + WS_CARRY) + (size_t)ch * 1024; car[c] = Pc; car[512 + c] = h;
    }
    const bf16* kt = proj + (size_t)1 * T * 512; float* kmean = (float*)(ws + WS_KMEAN);
    LAS float* red = (LAS float*)lds;
    for (int task = wg; task < 512; task += G) {
        const int h = task >> 6, j = task & 63, d = tid & 63, rg = tid >> 6; const bf16* kk = kt + (size_t)(256 * j + rg) * 512 + 64 * h + d; float sacc = 0.f;
#pragma unroll
        for (int r8 = 0; r8 < 32; r8 += 8) { bf16 v[8];
#pragma unroll
            for (int i = 0; i < 8; ++i) v[i] = kk[(size_t)(8 * (r8 + i)) * 512];
#pragma unroll
            for (int i = 0; i < 8; ++i) sacc += bf2f(v[i]); }
        __syncthreads();
        red[rg * 64 + d] = sacc;
        __syncthreads();
        if (tid < 64) { float t_ = 0.f;
#pragma unroll
            for (int g8 = 0; g8 < 8; ++g8) t_ += red[g8 * 64 + tid];
            kmean[(h * 64 + j) * 64 + tid] = t_ * (1.f / 256.f); }
    }
}

__device__ __forceinline__ void l0_stage_c(const Params& P, LAS unsigned char* lds, int tid, int lane, int wave, int wg, int G) {
    unsigned char* ws = P.ws;
    const bf16* proj = (const bf16*)(ws + WS_PROJ);
    bf16* attnout = (bf16*)(ws + WS_XN);
    {
        const unsigned* hp = (const unsigned*)(ws + WS_HLOC); const float* car = (const float*)(ws + WS_CARRY);
        const bf16* gr = proj + (size_t)4 * T * 512;
        for (int ch = wg; ch < T / 64; ch += G) {
            const int c = tid, t0 = ch * 64; float H = 0.f;
            int cc = 0;
            for (; cc + 16 <= ch; cc += 16) {
                float a_[16], b_[16];
#pragma unroll
                for (int i = 0; i < 16; ++i) { a_[i] = car[(size_t)(cc + i) * 1024 + c]; b_[i] = car[(size_t)(cc + i) * 1024 + 512 + c]; }
#pragma unroll
                for (int i = 0; i < 16; ++i) H = a_[i] * H + b_[i];
            }
            for (; cc < ch; ++cc) H = car[(size_t)cc * 1024 + c] * H + car[(size_t)cc * 1024 + 512 + c];
            for (int t8 = 0; t8 < 64; t8 += 16) {
                unsigned hw[16]; bf16 gv[16];
#pragma unroll
                for (int i = 0; i < 16; ++i) { const size_t ix = (size_t)(t0 + t8 + i) * 512 + c; hw[i] = hp[ix]; gv[i] = gr[ix]; }
#pragma unroll
                for (int i = 0; i < 16; ++i) attnout[(size_t)(t0 + t8 + i) * 1024 + 512 + c] = (bf16)f2bf((bflo(hw[i]) + bfhi(hw[i]) * H) * gelu_tanh(bf2f(gv[i])));
            }
        }
    }
#if !MOBA_MFMA
    const bf16* qt = proj; const bf16* kt = proj + (size_t)1 * T * 512; const bf16* vt = proj + (size_t)2 * T * 512;
    const float* kmean = (const float*)(ws + WS_KMEAN); const float* btab = (const float*)(ws + WS_BT);
    LAS float* qs = (LAS float*)(lds + wave * 8192);
    for (int task = wg * NWAVES + wave; task < T * 8; task += G * NWAVES) {
        const int t = task >> 3, h = task & 7, own = t >> 8;
        qs[lane] = bf2f(qt[(size_t)t * 512 + 64 * h + lane]);
        LDS_WAIT(); asm volatile("" ::: "memory");
        float rv = -1e30f;
        if (lane < own) { const float4* km = (const float4*)(kmean + (size_t)(h * 64 + lane) * 64); float s = 0.f;
#pragma unroll
            for (int i = 0; i < 16; ++i) { const float4 kv = km[i]; const f4 qv = *(const LAS f4*)(qs + 4 * i); s += (kv.x * qv.x + kv.y * qv.y) + (kv.z * qv.z + kv.w * qv.w); }
            rv = s; }
        int sel[3];
#pragma unroll
        for (int r = 0; r < 3; ++r) { float bv = rv; int bi = lane; wave_argmax(bv, bi); bi = __builtin_amdgcn_readfirstlane(bi); sel[r] = (bv > -5e29f) ? bi : -1; if (lane == bi) rv = -INFINITY; }
        float m[1] = {-INFINITY}, l[1] = {0.f}, o[1][1] = {{0.f}};
#pragma unroll
        for (int r = 0; r < 3; ++r) if (sel[r] >= 0) for (int tile = 0; tile < 4; ++tile) { const int key0 = sel[r] * 256 + 64 * tile;
            wattn_tile<64, 1, 0>(kt + 64 * h, vt + 64 * h, 512, key0, key0 + 64, t, 1, 0, 0x7fffffff, qs, btab, h, 0.125f, m, l, o, nullptr, lane); }
        for (int key0 = own * 256; key0 <= t; key0 += 64)
            wattn_tile<64, 1, 0>(kt + 64 * h, vt + 64 * h, 512, key0, t + 1, t, 1, 0, 0x7fffffff, qs, btab, h, 0.125f, m, l, o, nullptr, lane);
        attnout[(size_t)t * 1024 + 64 * h + lane] = (bf16)f2bf(o[0][0] / fmaxf(l[0], 1e-30f));
        asm volatile("" ::: "memory");
    }
#endif
}

__device__ __forceinline__ const bf16* l1_tensor(const unsigned char* ws, int i) { return (const bf16*)(ws + WS_PROJ) + (size_t)i * T * 128; }
__device__ __forceinline__ void l1_load_q(const unsigned char* ws, int t, int g, LAS float* qs, int lane) {
#pragma unroll
    for (int p = 0; p < 4; ++p) { const unsigned w = ((const unsigned*)(l1_tensor(ws, 4 * g + p) + (size_t)t * 128))[lane]; qs[p * 128 + 2 * lane] = bflo(w); qs[p * 128 + 2 * lane + 1] = bfhi(w); }
    LDS_WAIT(); asm volatile("" ::: "memory");
}
__device__ __forceinline__ bf16 l1_gate_raw(const unsigned char* ws, int t, int h, int i) { return l1_tensor(ws, 20)[(size_t)t * 128 + 3 * h + i]; }
__device__ __forceinline__ float l1_gate(const unsigned char* ws, int t, int h, int i) { return sigmoidf_(bf2f(l1_tensor(ws, 20)[(size_t)t * 128 + 3 * h + i])); }
constexpr float SCALE_C = 0.08838834764831845f;
#ifndef WIN_MFMA
#define WIN_MFMA 1
#endif
#ifndef COMPRESS_MFMA
#define COMPRESS_MFMA 1
#endif

__device__ __forceinline__ void l1_stage_a(const Params& P, LAS unsigned char* lds, int tid, int lane, int wave, int wg, int G) {
    unsigned char* ws = P.ws;
#if !COMPRESS_MFMA
    {
        LAS float* kts = (LAS float*)lds;
        LAS float* pos_s = (LAS float*)(lds + 73728);
        LAS float* red = (LAS float*)(lds + 90112);
        float* hid = (float*)(ws + WS_HID);
        for (int task = wg; task < 512; task += G) {
            const int kv = task >> 8, g = (task >> 7) & 1, n0 = (task & 127) * 8;
            const bf16* src = l1_tensor(ws, (kv ? 10 : 8) + g); const float* pos = P.in[kv ? I_POSV : I_POSK]; const float* w1 = P.in[kv ? I_V1 : I_K1];
            for (int i = tid; i < 144 * 128; i += NTHR) { const int tok = 16 * n0 + (i >> 7); kts[i] = tok < T ? bf2f(src[(size_t)tok * 128 + (i & 127)]) : 0.f; }
            for (int i = tid; i < 32 * 128; i += NTHR) pos_s[i] = pos[i];
            __syncthreads();
            const int j = tid & 255, half = tid >> 8;
            float acc[8];
#pragma unroll
            for (int i = 0; i < 8; ++i) acc[i] = 0.f;
            for (int l = half * 16; l < half * 16 + 16; ++l)
                for (int d4 = 0; d4 < 32; ++d4) {
                    const float* wp = w1 + (size_t)(l * 128 + 4 * d4) * 256 + j; const float wa = wp[0], wb = wp[256], wc_ = wp[512], wd = wp[768];
                    const f4 pv = *(const LAS f4*)(pos_s + l * 128 + 4 * d4);
#pragma unroll
                    for (int i = 0; i < 8; ++i) { const f4 kk = *(const LAS f4*)(kts + (16 * i + l) * 128 + 4 * d4);
                        acc[i] += ((kk.x + pv.x) * wa + (kk.y + pv.y) * wb) + ((kk.z + pv.z) * wc_ + (kk.w + pv.w) * wd); }
                }
            if (half == 1) {
#pragma unroll
                for (int i = 0; i < 8; ++i) red[i * 256 + j] = acc[i]; }
            __syncthreads();
            if (half == 0) {
#pragma unroll
                for (int i = 0; i < 8; ++i) { const int n = n0 + i; if (n < 1023) hid[((size_t)(kv * 1024 + n) * 2 + g) * 256 + j] = gelu_tanh(acc[i] + red[i * 256 + j]); } }
            __syncthreads();
        }
    }
#endif
#if !WIN_MFMA
    const float* btab = (const float*)(ws + WS_BT); float* ocw = (float*)(ws + WS_OCW);
    LAS float* qs = (LAS float*)(lds + wave * 8192);
    for (int task = wg * NWAVES + wave; task < T * 2; task += G * NWAVES) {
        const int t = task >> 1, g = task & 1;
        l1_load_q(ws, t, g, qs, lane);
        float m[4], l[4], o[4][2];
#pragma unroll
        for (int p = 0; p < 4; ++p) { m[p] = -INFINITY; l[p] = 0.f; o[p][0] = 0.f; o[p][1] = 0.f; }
        const int lo = t >= 511 ? t - 511 : 0;
        for (int key0 = lo; key0 <= t; key0 += 64)
            wattn_tile<128, 4, 0>(l1_tensor(ws, 16 + g), l1_tensor(ws, 18 + g), 128, key0, t + 1, t, 1, 0, 512, qs, btab, 4 * g, SCALE_C, m, l, o, nullptr, lane);
#pragma unroll
        for (int p = 0; p < 4; ++p) { const float gt = l1_gate(ws, t, 4 * g + p, 2) / fmaxf(l[p], 1e-30f);
            *(float2*)(ocw + (size_t)t * 1024 + (4 * g + p) * 128 + 2 * lane) = make_float2(gt * o[p][0], gt * o[p][1]); }
        asm volatile("" ::: "memory");
    }
#endif
}
__device__ __forceinline__ void l1_stage_b(const Params& P, int tid, int wg, int G) {
    unsigned char* ws = P.ws; const float* hid = (const float*)(ws + WS_HID); bf16* kc = (bf16*)(ws + WS_KCMP);
    for (int idx = wg * NTHR + tid; idx < 2 * 2 * 1023 * 128; idx += G * NTHR) {
        const int d = idx & 127; int r = idx >> 7; const int n = r % 1023; r /= 1023; const int g = r & 1, kv = r >> 1;
        const float* hp = hid + ((size_t)(kv * 1024 + n) * 2 + g) * 256; const float* w2 = P.in[kv ? I_V2 : I_K2] + d; float s = 0.f;
#pragma unroll 8
        for (int j = 0; j < 256; ++j) s += hp[j] * w2[(size_t)j * 128];
        kc[((size_t)(kv * 2 + g) * 1024 + n) * 128 + d] = (bf16)f2bf(s);
    }
}
__device__ __forceinline__ void l1_stage_c(const Params& P, LAS unsigned char* lds, int tid, int lane, int wave, int wg, int G) {
    unsigned char* ws = P.ws;
    const float* btab = (const float*)(ws + WS_BT); float* ocw = (float*)(ws + WS_OCW); unsigned* selmask = (unsigned*)(ws + WS_SELMASK);
    LAS float* qs = (LAS float*)(lds + wave * 8192); LAS float* cs = qs + 512 + 8;
    for (int task = wg * NWAVES + wave; task < T * 2; task += G * NWAVES) {
        const int t = task >> 1, g = task & 1, cur = t >> 6;
        l1_load_q(ws, t, g, qs, lane);
        for (int i = lane; i < 1040; i += 64) cs[i - 4] = 0.f;
        LDS_WAIT(); asm volatile("" ::: "memory");
        const bf16* kc = (const bf16*)(ws + WS_KCMP) + (size_t)(0 * 2 + g) * 1024 * 128; const bf16* vc = (const bf16*)(ws + WS_KCMP) + (size_t)(1 * 2 + g) * 1024 * 128;
        int nvalid = t >= 31 ? ((t - 31) >> 4) + 1 : 0; if (nvalid > 1023) nvalid = 1023;
        float m[4], l[4], o[4][2];
#pragma unroll
        for (int p = 0; p < 4; ++p) { m[p] = -INFINITY; l[p] = 0.f; o[p][0] = 0.f; o[p][1] = 0.f; }
        for (int key0 = 0; key0 < nvalid; key0 += 64)
            wattn_tile<128, 4, 1>(kc, vc, 128, key0, nvalid, t, 16, 31, 0x7fffffff, qs, btab, 4 * g, SCALE_C, m, l, o, cs, lane);
#pragma unroll
        for (int p = 0; p < 4; ++p) l[p] = 1.f / fmaxf(l[p], 1e-30f);
        for (int key0 = 0; key0 < nvalid; key0 += 64)
            wattn_tile<128, 4, 2>(kc, vc, 128, key0, nvalid, t, 16, 31, 0x7fffffff, qs, btab, 4 * g, SCALE_C, m, l, o, cs, lane);
#pragma unroll
        for (int p = 0; p < 4; ++p) { const float gt = l1_gate(ws, t, 4 * g + p, 0); float2* op = (float2*)(ocw + (size_t)t * 1024 + (4 * g + p) * 128 + 2 * lane);
            float2 v = *op; v.x += gt * o[p][0]; v.y += gt * o[p][1]; *op = v; }
        LDS_WAIT(); asm volatile("" ::: "memory");
        float iv[4];
#pragma unroll
        for (int i = 0; i < 4; ++i) { const int j = lane + 64 * i; float v = cs[4 * j - 1] + cs[4 * j] + cs[4 * j + 1] + cs[4 * j + 2] + cs[4 * j + 3];
            if (j == 0 || j == cur || j == cur - 1) v += 1e4f;
            if (j > cur) v = -1e30f;
            iv[i] = v; }
        unsigned mk[4] = {0u, 0u, 0u, 0u};
        for (int r = 0; r < 16; ++r) {
            float bv = iv[0]; int bi = lane;
#pragma unroll
            for (int i = 1; i < 4; ++i) if (iv[i] > bv) { bv = iv[i]; bi = lane + 64 * i; }
            wave_argmax(bv, bi); bi = __builtin_amdgcn_readfirstlane(bi);
            if (!(bv > -5e29f)) break;
#pragma unroll
            for (int i = 0; i < 4; ++i) if (lane + 64 * i == bi) { iv[i] = -INFINITY; mk[i] = 1u; }
        }
#pragma unroll
        for (int i = 0; i < 4; ++i) { const unsigned long long bal = __ballot(mk[i] != 0u);
            if (lane == 0) { selmask[((size_t)t * 2 + g) * 8 + 2 * i] = (unsigned)bal; selmask[((size_t)t * 2 + g) * 8 + 2 * i + 1] = (unsigned)(bal >> 32); } }
        asm volatile("" ::: "memory");
    }
}
__device__ __forceinline__ void l1_stage_d(const Params& P, LAS unsigned char* lds, int tid, int lane, int wave, int wg, int G) {
    unsigned char* ws = P.ws;
    const float* btab = (const float*)(ws + WS_BT); const float* ocw = (const float*)(ws + WS_OCW); const unsigned* selmask = (const unsigned*)(ws + WS_SELMASK);
    bf16* attnout = (bf16*)(ws + WS_XN);
    LAS float* qs = (LAS float*)(lds + wave * 8192);
    for (int task = wg * NWAVES + wave; task < T * 2; task += G * NWAVES) {
        const int t = task >> 1, g = task & 1;
        l1_load_q(ws, t, g, qs, lane);
        float m[4], l[4], o[4][2];
#pragma unroll
        for (int p = 0; p < 4; ++p) { m[p] = -INFINITY; l[p] = 0.f; o[p][0] = 0.f; o[p][1] = 0.f; }
        for (int w = 0; w < 8; ++w) {
            unsigned bits = __builtin_amdgcn_readfirstlane(selmask[((size_t)t * 2 + g) * 8 + w]);
            while (bits) { const int b = __builtin_ctz(bits); bits &= bits - 1u; const int key0 = (32 * w + b) * 64; const int kend = (key0 + 64) < (t + 1) ? (key0 + 64) : (t + 1);
                wattn_tile<128, 4, 0>(l1_tensor(ws, 12 + g), l1_tensor(ws, 14 + g), 128, key0, kend, t, 1, 0, 0x7fffffff, qs, btab, 4 * g, SCALE_C, m, l, o, nullptr, lane); }
        }
#pragma unroll
        for (int p = 0; p < 4; ++p) { const float gt = l1_gate(ws, t, 4 * g + p, 1) / fmaxf(l[p], 1e-30f); const float2 base = *(const float2*)(ocw + (size_t)t * 1024 + (4 * g + p) * 128 + 2 * lane);
            *(unsigned*)(attnout + (size_t)t * 1024 + (4 * g + p) * 128 + 2 * lane) = pk2(base.x + gt * o[p][0], base.y + gt * o[p][1]); }
        asm volatile("" ::: "memory");
    }
}

typedef short bf16x8 __attribute__((ext_vector_type(8)));
typedef short v4i16_t __attribute__((ext_vector_type(4)));
typedef float f32x16 __attribute__((ext_vector_type(16)));
typedef unsigned u4 __attribute__((ext_vector_type(4)));
template <int DH> struct AT { static constexpr int PK = DH * 2 + 16, TILE = 64 * PK, NKS = DH / 16, NDT = DH / 32, CPT = DH / 64; };
template <int DH> __device__ __forceinline__ int v_off(int row, int ch) {
    if (DH == 128) return 256 * row + 16 * (ch ^ (((row & 3) << 2) | ((row >> 2) & 3)));
    else return 128 * row + 16 * (ch ^ ((((row >> 1) & 1) << 2) | (((row >> 2) & 1) << 1) | ((row >> 3) & 1)));
}
constexpr int AT_BT_OFF = 4 * AT<128>::TILE;

template <int DH> __device__ __forceinline__ void at_load(const bf16* __restrict__ Kg, const bf16* __restrict__ Vg, int ldk, int key0, int kmax, u4 (&kr)[AT<DH>::CPT], u4 (&vr)[AT<DH>::CPT], int tid) {
#pragma unroll
    for (int i = 0; i < AT<DH>::CPT; ++i) { const int cid = tid + 512 * i, key = cid / (DH / 8), cc = cid % (DH / 8); int row = key0 + key; row = row < kmax ? row : kmax;
        kr[i] = *(const u4*)(Kg + (size_t)row * ldk + cc * 8); vr[i] = *(const u4*)(Vg + (size_t)row * ldk + cc * 8); }
}
template <int DH> __device__ __forceinline__ void at_load_k(const bf16* __restrict__ Kg, int ldk, int key0, int kmax, u4 (&kr)[AT<DH>::CPT], int tid) {
#pragma unroll
    for (int i = 0; i < AT<DH>::CPT; ++i) { const int cid = tid + 512 * i, key = cid / (DH / 8), cc = cid % (DH / 8); int row = key0 + key; row = row < kmax ? row : kmax;
        kr[i] = *(const u4*)(Kg + (size_t)row * ldk + cc * 8); }
}
template <int DH> __device__ __forceinline__ void at_store_k(LAS unsigned char* Kl, const u4 (&kr)[AT<DH>::CPT], int tid) {
#pragma unroll
    for (int i = 0; i < AT<DH>::CPT; ++i) { const int cid = tid + 512 * i, key = cid / (DH / 8), cc = cid % (DH / 8); *(LAS u4*)(Kl + key * AT<DH>::PK + cc * 16) = kr[i]; }
}
template <int DH> __device__ __forceinline__ void at_store(LAS unsigned char* Kl, LAS unsigned char* Vl, const u4 (&kr)[AT<DH>::CPT], const u4 (&vr)[AT<DH>::CPT], int tid) {
#pragma unroll
    for (int i = 0; i < AT<DH>::CPT; ++i) { const int cid = tid + 512 * i, key = cid / (DH / 8), cc = cid % (DH / 8);
        *(LAS u4*)(Kl + key * AT<DH>::PK + cc * 16) = kr[i]; *(LAS u4*)(Vl + v_off<DH>(key, cc)) = vr[i]; }
}
template <int DH, int KB = AT<DH>::NKS> __device__ __forceinline__ void at_qk(const LAS unsigned char* Kl, const bf16x8 (&qf)[AT<DH>::NKS], f32x16 (&s)[2], int r, int h) {
#pragma unroll
    for (int kt = 0; kt < 2; ++kt) {
        f32x16 a0;
#pragma unroll
        for (int i = 0; i < 16; ++i) a0[i] = 0.f;
#pragma unroll
        for (int k0 = 0; k0 < AT<DH>::NKS; k0 += KB) {
            bf16x8 kf[KB];
#pragma unroll
            for (int ks = 0; ks < KB; ++ks) kf[ks] = *(const LAS bf16x8*)(Kl + (32 * kt + r) * AT<DH>::PK + (16 * (k0 + ks) + 8 * h) * 2);
            asm volatile("" ::: "memory");
#pragma unroll
            for (int ks = 0; ks < KB; ++ks) a0 = __builtin_amdgcn_mfma_f32_32x32x16_bf16(kf[ks], qf[k0 + ks], a0, 0, 0, 0);
        }
        s[kt] = a0; }
}
template <int POSMUL, int POSADD, int DMAX> __device__ __forceinline__ float at_mask(f32x16 (&s)[2], int key0, int kend, int t_row, bool rowsel, const LAS float* brow, float scale, int h) {
    float lm = -INFINITY;
#pragma unroll
    for (int kt = 0; kt < 2; ++kt)
#pragma unroll
        for (int i4 = 0; i4 < 16; i4 += 4) {
            float bv[4];
#pragma unroll
            for (int i = i4; i < i4 + 4; ++i) { const int key = key0 + 32 * kt + (i & 3) + 8 * (i >> 2) + 4 * h; const int d = t_row - (POSMUL * key + POSADD); const int dd = d < 0 ? 0 : (d > 127 ? 127 : d); bv[i - i4] = brow[dd]; }
            asm volatile("" ::: "memory");
#pragma unroll
            for (int i = i4; i < i4 + 4; ++i) { const int key = key0 + 32 * kt + (i & 3) + 8 * (i >> 2) + 4 * h; const int d = t_row - (POSMUL * key + POSADD);
                const bool valid = rowsel && key < kend && (unsigned)d < (unsigned)DMAX;
                const float v = valid ? s[kt][i] * scale + bv[i - i4] : -INFINITY; s[kt][i] = v; lm = fmaxf(lm, v); }
        }
    return lm;
}
template <int DH, int DB = ((DH == 128) ? 1 : 2)> __device__ __forceinline__ void at_pv(const LAS unsigned char* Vl, const f32x16 (&s)[2], f32x16 (&o)[AT<DH>::NDT], int lane) {
    bf16x8 pb[4];
#pragma unroll
    for (int kt = 0; kt < 2; ++kt)
#pragma unroll
        for (int s2 = 0; s2 < 2; ++s2) { u4 w; w.x = pg8::cvt_pk_bf16(s[kt][8 * s2 + 0], s[kt][8 * s2 + 1]); w.y = pg8::cvt_pk_bf16(s[kt][8 * s2 + 2], s[kt][8 * s2 + 3]);
            w.z = pg8::cvt_pk_bf16(s[kt][8 * s2 + 4], s[kt][8 * s2 + 5]); w.w = pg8::cvt_pk_bf16(s[kt][8 * s2 + 6], s[kt][8 * s2 + 7]); pb[2 * kt + s2] = __builtin_bit_cast(bf16x8, w); }
    const int i16 = lane & 15, q4 = i16 >> 2, p4 = i16 & 3, half = (lane >> 4) & 1, h = lane >> 5;
#pragma unroll
    for (int dp = 0; dp < AT<DH>::NDT; dp += DB) {
        v4i16_t lo[4 * DB], hi[4 * DB];
#pragma unroll
        for (int d2 = 0; d2 < DB; ++d2)
#pragma unroll
            for (int ks4 = 0; ks4 < 4; ++ks4) {
                const int row = 16 * ks4 + 4 * h + q4, ch = 4 * (dp + d2) + 2 * half + (p4 >> 1);
                lo[4 * d2 + ks4] = __builtin_amdgcn_ds_read_tr16_b64_v4i16((LAS v4i16_t*)(Vl + v_off<DH>(row, ch) + 8 * (p4 & 1)));
                hi[4 * d2 + ks4] = __builtin_amdgcn_ds_read_tr16_b64_v4i16((LAS v4i16_t*)(Vl + v_off<DH>(row + 8, ch) + 8 * (p4 & 1))); }
        if (DB == 2) asm volatile("s_waitcnt lgkmcnt(0)" : "+v"(lo[0]), "+v"(lo[1]), "+v"(lo[2]), "+v"(lo[3]), "+v"(lo[4 * (DB - 1)]), "+v"(lo[4 * (DB - 1) + 1]), "+v"(lo[4 * (DB - 1) + 2]), "+v"(lo[4 * (DB - 1) + 3]),
                                  "+v"(hi[0]), "+v"(hi[1]), "+v"(hi[2]), "+v"(hi[3]), "+v"(hi[4 * (DB - 1)]), "+v"(hi[4 * (DB - 1) + 1]), "+v"(hi[4 * (DB - 1) + 2]), "+v"(hi[4 * (DB - 1) + 3]) :: "memory");
        else asm volatile("s_waitcnt lgkmcnt(0)" : "+v"(lo[0]), "+v"(lo[1]), "+v"(lo[2]), "+v"(lo[3]), "+v"(hi[0]), "+v"(hi[1]), "+v"(hi[2]), "+v"(hi[3]) :: "memory");
#pragma unroll
        for (int ks4 = 0; ks4 < 4; ++ks4)
#pragma unroll
            for (int d2 = 0; d2 < DB; ++d2) { const v4i16_t l_ = lo[4 * d2 + ks4], h_ = hi[4 * d2 + ks4];
                const bf16x8 a = {l_[0], l_[1], l_[2], l_[3], h_[0], h_[1], h_[2], h_[3]};
                o[dp + d2] = __builtin_amdgcn_mfma_f32_32x32x16_bf16(a, pb[ks4], o[dp + d2], 0, 0, 0); }
#pragma unroll
        for (int d2 = 0; d2 < DB; ++d2) asm volatile("" : "+v"(o[dp + d2]) :: "memory");
    }
}
template <int DH> __device__ __forceinline__ void at_softmax(f32x16 (&s)[2], float lm, float& m_run, float& l_run, f32x16 (&o)[AT<DH>::NDT]) {
    lm = fmaxf(lm, __shfl_xor(lm, 32));
    const float mn = fmaxf(m_run, lm); const float ms = (mn == -INFINITY) ? 0.f : mn;
    const float alpha = __expf(m_run - ms); m_run = mn;
    float ps = 0.f;
#pragma unroll
    for (int kt = 0; kt < 2; ++kt)
#pragma unroll
        for (int i = 0; i < 16; ++i) { const float p = __expf(s[kt][i] - ms); s[kt][i] = p; ps += p; }
    l_run = l_run * alpha + ps;
#pragma unroll
    for (int dt = 0; dt < AT<DH>::NDT; ++dt)
#pragma unroll
        for (int i = 0; i < 16; ++i) o[dt][i] *= alpha;
}
__device__ __forceinline__ void at_load_bt(const unsigned char* ws, LAS unsigned char* lds, int tid) {
    const float* bt = (const float*)(ws + WS_BT); LAS float* d = (LAS float*)(lds + AT_BT_OFF);
    for (int i = tid; i < 1024; i += NTHR) d[i] = bt[i];
}

constexpr float LOG2E = 1.4426950408889634f;
__device__ __forceinline__ float dpp_quad_xor1(float v) { return __builtin_bit_cast(float, __builtin_amdgcn_update_dpp(0, __builtin_bit_cast(int, v), 0xB1, 0xf, 0xf, false)); }
__device__ __forceinline__ float dpp_quad_xor2(float v) { return __builtin_bit_cast(float, __builtin_amdgcn_update_dpp(0, __builtin_bit_cast(int, v), 0x4E, 0xf, 0xf, false)); }
__device__ __forceinline__ unsigned wave_max_u32(unsigned v) {
    v = max(v, (unsigned)__builtin_amdgcn_update_dpp(0, (int)v, 0x128, 0xf, 0xf, false));
    v = max(v, (unsigned)__builtin_amdgcn_update_dpp(0, (int)v, 0x124, 0xf, 0xf, false));
    v = max(v, (unsigned)__builtin_amdgcn_update_dpp(0, (int)v, 0x122, 0xf, 0xf, false));
    v = max(v, (unsigned)__builtin_amdgcn_update_dpp(0, (int)v, 0x121, 0xf, 0xf, false));
    const auto a = __builtin_amdgcn_permlane16_swap(v, v, false, false); v = max(a[0], a[1]);
    const auto b = __builtin_amdgcn_permlane32_swap(v, v, false, false); v = max(b[0], b[1]);
    return v; }
__device__ __forceinline__ float max_xor32(float v) { const auto rr = __builtin_amdgcn_permlane32_swap(__builtin_bit_cast(unsigned, v), __builtin_bit_cast(unsigned, v), false, false);
    return fmaxf(__builtin_bit_cast(float, rr[0]), __builtin_bit_cast(float, rr[1])); }
__device__ __forceinline__ float max_xor16(float v) { const auto rr = __builtin_amdgcn_permlane16_swap(__builtin_bit_cast(unsigned, v), __builtin_bit_cast(unsigned, v), false, false);
    return fmaxf(__builtin_bit_cast(float, rr[0]), __builtin_bit_cast(float, rr[1])); }
constexpr float AT_THR = 8.f;
__device__ __forceinline__ void at_load_bt2(const unsigned char* ws, LAS unsigned char* lds, int off, int tid) {
    const float* bt = (const float*)(ws + WS_BT); LAS float* d = (LAS float*)(lds + off);
    for (int i = tid; i < 1024; i += NTHR) d[i] = bt[i] * LOG2E;
}
template <int POSMUL, int POSADD, int DMAX> __device__ __forceinline__ float at_scores(f32x16 (&s)[2], bool fast, int key0, int kend, int t_row, bool rowsel, const LAS float* brow2, float c1, int h) {
    float lm = -INFINITY;
    if (fast) {
#pragma unroll
        for (int kt = 0; kt < 2; ++kt)
#pragma unroll
            for (int i = 0; i < 16; ++i) lm = fmaxf(lm, s[kt][i]);
        lm = rowsel ? fmaf(lm, c1, brow2[127]) : -INFINITY;
    } else {
#pragma unroll
        for (int kt = 0; kt < 2; ++kt)
#pragma unroll
            for (int i4 = 0; i4 < 16; i4 += 4) {
                float bv[4];
#pragma unroll
                for (int i = i4; i < i4 + 4; ++i) { const int key = key0 + 32 * kt + (i & 3) + 8 * (i >> 2) + 4 * h; const int d = t_row - (POSMUL * key + POSADD); const int dd = d < 0 ? 0 : (d > 127 ? 127 : d); bv[i - i4] = brow2[dd]; }
                asm volatile("" ::: "memory");
#pragma unroll
                for (int i = i4; i < i4 + 4; ++i) { const int key = key0 + 32 * kt + (i & 3) + 8 * (i >> 2) + 4 * h; const int d = t_row - (POSMUL * key + POSADD);
                    const bool valid = rowsel && key < kend && (unsigned)d < (unsigned)DMAX;
                    const float v = valid ? fmaf(s[kt][i], c1, bv[i - i4]) : -INFINITY; s[kt][i] = v; lm = fmaxf(lm, v); }
            }
    }
    return max_xor32(lm);
}
__device__ __forceinline__ float at_probs(f32x16 (&s)[2], bool fast, bool rowsel, float bfar2, float c1, float sub) {
    float ps = 0.f;
    if (fast) { const float bb = rowsel ? (bfar2 - sub) : -INFINITY;
#pragma unroll
        for (int kt = 0; kt < 2; ++kt)
#pragma unroll
            for (int i = 0; i < 16; ++i) { const float p = __builtin_amdgcn_exp2f(fmaf(s[kt][i], c1, bb)); s[kt][i] = p; ps += p; }
    } else {
#pragma unroll
        for (int kt = 0; kt < 2; ++kt)
#pragma unroll
            for (int i = 0; i < 16; ++i) { const float p = __builtin_amdgcn_exp2f(s[kt][i] - sub); s[kt][i] = p; ps += p; }
    }
    return ps;
}
template <int DH, int POSMUL, int POSADD, int DMAX, int DB = ((DH == 128) ? 1 : 2), int KB = AT<DH>::NKS>
__device__ __forceinline__ void at_step(const LAS unsigned char* Kl, const LAS unsigned char* Vl, const bf16x8 (&qf)[AT<DH>::NKS], f32x16 (&o)[AT<DH>::NDT], float& m_run, float& l_run,
                                        bool fast, int key0, int kend, int t_row, bool rowsel, const LAS float* brow2, float c1, int r, int h, int lane) {
    f32x16 s[2];
    at_qk<DH, KB>(Kl, qf, s, r, h);
    const float lm = at_scores<POSMUL, POSADD, DMAX>(s, fast, key0, kend, t_row, rowsel, brow2, c1, h);
    if (!__all(lm <= m_run + AT_THR)) {
        const float mn = fmaxf(m_run, lm); const float ms = (mn == -INFINITY) ? 0.f : mn;
        const float alpha = __builtin_amdgcn_exp2f(m_run - ms); m_run = mn; l_run *= alpha;
#pragma unroll
        for (int dt = 0; dt < AT<DH>::NDT; ++dt)
#pragma unroll
            for (int i = 0; i < 16; ++i) o[dt][i] *= alpha;
    }
    const float sub = (m_run == -INFINITY) ? 0.f : m_run;
    l_run += at_probs(s, fast, rowsel, brow2[127], c1, sub);
    at_pv<DH, DB>(Vl, s, o, lane);
}

__device__ __forceinline__ void l1_window_mfma(const Params& P, LAS unsigned char* lds, int tid, int lane, int wave, int wg, int G) {
    unsigned char* ws = P.ws; float* ocw = (float*)(ws + WS_OCW);
    constexpr int TILE = AT<128>::TILE;
    at_load_bt2(ws, lds, AT_BT_OFF, tid);
    const int r = lane & 31, h = lane >> 5;
    for (int unit = wg; unit < 512; unit += G) {
        const int g = unit & 1, c = unit >> 1, t0 = 64 * c;
        const int t_row = t0 + 8 * wave + (r >> 2), head = 4 * g + (r & 3);
        const bf16* Kg = l1_tensor(ws, 16 + g); const bf16* Vg = l1_tensor(ws, 18 + g);
        bf16x8 qf[8];
        { const bf16* qrow = l1_tensor(ws, head) + (size_t)t_row * 128 + 8 * h;
#pragma unroll
          for (int ks = 0; ks < 8; ++ks) qf[ks] = *(const bf16x8*)(qrow + 16 * ks); }
        const bf16 graw = l1_gate_raw(ws, t_row, head, 2);
        const LAS float* brow = (const LAS float*)(lds + AT_BT_OFF) + head * 128;
        f32x16 o[4];
#pragma unroll
        for (int dt = 0; dt < 4; ++dt)
#pragma unroll
            for (int i = 0; i < 16; ++i) o[dt][i] = 0.f;
        float m_run = -INFINITY, l_run = 0.f;
        const int jlo = c >= 8 ? c - 8 : 0;
        u4 kr[2], vr[2];
        at_load<128>(Kg, Vg, 128, 64 * jlo, T - 1, kr, vr, tid);
        __syncthreads();
        for (int j = jlo; j <= c; ++j) {
            LAS unsigned char* Kl = lds + ((j - jlo) & 1) * 2 * TILE; LAS unsigned char* Vl = Kl + TILE;
            at_store<128>(Kl, Vl, kr, vr, tid);
            __syncthreads();
            if (j < c) at_load<128>(Kg, Vg, 128, 64 * (j + 1), T - 1, kr, vr, tid);
            const int dmin = t0 + 8 * wave - (64 * j + 63), dmax = t0 + 8 * wave + 7 - 64 * j;
            at_step<128, 1, 0, 512, 2>(Kl, Vl, qf, o, m_run, l_run, dmin >= 113 && dmax < 512, 64 * j, T, t_row, true, brow, SCALE_C * LOG2E, r, h, lane);
        }
        const float lt = l_run + __shfl_xor(l_run, 32);
        const float f = sigmoidf_(bf2f(graw)) / fmaxf(lt, 1e-30f);
        float* orow = ocw + (size_t)t_row * 1024 + head * 128 + 4 * h;
#pragma unroll
        for (int dt = 0; dt < 4; ++dt)
#pragma unroll
            for (int gq = 0; gq < 4; ++gq)
                *(float4*)(orow + 32 * dt + 8 * gq) = make_float4(o[dt][4 * gq] * f, o[dt][4 * gq + 1] * f, o[dt][4 * gq + 2] * f, o[dt][4 * gq + 3] * f);
    }
}

__device__ __forceinline__ void l1_sel_mfma(const Params& P, LAS unsigned char* lds, int tid, int lane, int wave, int wg, int G) {
    unsigned char* ws = P.ws; const float* ocw = (const float*)(ws + WS_OCW); const unsigned* selmask = (const unsigned*)(ws + WS_SELMASK);
    bf16* attnout = (bf16*)(ws + WS_XN);
    constexpr int TILE = AT<128>::TILE;
    LAS unsigned* selm = (LAS unsigned*)(lds + AT_BT_OFF + 4096);
    at_load_bt2(ws, lds, AT_BT_OFF, tid);
    const int r = lane & 31, h = lane >> 5;
    for (int u = wg; u < 512; u += G) {
        const int g = u & 1, k = u >> 1, c = k < 128 ? k : 383 - k, t0 = 64 * c;
        const int ql = 8 * wave + (r >> 2), t_row = t0 + ql, head = 4 * g + (r & 3);
        const bf16* Kg = l1_tensor(ws, 12 + g); const bf16* Vg = l1_tensor(ws, 14 + g);
        bf16x8 qf[8];
        { const bf16* qrow = l1_tensor(ws, head) + (size_t)t_row * 128 + 8 * h;
#pragma unroll
          for (int ks = 0; ks < 8; ++ks) qf[ks] = *(const bf16x8*)(qrow + 16 * ks); }
        const LAS float* brow = (const LAS float*)(lds + AT_BT_OFF) + head * 128;
        f32x16 o[4];
#pragma unroll
        for (int dt = 0; dt < 4; ++dt)
#pragma unroll
            for (int i = 0; i < 16; ++i) o[dt][i] = 0.f;
        float m_run = -INFINITY, l_run = 0.f;
        u4 kra[2], vra[2], krb[2], vrb[2];
        at_load<128>(Kg, Vg, 128, 0, T - 1, kra, vra, tid);
        if (c >= 1) at_load<128>(Kg, Vg, 128, 64, T - 1, krb, vrb, tid);
        __syncthreads();
        selm[tid] = selmask[((size_t)(t0 + (tid >> 3)) * 2 + g) * 8 + (tid & 7)];
#define SEL_STEP(KR, VR, BUF, J) do { const int j_ = (J); LAS unsigned char* Kl = lds + (BUF) * 2 * TILE; LAS unsigned char* Vl = Kl + TILE; \
            at_store<128>(Kl, Vl, KR, VR, tid); __syncthreads(); \
            if (j_ + 2 <= c) at_load<128>(Kg, Vg, 128, 64 * (j_ + 2), T - 1, KR, VR, tid); \
            const bool rowsel = (selm[ql * 8 + (j_ >> 5)] >> (j_ & 31)) & 1u; \
            if (__any(rowsel)) at_step<128, 1, 0, 0x7fffffff>(Kl, Vl, qf, o, m_run, l_run, t0 + 8 * wave - (64 * j_ + 63) >= 113, 64 * j_, T, t_row, rowsel, brow, SCALE_C * LOG2E, r, h, lane); } while (0)
        for (int j = 0; j <= c; j += 2) {
            SEL_STEP(kra, vra, 0, j);
            if (j + 1 <= c) SEL_STEP(krb, vrb, 1, j + 1);
        }
#undef SEL_STEP
        const float lt = l_run + __shfl_xor(l_run, 32);
        const float f = l1_gate(ws, t_row, head, 1) / fmaxf(lt, 1e-30f);
        const size_t ob = (size_t)t_row * 1024 + head * 128 + 4 * h;
#pragma unroll
        for (int dt = 0; dt < 4; ++dt)
#pragma unroll
            for (int gq = 0; gq < 4; ++gq) { const float4 b = *(const float4*)(ocw + ob + 32 * dt + 8 * gq);
                uint2 w; w.x = pk2(b.x + o[dt][4 * gq] * f, b.y + o[dt][4 * gq + 1] * f); w.y = pk2(b.z + o[dt][4 * gq + 2] * f, b.w + o[dt][4 * gq + 3] * f);
                *(uint2*)(attnout + ob + 32 * dt + 8 * gq) = w; }
    }
}

#define MOBA_INSERT(v_, idx_) do { const float v__ = (v_); const int x__ = (idx_); \
    const bool g0 = v__ > b0 || (v__ == b0 && x__ < i0), g1 = v__ > b1 || (v__ == b1 && x__ < i1), g2 = v__ > b2 || (v__ == b2 && x__ < i2); \
    const float nb2 = g1 ? b1 : (g2 ? v__ : b2); const int ni2 = g1 ? i1 : (g2 ? x__ : i2); \
    const float nb1 = g0 ? b0 : (g1 ? v__ : b1); const int ni1 = g0 ? i0 : (g1 ? x__ : i1); \
    const float nb0 = g0 ? v__ : b0; const int ni0 = g0 ? x__ : i0; \
    b0 = nb0; b1 = nb1; b2 = nb2; i0 = ni0; i1 = ni1; i2 = ni2; } while (0)
__device__ __forceinline__ void l0_moba_mfma(const Params& P, LAS unsigned char* lds, int tid, int lane, int wave, int wg, int G) {
    unsigned char* ws = P.ws; const bf16* proj = (const bf16*)(ws + WS_PROJ); bf16* attnout = (bf16*)(ws + WS_XN);
    const float* kmean = (const float*)(ws + WS_KMEAN);
    constexpr int TILE = AT<64>::TILE;
    LAS float* kml = (LAS float*)(lds + 81920);
    LAS unsigned* uni = (LAS unsigned*)(lds + 98304);
    at_load_bt2(ws, lds, AT_BT_OFF, tid);
    const int r = lane & 31, h = lane >> 5;
    for (int u = wg; u < 512; u += G) {
        const int head = u & 7, k = u >> 3, ob = k < 32 ? k : 95 - k, t0 = 256 * ob;
        const int t_row = t0 + 32 * wave + r;
        const bf16* Kg = proj + (size_t)1 * T * 512 + 64 * head; const bf16* Vg = proj + (size_t)2 * T * 512 + 64 * head;
        const bf16* qrow = proj + (size_t)t_row * 512 + 64 * head;
        __syncthreads();
        for (int i = tid; i < 64 * 64; i += NTHR) kml[i] = kmean[(size_t)head * 4096 + i];
        __syncthreads();
        unsigned mlo = 0u, mhi = 0u;
        {
            float qv[64];
#pragma unroll
            for (int i = 0; i < 8; ++i) { const u4 w = ((const u4*)qrow)[i]; qv[8 * i] = bflo(w.x); qv[8 * i + 1] = bfhi(w.x); qv[8 * i + 2] = bflo(w.y); qv[8 * i + 3] = bfhi(w.y);
                qv[8 * i + 4] = bflo(w.z); qv[8 * i + 5] = bfhi(w.z); qv[8 * i + 6] = bflo(w.w); qv[8 * i + 7] = bfhi(w.w); }
            float b0 = -INFINITY, b1 = -INFINITY, b2 = -INFINITY; int i0 = 0x7fffffff, i1 = 0x7fffffff, i2 = 0x7fffffff;
            for (int j = h; j < ob; j += 2) { const LAS f4* km = (const LAS f4*)(kml + j * 64); float sc = 0.f;
#pragma unroll
                for (int d4 = 0; d4 < 16; ++d4) { const f4 kv = km[d4]; sc += (kv.x * qv[4 * d4] + kv.y * qv[4 * d4 + 1]) + (kv.z * qv[4 * d4 + 2] + kv.w * qv[4 * d4 + 3]); }
                MOBA_INSERT(sc, j); }
            const float p0 = __shfl_xor(b0, 32), p1 = __shfl_xor(b1, 32), p2 = __shfl_xor(b2, 32); const int j0 = __shfl_xor(i0, 32), j1 = __shfl_xor(i1, 32), j2 = __shfl_xor(i2, 32);
            MOBA_INSERT(p0, j0); MOBA_INSERT(p1, j1); MOBA_INSERT(p2, j2);
            if (b0 > -INFINITY) { if (i0 < 32) mlo |= 1u << i0; else mhi |= 1u << (i0 - 32); }
            if (b1 > -INFINITY) { if (i1 < 32) mlo |= 1u << i1; else mhi |= 1u << (i1 - 32); }
            if (b2 > -INFINITY) { if (i2 < 32) mlo |= 1u << i2; else mhi |= 1u << (i2 - 32); }
        }
        {
            unsigned ulo = mlo, uhi = mhi;
#pragma unroll
            for (int o = 1; o < 64; o <<= 1) { ulo |= __shfl_xor(ulo, o); uhi |= __shfl_xor(uhi, o); }
            if (lane == 0) { uni[2 * wave] = ulo; uni[2 * wave + 1] = uhi; }
        }
        __syncthreads();
        unsigned long long un = 0ull;
#pragma unroll
        for (int w = 0; w < 8; ++w) un |= (unsigned long long)uni[2 * w] | ((unsigned long long)uni[2 * w + 1] << 32);
        un = ((unsigned long long)__builtin_amdgcn_readfirstlane((unsigned)(un >> 32)) << 32) | (unsigned long long)__builtin_amdgcn_readfirstlane((unsigned)un);
        un |= 1ull << ob;
        bf16x8 qf[4];
#pragma unroll
        for (int ks = 0; ks < 4; ++ks) qf[ks] = *(const bf16x8*)(qrow + 16 * ks + 8 * h);
        const LAS float* brow = (const LAS float*)(lds + AT_BT_OFF) + head * 128;
        f32x16 o[2];
#pragma unroll
        for (int dt = 0; dt < 2; ++dt)
#pragma unroll
            for (int i = 0; i < 16; ++i) o[dt][i] = 0.f;
        float m_run = -INFINITY, l_run = 0.f;
        LAS int* tl = (LAS int*)(lds + 98304 + 64);
        if (tid < 64 && ((un >> tid) & 1ull)) { const int pos = __builtin_popcountll(un & ((1ull << tid) - 1ull));
#pragma unroll
            for (int tt = 0; tt < 4; ++tt) tl[4 * pos + tt] = 256 * tid + 64 * tt; }
        const int nt = 4 * __builtin_popcountll(un);
        __syncthreads();
        u4 kra[1], vra[1], krb[1], vrb[1];
        at_load<64>(Kg, Vg, 512, tl[0], T - 1, kra, vra, tid);
        at_load<64>(Kg, Vg, 512, tl[1], T - 1, krb, vrb, tid);
#define MOBA_STEP(KR, VR, BUF, I) do { const int i_ = (I); LAS unsigned char* Kl = lds + (BUF) * 2 * TILE; LAS unsigned char* Vl = Kl + TILE; \
            at_store<64>(Kl, Vl, KR, VR, tid); __syncthreads(); \
            if (i_ + 2 < nt) at_load<64>(Kg, Vg, 512, tl[i_ + 2], T - 1, KR, VR, tid); \
            const int key0 = tl[i_], j = key0 >> 8, tt = (key0 >> 6) & 3; const bool own = (j == ob); \
            const bool rowsel = own ? true : (bool)(((j < 32 ? mlo >> j : mhi >> (j - 32)) & 1u) != 0u); \
            const bool wave_on = own ? (32 * wave + 31 >= 64 * tt) : (__any(rowsel) != 0); \
            if (wave_on) at_step<64, 1, 0, 0x7fffffff>(Kl, Vl, qf, o, m_run, l_run, t0 + 32 * wave - (key0 + 63) >= 113, key0, T, t_row, rowsel, brow, 0.125f * LOG2E, r, h, lane); } while (0)
        for (int i = 0; i < nt; i += 2) { MOBA_STEP(kra, vra, 0, i); MOBA_STEP(krb, vrb, 1, i + 1); }
#undef MOBA_STEP
        const float lt = l_run + __shfl_xor(l_run, 32);
        const float f = 1.f / fmaxf(lt, 1e-30f);
        bf16* orow = attnout + (size_t)t_row * 1024 + 64 * head + 4 * h;
#pragma unroll
        for (int dt = 0; dt < 2; ++dt)
#pragma unroll
            for (int gq = 0; gq < 4; ++gq) { uint2 w; w.x = pk2(o[dt][4 * gq] * f, o[dt][4 * gq + 1] * f); w.y = pk2(o[dt][4 * gq + 2] * f, o[dt][4 * gq + 3] * f);
                *(uint2*)(orow + 32 * dt + 8 * gq) = w; }
    }
}

__device__ __forceinline__ void l1_cmp_mfma(const Params& P, LAS unsigned char* lds, int tid, int lane, int wave, int wg, int G) {
    unsigned char* ws = P.ws; float* ocw = (float*)(ws + WS_OCW); unsigned* selmask = (unsigned*)(ws + WS_SELMASK);
    constexpr int TILE = AT<128>::TILE, BT_OFF = 2 * TILE, IMP_OFF = BT_OFF + 4096;
    LAS float* imp = (LAS float*)(lds + IMP_OFF);
    at_load_bt2(ws, lds, BT_OFF, tid);
    const int r = lane & 31, h = lane >> 5;
    const float c1 = SCALE_C * LOG2E;
    LAS unsigned char* Kl = lds; LAS unsigned char* Vl = lds + TILE;
    for (int u = wg; u < 512; u += G) {
        const int g = u & 1, k = u >> 1, c = k < 128 ? k : 383 - k, t0 = 64 * c;
        const int ql = 8 * wave + (r >> 2), t_row = t0 + ql, head = 4 * g + (r & 3);
        const bf16* Kg = (const bf16*)(ws + WS_KCMP) + (size_t)(0 * 2 + g) * 1024 * 128; const bf16* Vg = (const bf16*)(ws + WS_KCMP) + (size_t)(1 * 2 + g) * 1024 * 128;
        const int NV = (4 * c + 3) < 1023 ? (4 * c + 3) : 1023, ntiles = (NV + 63) >> 6;
        bf16x8 qf[8];
        { const bf16* qrow = l1_tensor(ws, head) + (size_t)t_row * 128 + 8 * h;
#pragma unroll
          for (int ks = 0; ks < 8; ++ks) qf[ks] = *(const bf16x8*)(qrow + 16 * ks); }
        const LAS float* brow = (const LAS float*)(lds + BT_OFF) + head * 128;
        float m_run = -INFINITY, l_run = 0.f;
        u4 kr[2], vr[2];
        at_load_k<128>(Kg, 128, 0, 1022, kr, tid);
#pragma unroll 1
        for (int tl = 0; tl < ntiles; ++tl) {
            __syncthreads();
            at_store_k<128>(Kl, kr, tid);
            __syncthreads();
            if (tl + 1 < ntiles) at_load_k<128>(Kg, 128, 64 * (tl + 1), 1022, kr, tid);
            f32x16 s[2];
            at_qk<128, 4>(Kl, qf, s, r, h);
            const bool fast = (64 * tl + 63 < NV) && (t0 + 8 * wave - (16 * (64 * tl + 63) + 31) >= 113);
            const float lm = at_scores<16, 31, 0x7fffffff>(s, fast, 64 * tl, NV, t_row, true, brow, c1, h);
            if (!__all(lm <= m_run + AT_THR)) { const float mn = fmaxf(m_run, lm); const float ms = (mn == -INFINITY) ? 0.f : mn; l_run *= __builtin_amdgcn_exp2f(m_run - ms); m_run = mn; }
            l_run += at_probs(s, fast, true, brow[127], c1, (m_run == -INFINITY) ? 0.f : m_run);
        }
        at_load<128>(Kg, Vg, 128, 0, 1022, kr, vr, tid);
        const float ltot = fmaxf(l_run + __shfl_xor(l_run, 32), 1e-30f);
        const float sub2 = ((m_run == -INFINITY) ? 0.f : m_run) + __builtin_amdgcn_logf(ltot);
        f32x16 o[4];
#pragma unroll
        for (int dt = 0; dt < 4; ++dt)
#pragma unroll
            for (int i = 0; i < 16; ++i) o[dt][i] = 0.f;
        float y_prev = 0.f;
#pragma unroll 1
        for (int tl = 0; tl < ntiles; ++tl) {
            __syncthreads();
            at_store<128>(Kl, Vl, kr, vr, tid);
            __syncthreads();
            if (tl + 1 < ntiles) at_load<128>(Kg, Vg, 128, 64 * (tl + 1), 1022, kr, vr, tid);
            f32x16 s[2];
            {
                int zoff = 0; asm volatile("" : "+v"(zoff));
                const bf16* qrow2 = l1_tensor(ws, head) + (size_t)t_row * 128 + 8 * h + zoff; bf16x8 qf2[8];
#pragma unroll
                for (int ks = 0; ks < 8; ++ks) qf2[ks] = *(const bf16x8*)(qrow2 + 16 * ks);
                at_qk<128, 4>(Kl, qf2, s, r, h);
            }
            const bool fast = (64 * tl + 63 < NV) && (t0 + 8 * wave - (16 * (64 * tl + 63) + 31) >= 113);
            (void)at_scores<16, 31, 0x7fffffff>(s, fast, 64 * tl, NV, t_row, true, brow, c1, h);
            (void)at_probs(s, fast, true, brow[127], c1, sub2);
#pragma unroll
            for (int idx = 0; idx < 8; ++idx) { const int kt = idx >> 2, gq = idx & 3;
                float g4 = (s[kt][4 * gq] + s[kt][4 * gq + 1]) + (s[kt][4 * gq + 2] + s[kt][4 * gq + 3]); float la = s[kt][4 * gq + 3];
                g4 += dpp_quad_xor1(g4); g4 += dpp_quad_xor2(g4); la += dpp_quad_xor1(la); la += dpp_quad_xor2(la);
                const auto sw = __builtin_amdgcn_permlane32_swap(__builtin_bit_cast(unsigned, la), __builtin_bit_cast(unsigned, la), false, false);
                const float y_cur = __builtin_bit_cast(float, h ? sw[0] : sw[1]);
                const float v = g4 + (h ? y_cur : y_prev); y_prev = y_cur;
                if ((r & 3) == 0) imp[ql * 256 + 16 * tl + 2 * idx + h] = v; }
            at_pv<128>(Vl, s, o, lane);
        }
        {
            const float f = l1_gate(ws, t_row, head, 0);
            float* orow = ocw + (size_t)t_row * 1024 + head * 128 + 4 * h;
#pragma unroll
            for (int dt = 0; dt < 4; ++dt)
#pragma unroll
                for (int gq = 0; gq < 4; ++gq) { float4 b = *(float4*)(orow + 32 * dt + 8 * gq);
                    b.x += o[dt][4 * gq] * f; b.y += o[dt][4 * gq + 1] * f; b.z += o[dt][4 * gq + 2] * f; b.w += o[dt][4 * gq + 3] * f; *(float4*)(orow + 32 * dt + 8 * gq) = b; }
        }
        __syncthreads();
        const int nsel = (c + 1) < 16 ? (c + 1) : 16;
#pragma unroll 1
        for (int qi = 0; qi < 8; ++qi) {
            const int q = 8 * wave + qi, t = t0 + q;
            unsigned key[4];
#pragma unroll
            for (int i = 0; i < 4; ++i) { const int j = lane + 64 * i; float v = imp[q * 256 + j];
                if (j == 0 || j == c || j == c - 1) v += 1e4f;
                key[i] = (j <= c) ? ((__builtin_bit_cast(unsigned, v) & 0xFFFFFF00u) | (unsigned)(255 - j)) : 0u; }
            unsigned mk[4] = {0u, 0u, 0u, 0u};
            for (int rr = 0; rr < nsel; ++rr) {
                const unsigned m = wave_max_u32(max(max(key[0], key[1]), max(key[2], key[3])));
#pragma unroll
                for (int i = 0; i < 4; ++i) if (m != 0u && key[i] == m) { key[i] = 0u; mk[i] = 1u; }
            }
#pragma unroll
            for (int i = 0; i < 4; ++i) { const unsigned long long bal = __ballot(mk[i] != 0u);
                if (lane == 0) { selmask[((size_t)t * 2 + g) * 8 + 2 * i] = (unsigned)bal; selmask[((size_t)t * 2 + g) * 8 + 2 * i + 1] = (unsigned)(bal >> 32); } }
        }
    }
}

struct EpiF32P {
    static constexpr bool PERM = false, AFTER_DRAIN = false;
    float* C; int ldc;
    __device__ __forceinline__ void operator()(const pg8::f32x4 (&acc)[2][2][4][2], const pg8::Unit& u, int wr, int wc, int fr, int fq) const {
        const int row0 = u.pm * 256 + wr * 64 + fr, col0 = u.pn * 256 + wc * 32 + 4 * fq;
#pragma unroll
        for (int ai = 0; ai < 2; ++ai)
#pragma unroll
            for (int m = 0; m < 4; ++m) { float* rowp = C + (size_t)(row0 + ai * 128 + m * 16) * ldc + col0;
#pragma unroll
                for (int bj = 0; bj < 2; ++bj)
#pragma unroll
                    for (int n = 0; n < 2; ++n) *(pg8::f32x4*)(rowp + bj * 128 + n * 16) = acc[ai][bj][m][n]; }
    }
};
struct OneUnit { int pm;
    __device__ __forceinline__ bool next(int i, pg8::Unit& u) const { if (i) return false; u.pm = pm; u.pn = 0; return true; }
    __device__ __forceinline__ void a_ready(const pg8::Unit&) const {}
    __device__ __forceinline__ void done(const pg8::Unit&) const {}
};
__device__ __forceinline__ void l1_compress_gemm(const Params& P, LAS unsigned char* lds, int tid, int wg) {
    unsigned char* ws = P.ws;
    if (wg < 64) {
        const int prob = wg >> 2, pm = wg & 3, kv = prob >> 3, g = (prob >> 2) & 1, sp = prob & 3;
        pg8::Gemm gm{l1_tensor(ws, (kv ? 10 : 8) + g) + sp * 1024, (const bf16*)(ws + (kv ? WS_CW1V : WS_CW1K)) + sp * 1024, 1024, 256, 1024, 2048, 4096};
        OneUnit S{pm}; EpiF32P E{(float*)(ws + WS_CPART) + (size_t)((sp * 2 + kv) * 2 + g) * 1024 * 256, 256};
        pg8::gemm_phase<EpiF32P, OneUnit, true, true>((PG8_LAS unsigned char*)lds, gm, S, E);
    } else if (wg < 96) {
        const int tq = wg - 64, kv = tq >> 4, l = 2 * (tq & 15) + (tid >> 8), j = tid & 255;
        const float* pos = P.in[kv ? I_POSV : I_POSK] + l * 128; const float* w1 = P.in[kv ? I_V1 : I_K1] + (size_t)l * 128 * 256 + j; float s = 0.f;
#pragma unroll 8
        for (int d = 0; d < 128; ++d) s += pos[d] * w1[(size_t)d * 256];
        ((float*)(ws + WS_POSP))[(kv * 32 + l) * 256 + j] = s;
    }
}
__device__ __forceinline__ void l1_compress_out(const Params& P, LAS unsigned char* lds, int tid, int wg, int G) {
    unsigned char* ws = P.ws; const float* part = (const float*)(ws + WS_CPART); const float* posp = (const float*)(ws + WS_POSP); bf16* kc = (bf16*)(ws + WS_KCMP);
    LAS float* pb = (LAS float*)lds; LAS float* hs = (LAS float*)(lds + 1024);
    for (int task = wg; task < 256; task += G) {
        const int kv = task >> 7, g = (task >> 6) & 1, n0 = (task & 63) * 16;
        __syncthreads();
        if (tid < 256) { float s = 0.f;
#pragma unroll 8
            for (int l = 0; l < 32; ++l) s += posp[(kv * 32 + l) * 256 + tid]; pb[tid] = s; }
        __syncthreads();
#pragma unroll
        for (int i = 0; i < 8; ++i) { const int e = tid + 512 * i, row = e >> 8, j = e & 255; float s = pb[j];
#pragma unroll
            for (int sp = 0; sp < 4; ++sp) s += part[((size_t)((sp * 2 + kv) * 2 + g) * 1024 + n0 + row) * 256 + j];
            hs[e] = gelu_tanh(s); }
        __syncthreads();
        const int d = tid & 127, rq = tid >> 7; const float* w2 = P.in[kv ? I_V2 : I_K2] + d; float acc[4] = {0.f, 0.f, 0.f, 0.f};
        for (int j = 0; j < 256; ++j) { const float w = w2[(size_t)j * 128];
#pragma unroll
            for (int i = 0; i < 4; ++i) acc[i] += hs[(rq + 4 * i) * 256 + j] * w; }
#pragma unroll
        for (int i = 0; i < 4; ++i) { const int n = n0 + rq + 4 * i; if (n < 1023) kc[((size_t)(kv * 2 + g) * 1024 + n) * 128 + d] = (bf16)f2bf(acc[i]); }
    }
}

__device__ __forceinline__ void l0_route(const Params& P, LAS unsigned char* lds, int tid, int lane, int wave, int wg, int G) {
    unsigned char* ws = P.ws; const bf16* proj = (const bf16*)(ws + WS_PROJ); const float* kmean = (const float*)(ws + WS_KMEAN);
    unsigned long long* selq = (unsigned long long*)(ws + WS_SELQ); unsigned* selT = (unsigned*)(ws + WS_SELT);
    LAS float* kml = (LAS float*)lds;
    const int r = lane & 31, h = lane >> 5;
    for (int u = wg; u < 512; u += G) {
        const int head = u & 7, k = u >> 3, ob = k < 32 ? k : 95 - k, t_row = 256 * ob + 32 * wave + r;
        const bf16* qrow = proj + (size_t)t_row * 512 + 64 * head;
        __syncthreads();
        for (int i = tid; i < 64 * 64; i += NTHR) kml[i] = kmean[(size_t)head * 4096 + i];
        __syncthreads();
        unsigned mlo = 0u, mhi = 0u;
        float qv[64];
#pragma unroll
        for (int i = 0; i < 8; ++i) { const u4 w = ((const u4*)qrow)[i]; qv[8 * i] = bflo(w.x); qv[8 * i + 1] = bfhi(w.x); qv[8 * i + 2] = bflo(w.y); qv[8 * i + 3] = bfhi(w.y);
            qv[8 * i + 4] = bflo(w.z); qv[8 * i + 5] = bfhi(w.z); qv[8 * i + 6] = bflo(w.w); qv[8 * i + 7] = bfhi(w.w); }
        float b0 = -INFINITY, b1 = -INFINITY, b2 = -INFINITY; int i0 = 0x7fffffff, i1 = 0x7fffffff, i2 = 0x7fffffff;
        for (int j = h; j < ob; j += 2) { const LAS f4* km = (const LAS f4*)(kml + j * 64); float sc = 0.f;
#pragma unroll
            for (int d4 = 0; d4 < 16; ++d4) { const f4 kv = km[d4]; sc += (kv.x * qv[4 * d4] + kv.y * qv[4 * d4 + 1]) + (kv.z * qv[4 * d4 + 2] + kv.w * qv[4 * d4 + 3]); }
            MOBA_INSERT(sc, j); }
        const float p0 = __shfl_xor(b0, 32), p1 = __shfl_xor(b1, 32), p2 = __shfl_xor(b2, 32); const int j0 = __shfl_xor(i0, 32), j1 = __shfl_xor(i1, 32), j2 = __shfl_xor(i2, 32);
        MOBA_INSERT(p0, j0); MOBA_INSERT(p1, j1); MOBA_INSERT(p2, j2);
        if (b0 > -INFINITY) { if (i0 < 32) mlo |= 1u << i0; else mhi |= 1u << (i0 - 32); }
        if (b1 > -INFINITY) { if (i1 < 32) mlo |= 1u << i1; else mhi |= 1u << (i1 - 32); }
        if (b2 > -INFINITY) { if (i2 < 32) mlo |= 1u << i2; else mhi |= 1u << (i2 - 32); }
        if (h == 0) selq[(size_t)t_row * 8 + head] = ((unsigned long long)mhi << 32) | (unsigned long long)mlo;
        for (int j = 0; j < ob; ++j) { const unsigned bit = ((j < 32 ? mlo >> j : mhi >> (j - 32)) & 1u); const unsigned long long bal = __ballot(bit != 0u);
            if (lane == 0) selT[((size_t)(head * 64 + j) * 64 + ob) * 8 + wave] = (unsigned)bal; }
    }
}
__device__ __forceinline__ void moba_write_partial(unsigned char* ws, const f32x16 (&o)[2], float m_run, float l_run, int tq, int head, int slot, bool valid_row, int h) {
    const float lt = l_run + __shfl_xor(l_run, 32); const float inv = 1.f / fmaxf(lt, 1e-30f);
    if (valid_row) { const size_t rec = ((size_t)tq * 8 + head) * 4 + slot; bf16* po = (bf16*)(ws + WS_PO) + rec * 64 + 4 * h;
#pragma unroll
        for (int dt = 0; dt < 2; ++dt)
#pragma unroll
            for (int gq = 0; gq < 4; ++gq) { uint2 w; w.x = pk2(o[dt][4 * gq] * inv, o[dt][4 * gq + 1] * inv); w.y = pk2(o[dt][4 * gq + 2] * inv, o[dt][4 * gq + 3] * inv);
                *(uint2*)(po + 32 * dt + 8 * gq) = w; }
        if (h == 0) ((float2*)(ws + WS_PML))[rec] = make_float2(m_run, lt); }
}
constexpr int MOBA_NB = 8 * (15 + 31 + 47 + 63);
constexpr int MOBA_NU = MOBA_NB + 512;
__device__ __forceinline__ void l0_moba_gather(const Params& P, LAS unsigned char* lds, int tid, int lane, int wave, int wg, int G) {
    unsigned char* ws = P.ws; const bf16* proj = (const bf16*)(ws + WS_PROJ);
    const unsigned long long* selq = (const unsigned long long*)(ws + WS_SELQ); const unsigned* selT = (const unsigned*)(ws + WS_SELT);
    unsigned* queue = (unsigned*)(ws + WS_CTL) + CW_QUEUE;
    constexpr int TILE = AT<64>::TILE, BTO = 8 * TILE;
    LAS int* rows = (LAS int*)(lds + BTO + 4096);
    LAS unsigned* wsum = (LAS unsigned*)(lds + BTO + 4096 + 16384);
    at_load_bt2(ws, lds, BTO, tid);
    const int r = lane & 31, h = lane >> 5;
    const float c1 = 0.125f * LOG2E;
    int unit = wg, it = 0;
    while (unit < MOBA_NU) {
        if (tid == 0) wsum[16 + (it & 1)] = __hip_atomic_fetch_add(queue, 1u, __ATOMIC_RELAXED, __HIP_MEMORY_SCOPE_AGENT) + (unsigned)G;
        __syncthreads();
        if (unit < MOBA_NB) {
            int rg, rem; if (unit < 120) { rg = 0; rem = unit; } else if (unit < 368) { rg = 1; rem = unit - 120; } else if (unit < 744) { rg = 2; rem = unit - 368; } else { rg = 3; rem = unit - 744; }
            const int head = rem & 7, j = rem >> 3;
            const bf16* Kg = proj + (size_t)1 * T * 512 + 64 * head; const bf16* Vg = proj + (size_t)2 * T * 512 + 64 * head;
            const LAS float* brow = (const LAS float*)(lds + BTO) + head * 128;
            const int ob = 16 * rg + (tid >> 5), word = (tid & 31) >> 2, sh = 8 * (tid & 3);
            unsigned bits = (ob > j && ob <= 63) ? ((selT[((size_t)(head * 64 + j) * 64 + ob) * 8 + word] >> sh) & 0xffu) : 0u;
#pragma unroll
            for (int tt = 0; tt < 4; ++tt) { u4 kr[1], vr[1]; at_load<64>(Kg, Vg, 512, 256 * j + 64 * tt, T - 1, kr, vr, tid); at_store<64>(lds + tt * TILE, lds + (4 + tt) * TILE, kr, vr, tid); }
            const int cnt = __builtin_popcount(bits); int incl = cnt;
#pragma unroll
            for (int o_ = 1; o_ < 64; o_ <<= 1) { const int v = __shfl_up(incl, o_); if (lane >= o_) incl += v; }
            if (lane == 63) wsum[wave] = (unsigned)incl;
            __syncthreads();
            int base = 0, n = 0;
#pragma unroll
            for (int w = 0; w < 8; ++w) { const int x = (int)wsum[w]; if (w < wave) base += x; n += x; }
            int pos = base + incl - cnt;
            while (bits) { const int b = __builtin_ctz(bits); bits &= bits - 1u; rows[pos++] = 256 * ob + 8 * (tid & 31) + b; }
            __syncthreads();
            const int ntile = (n + 31) >> 5;
            for (int tile = wave; tile < ntile; tile += NWAVES) {
                const int idx = 32 * tile + r; const bool valid_row = idx < n; const int tq = rows[valid_row ? idx : (n - 1)];
                const int tmin = __builtin_amdgcn_readfirstlane(rows[32 * tile]);
                const bf16* qrow = proj + (size_t)tq * 512 + 64 * head;
                bf16x8 qf[4];
#pragma unroll
                for (int ks = 0; ks < 4; ++ks) qf[ks] = *(const bf16x8*)(qrow + 16 * ks + 8 * h);
                const unsigned long long sq = selq[(size_t)tq * 8 + head];
                f32x16 o[2];
#pragma unroll
                for (int dt = 0; dt < 2; ++dt)
#pragma unroll
                    for (int i = 0; i < 16; ++i) o[dt][i] = 0.f;
                float m_run = -INFINITY, l_run = 0.f;
#pragma unroll 1
                for (int tt = 0; tt < 4; ++tt) { const int key0 = 256 * j + 64 * tt;
                    at_step<64, 1, 0, 0x7fffffff>(lds + tt * TILE, lds + (4 + tt) * TILE, qf, o, m_run, l_run, tmin - (key0 + 63) >= 113, key0, T, tq, true, brow, c1, r, h, lane); }
                const int slot = __builtin_popcountll(sq & ((1ull << j) - 1ull));
                moba_write_partial(ws, o, m_run, l_run, tq, head, slot, valid_row, h);
            }
        } else {
            const int ua = unit - MOBA_NB, head = ua & 7, ob = 63 - (ua >> 3), t0 = 256 * ob, t_row = t0 + 32 * wave + r;
            const bf16* Kg = proj + (size_t)1 * T * 512 + 64 * head; const bf16* Vg = proj + (size_t)2 * T * 512 + 64 * head;
            const LAS float* brow = (const LAS float*)(lds + BTO) + head * 128;
            const bf16* qrow = proj + (size_t)t_row * 512 + 64 * head;
            bf16x8 qf[4];
#pragma unroll
            for (int ks = 0; ks < 4; ++ks) qf[ks] = *(const bf16x8*)(qrow + 16 * ks + 8 * h);
            f32x16 o[2];
#pragma unroll
            for (int dt = 0; dt < 2; ++dt)
#pragma unroll
                for (int i = 0; i < 16; ++i) o[dt][i] = 0.f;
            float m_run = -INFINITY, l_run = 0.f;
            u4 kr[1], vr[1];
            at_load<64>(Kg, Vg, 512, t0, T - 1, kr, vr, tid);
#pragma unroll 1
            for (int tt = 0; tt < 4; ++tt) {
                LAS unsigned char* Kl = lds + (tt & 1) * 2 * TILE; LAS unsigned char* Vl = Kl + TILE;
                at_store<64>(Kl, Vl, kr, vr, tid);
                __syncthreads();
                if (tt < 3) at_load<64>(Kg, Vg, 512, t0 + 64 * (tt + 1), T - 1, kr, vr, tid);
                if (32 * wave + 31 >= 64 * tt)
                    at_step<64, 1, 0, 0x7fffffff>(Kl, Vl, qf, o, m_run, l_run, false, t0 + 64 * tt, T, t_row, true, brow, c1, r, h, lane);
            }
            moba_write_partial(ws, o, m_run, l_run, t_row, head, 3, true, h);
        }
        __syncthreads();
        unit = (int)wsum[16 + (it & 1)]; ++it;
    }
}
__device__ __forceinline__ void l0_moba_merge(const Params& P, int tid, int wg, int G) {
    unsigned char* ws = P.ws; const unsigned long long* selq = (const unsigned long long*)(ws + WS_SELQ);
    const bf16* po = (const bf16*)(ws + WS_PO); const float2* pml = (const float2*)(ws + WS_PML); bf16* attnout = (bf16*)(ws + WS_XN);
    for (int idx = wg * NTHR + tid; idx < T * 8 * 16; idx += G * NTHR) {
        const int dq = idx & 15, th = idx >> 4;
        const unsigned long long sq = selq[th]; float2 ml[4]; uint2 pv[4];
#pragma unroll
        for (int s_ = 0; s_ < 4; ++s_) { ml[s_] = pml[(size_t)th * 4 + s_]; pv[s_] = *(const uint2*)(po + ((size_t)th * 4 + s_) * 64 + 4 * dq); }
        const int cnt = __builtin_popcountll(sq);
        float M = ml[3].x;
#pragma unroll
        for (int s_ = 0; s_ < 3; ++s_) { if (s_ >= cnt) { ml[s_] = make_float2(-INFINITY, 0.f); pv[s_] = make_uint2(0u, 0u); } M = fmaxf(M, ml[s_].x); }
        float a0 = 0.f, a1 = 0.f, a2 = 0.f, a3 = 0.f, den = 0.f;
#pragma unroll
        for (int s_ = 0; s_ < 4; ++s_) { const float w = ml[s_].y * __builtin_amdgcn_exp2f(ml[s_].x - M); const uint2 v = pv[s_];
            a0 += w * bflo(v.x); a1 += w * bfhi(v.x); a2 += w * bflo(v.y); a3 += w * bfhi(v.y); den += w; }
        const float inv = 1.f / fmaxf(den, 1e-30f);
        uint2 o; o.x = pk2(a0 * inv, a1 * inv); o.y = pk2(a2 * inv, a3 * inv);
        *(uint2*)(attnout + (size_t)(th >> 3) * 1024 + 64 * (th & 7) + 4 * dq) = o;
    }
}

typedef float f32x4v __attribute__((ext_vector_type(4)));
__device__ __forceinline__ void at16_step(const LAS unsigned char* Kl, const LAS unsigned char* Vl, const bf16x8 (&qf)[4], f32x4v (&o)[8], float& m_run, float& l_run,
                                          bool fast, int key0, int kend, int t_row, bool rowsel, const LAS float* brow2, float c1, int lane) {
    constexpr int PK = AT<128>::PK;
    const int r16 = lane & 15, gl = lane >> 4;
    f32x4v s[4];
    {
        bf16x8 kf[16];
#pragma unroll
        for (int kt = 0; kt < 4; ++kt)
#pragma unroll
            for (int ks = 0; ks < 4; ++ks) kf[4 * kt + ks] = *(const LAS bf16x8*)(Kl + (16 * kt + r16) * PK + (32 * ks + 8 * gl) * 2);
        asm volatile("" ::: "memory");
#pragma unroll
        for (int kt = 0; kt < 4; ++kt) s[kt] = (f32x4v){0.f, 0.f, 0.f, 0.f};
#pragma unroll
        for (int ks = 0; ks < 4; ++ks)
#pragma unroll
            for (int kt = 0; kt < 4; ++kt) s[kt] = __builtin_amdgcn_mfma_f32_16x16x32_bf16(kf[4 * kt + ks], qf[ks], s[kt], 0, 0, 0);
    }
    float bfar = brow2[127];
    float lm = -INFINITY;
    if (!fast) {
        float bv[16];
#pragma unroll
        for (int kt = 0; kt < 4; ++kt)
#pragma unroll
            for (int i = 0; i < 4; ++i) { const int d = t_row - (key0 + 16 * kt + 4 * gl + i); const int dd = d < 0 ? 0 : (d > 127 ? 127 : d); bv[4 * kt + i] = brow2[dd]; }
        asm volatile("" ::: "memory");
#pragma unroll
        for (int kt = 0; kt < 4; ++kt)
#pragma unroll
            for (int i = 0; i < 4; ++i) { const int key = key0 + 16 * kt + 4 * gl + i; const int d = t_row - key;
                const bool valid = rowsel && key < kend && d >= 0;
                const float v = valid ? fmaf(s[kt][i], c1, bv[4 * kt + i]) : -INFINITY; s[kt][i] = v; lm = fmaxf(lm, v); }
    }
    asm volatile("s_waitcnt lgkmcnt(0)" : "+v"(bfar) :: "memory");
    const int q4 = r16 >> 2, p4 = r16 & 3;
    v4i16_t lo0[8], hi0[8];
#pragma unroll
    for (int d4 = 0; d4 < 4; ++d4)
#pragma unroll
        for (int s2 = 0; s2 < 2; ++s2) { const int row = 32 * s2 + 4 * gl + q4, ch = 2 * d4 + (p4 >> 1);
            lo0[2 * d4 + s2] = __builtin_amdgcn_ds_read_tr16_b64_v4i16((LAS v4i16_t*)(Vl + v_off<128>(row, ch) + 8 * (p4 & 1)));
            hi0[2 * d4 + s2] = __builtin_amdgcn_ds_read_tr16_b64_v4i16((LAS v4i16_t*)(Vl + v_off<128>(row + 16, ch) + 8 * (p4 & 1))); }
    asm volatile("" ::: "memory");
    if (fast) {
#pragma unroll
        for (int kt = 0; kt < 4; ++kt)
#pragma unroll
            for (int i = 0; i < 4; ++i) lm = fmaxf(lm, s[kt][i]);
        lm = rowsel ? fmaf(lm, c1, bfar) : -INFINITY;
    }
    lm = max_xor32(max_xor16(lm));
    if (!__all(lm <= m_run + AT_THR)) {
        const float mn = fmaxf(m_run, lm); const float ms = (mn == -INFINITY) ? 0.f : mn;
        const float alpha = __builtin_amdgcn_exp2f(m_run - ms); m_run = mn; l_run *= alpha;
#pragma unroll
        for (int dt = 0; dt < 8; ++dt)
#pragma unroll
            for (int i = 0; i < 4; ++i) o[dt][i] *= alpha;
    }
    const float sub = (m_run == -INFINITY) ? 0.f : m_run;
    float ps = 0.f;
    if (fast) { const float bb = rowsel ? (bfar - sub) : -INFINITY;
#pragma unroll
        for (int kt = 0; kt < 4; ++kt)
#pragma unroll
            for (int i = 0; i < 4; ++i) { const float p = __builtin_amdgcn_exp2f(fmaf(s[kt][i], c1, bb)); s[kt][i] = p; ps += p; }
    } else {
#pragma unroll
        for (int kt = 0; kt < 4; ++kt)
#pragma unroll
            for (int i = 0; i < 4; ++i) { const float p = __builtin_amdgcn_exp2f(s[kt][i] - sub); s[kt][i] = p; ps += p; }
    }
    l_run += ps;
    bf16x8 pb[2];
#pragma unroll
    for (int s2 = 0; s2 < 2; ++s2) { u4 w; w.x = pg8::cvt_pk_bf16(s[2 * s2][0], s[2 * s2][1]); w.y = pg8::cvt_pk_bf16(s[2 * s2][2], s[2 * s2][3]);
        w.z = pg8::cvt_pk_bf16(s[2 * s2 + 1][0], s[2 * s2 + 1][1]); w.w = pg8::cvt_pk_bf16(s[2 * s2 + 1][2], s[2 * s2 + 1][3]); pb[s2] = __builtin_bit_cast(bf16x8, w); }
    asm volatile("s_waitcnt lgkmcnt(0)" : "+v"(lo0[0]), "+v"(lo0[1]), "+v"(lo0[2]), "+v"(lo0[3]), "+v"(lo0[4]), "+v"(lo0[5]), "+v"(lo0[6]), "+v"(lo0[7]),
                 "+v"(hi0[0]), "+v"(hi0[1]), "+v"(hi0[2]), "+v"(hi0[3]), "+v"(hi0[4]), "+v"(hi0[5]), "+v"(hi0[6]), "+v"(hi0[7]) :: "memory");
    v4i16_t lo1[8], hi1[8];
#pragma unroll
    for (int d4 = 0; d4 < 4; ++d4)
#pragma unroll
        for (int s2 = 0; s2 < 2; ++s2) { const int row = 32 * s2 + 4 * gl + q4, ch = 2 * (4 + d4) + (p4 >> 1);
            lo1[2 * d4 + s2] = __builtin_amdgcn_ds_read_tr16_b64_v4i16((LAS v4i16_t*)(Vl + v_off<128>(row, ch) + 8 * (p4 & 1)));
            hi1[2 * d4 + s2] = __builtin_amdgcn_ds_read_tr16_b64_v4i16((LAS v4i16_t*)(Vl + v_off<128>(row + 16, ch) + 8 * (p4 & 1))); }
    asm volatile("" ::: "memory");
#pragma unroll
    for (int s2 = 0; s2 < 2; ++s2)
#pragma unroll
        for (int d4 = 0; d4 < 4; ++d4) { const v4i16_t l_ = lo0[2 * d4 + s2], h_ = hi0[2 * d4 + s2];
            const bf16x8 a = {l_[0], l_[1], l_[2], l_[3], h_[0], h_[1], h_[2], h_[3]};
            o[d4] = __builtin_amdgcn_mfma_f32_16x16x32_bf16(a, pb[s2], o[d4], 0, 0, 0); }
    asm volatile("s_waitcnt lgkmcnt(0)" : "+v"(lo1[0]), "+v"(lo1[1]), "+v"(lo1[2]), "+v"(lo1[3]), "+v"(lo1[4]), "+v"(lo1[5]), "+v"(lo1[6]), "+v"(lo1[7]),
                 "+v"(hi1[0]), "+v"(hi1[1]), "+v"(hi1[2]), "+v"(hi1[3]), "+v"(hi1[4]), "+v"(hi1[5]), "+v"(hi1[6]), "+v"(hi1[7]) :: "memory");
#pragma unroll
    for (int s2 = 0; s2 < 2; ++s2)
#pragma unroll
        for (int d4 = 0; d4 < 4; ++d4) { const v4i16_t l_ = lo1[2 * d4 + s2], h_ = hi1[2 * d4 + s2];
            const bf16x8 a = {l_[0], l_[1], l_[2], l_[3], h_[0], h_[1], h_[2], h_[3]};
            o[4 + d4] = __builtin_amdgcn_mfma_f32_16x16x32_bf16(a, pb[s2], o[4 + d4], 0, 0, 0); }
}
__device__ __forceinline__ void at16_soft(f32x4v (&s)[4], float lm, float& m_run, float& l_run, f32x4v (&o)[8], bool fast, bool rowsel, float bfar, float c1, bf16x8 (&pb)[2]) {
    if (fast) {
#pragma unroll
        for (int kt = 0; kt < 4; ++kt)
#pragma unroll
            for (int i = 0; i < 4; ++i) lm = fmaxf(lm, s[kt][i]);
        lm = rowsel ? fmaf(lm, c1, bfar) : -INFINITY;
    }
    lm = max_xor32(max_xor16(lm));
    if (!__all(lm <= m_run + AT_THR)) {
        const float mn = fmaxf(m_run, lm); const float ms = (mn == -INFINITY) ? 0.f : mn;
        const float alpha = __builtin_amdgcn_exp2f(m_run - ms); m_run = mn; l_run *= alpha;
#pragma unroll
        for (int dt = 0; dt < 8; ++dt)
#pragma unroll
            for (int i = 0; i < 4; ++i) o[dt][i] *= alpha;
    }
    const float sub = (m_run == -INFINITY) ? 0.f : m_run;
    float ps = 0.f;
    if (fast) { const float bb = rowsel ? (bfar - sub) : -INFINITY;
#pragma unroll
        for (int kt = 0; kt < 4; ++kt)
#pragma unroll
            for (int i = 0; i < 4; ++i) { const float p = __builtin_amdgcn_exp2f(fmaf(s[kt][i], c1, bb)); s[kt][i] = p; ps += p; }
    } else {
#pragma unroll
        for (int kt = 0; kt < 4; ++kt)
#pragma unroll
            for (int i = 0; i < 4; ++i) { const float p = __builtin_amdgcn_exp2f(s[kt][i] - sub); s[kt][i] = p; ps += p; }
    }
    l_run += ps;
#pragma unroll
    for (int s2 = 0; s2 < 2; ++s2) { u4 w; w.x = pg8::cvt_pk_bf16(s[2 * s2][0], s[2 * s2][1]); w.y = pg8::cvt_pk_bf16(s[2 * s2][2], s[2 * s2][3]);
        w.z = pg8::cvt_pk_bf16(s[2 * s2 + 1][0], s[2 * s2 + 1][1]); w.w = pg8::cvt_pk_bf16(s[2 * s2 + 1][2], s[2 * s2 + 1][3]); pb[s2] = __builtin_bit_cast(bf16x8, w); }
}
__device__ __forceinline__ void at16_step2(const LAS unsigned char* Kl, const LAS unsigned char* Vl, const bf16x8 (&qfa)[4], const bf16x8 (&qfb)[4], f32x4v (&oa)[8], f32x4v (&ob)[8],
                                           float& m_a, float& l_a, float& m_b, float& l_b, bool fast, int key0, int kend, int t_rowa, int t_rowb, bool rsa, bool rsb,
                                           const LAS float* brow2, float c1, int lane) {
    constexpr int PK = AT<128>::PK;
    const int r16 = lane & 15, gl = lane >> 4;
    f32x4v sa[4], sb[4];
#pragma unroll
    for (int kt = 0; kt < 4; ++kt) { sa[kt] = (f32x4v){0.f, 0.f, 0.f, 0.f}; sb[kt] = (f32x4v){0.f, 0.f, 0.f, 0.f}; }
#pragma unroll
    for (int kh = 0; kh < 2; ++kh) {
        bf16x8 kf[8];
#pragma unroll
        for (int kt = 0; kt < 4; ++kt)
#pragma unroll
            for (int k2 = 0; k2 < 2; ++k2) kf[2 * kt + k2] = *(const LAS bf16x8*)(Kl + (16 * kt + r16) * PK + (32 * (2 * kh + k2) + 8 * gl) * 2);
        asm volatile("" ::: "memory");
#pragma unroll
        for (int k2 = 0; k2 < 2; ++k2)
#pragma unroll
            for (int kt = 0; kt < 4; ++kt) { sa[kt] = __builtin_amdgcn_mfma_f32_16x16x32_bf16(kf[2 * kt + k2], qfa[2 * kh + k2], sa[kt], 0, 0, 0);
                sb[kt] = __builtin_amdgcn_mfma_f32_16x16x32_bf16(kf[2 * kt + k2], qfb[2 * kh + k2], sb[kt], 0, 0, 0); }
        asm volatile("" ::: "memory");
    }
    float bfar = brow2[127];
    float lma = -INFINITY, lmb = -INFINITY;
    if (!fast) {
#pragma unroll
        for (int sbi = 0; sbi < 2; ++sbi) {
            const int t_row = sbi ? t_rowb : t_rowa; const bool rowsel = sbi ? rsb : rsa; float bv[16];
#pragma unroll
            for (int kt = 0; kt < 4; ++kt)
#pragma unroll
                for (int i = 0; i < 4; ++i) { const int d = t_row - (key0 + 16 * kt + 4 * gl + i); const int dd = d < 0 ? 0 : (d > 127 ? 127 : d); bv[4 * kt + i] = brow2[dd]; }
            asm volatile("" ::: "memory");
            float lm = -INFINITY;
#pragma unroll
            for (int kt = 0; kt < 4; ++kt)
#pragma unroll
                for (int i = 0; i < 4; ++i) { const int key = key0 + 16 * kt + 4 * gl + i; const int d = t_row - key;
                    const bool valid = rowsel && key < kend && d >= 0;
                    const float sv = sbi ? sb[kt][i] : sa[kt][i];
                    const float v = valid ? fmaf(sv, c1, bv[4 * kt + i]) : -INFINITY; if (sbi) sb[kt][i] = v; else sa[kt][i] = v; lm = fmaxf(lm, v); }
            if (sbi) lmb = lm; else lma = lm;
        }
    }
    asm volatile("s_waitcnt lgkmcnt(0)" : "+v"(bfar) :: "memory");
    bf16x8 pba[2], pbb[2];
    at16_soft(sa, lma, m_a, l_a, oa, fast, rsa, bfar, c1, pba);
    at16_soft(sb, lmb, m_b, l_b, ob, fast, rsb, bfar, c1, pbb);
    const int q4 = r16 >> 2, p4 = r16 & 3;
    v4i16_t lo0[8], hi0[8];
#pragma unroll
    for (int d4 = 0; d4 < 4; ++d4)
#pragma unroll
        for (int s2 = 0; s2 < 2; ++s2) { const int row = 32 * s2 + 4 * gl + q4, ch = 2 * d4 + (p4 >> 1);
            lo0[2 * d4 + s2] = __builtin_amdgcn_ds_read_tr16_b64_v4i16((LAS v4i16_t*)(Vl + v_off<128>(row, ch) + 8 * (p4 & 1)));
            hi0[2 * d4 + s2] = __builtin_amdgcn_ds_read_tr16_b64_v4i16((LAS v4i16_t*)(Vl + v_off<128>(row + 16, ch) + 8 * (p4 & 1))); }
    asm volatile("" ::: "memory");
    asm volatile("s_waitcnt lgkmcnt(0)" : "+v"(lo0[0]), "+v"(lo0[1]), "+v"(lo0[2]), "+v"(lo0[3]), "+v"(lo0[4]), "+v"(lo0[5]), "+v"(lo0[6]), "+v"(lo0[7]),
                 "+v"(hi0[0]), "+v"(hi0[1]), "+v"(hi0[2]), "+v"(hi0[3]), "+v"(hi0[4]), "+v"(hi0[5]), "+v"(hi0[6]), "+v"(hi0[7]) :: "memory");
#pragma unroll
    for (int s2 = 0; s2 < 2; ++s2)
#pragma unroll
        for (int d4 = 0; d4 < 4; ++d4) { const v4i16_t l_ = lo0[2 * d4 + s2], h_ = hi0[2 * d4 + s2];
            const bf16x8 a = {l_[0], l_[1], l_[2], l_[3], h_[0], h_[1], h_[2], h_[3]};
            oa[d4] = __builtin_amdgcn_mfma_f32_16x16x32_bf16(a, pba[s2], oa[d4], 0, 0, 0); ob[d4] = __builtin_amdgcn_mfma_f32_16x16x32_bf16(a, pbb[s2], ob[d4], 0, 0, 0); }
    asm volatile("" ::: "memory");
    v4i16_t lo1[8], hi1[8];
#pragma unroll
    for (int d4 = 0; d4 < 4; ++d4)
#pragma unroll
        for (int s2 = 0; s2 < 2; ++s2) { const int row = 32 * s2 + 4 * gl + q4, ch = 2 * (4 + d4) + (p4 >> 1);
            lo1[2 * d4 + s2] = __builtin_amdgcn_ds_read_tr16_b64_v4i16((LAS v4i16_t*)(Vl + v_off<128>(row, ch) + 8 * (p4 & 1)));
            hi1[2 * d4 + s2] = __builtin_amdgcn_ds_read_tr16_b64_v4i16((LAS v4i16_t*)(Vl + v_off<128>(row + 16, ch) + 8 * (p4 & 1))); }
    asm volatile("" ::: "memory");
    asm volatile("s_waitcnt lgkmcnt(0)" : "+v"(lo1[0]), "+v"(lo1[1]), "+v"(lo1[2]), "+v"(lo1[3]), "+v"(lo1[4]), "+v"(lo1[5]), "+v"(lo1[6]), "+v"(lo1[7]),
                 "+v"(hi1[0]), "+v"(hi1[1]), "+v"(hi1[2]), "+v"(hi1[3]), "+v"(hi1[4]), "+v"(hi1[5]), "+v"(hi1[6]), "+v"(hi1[7]) :: "memory");
#pragma unroll
    for (int s2 = 0; s2 < 2; ++s2)
#pragma unroll
        for (int d4 = 0; d4 < 4; ++d4) { const v4i16_t l_ = lo1[2 * d4 + s2], h_ = hi1[2 * d4 + s2];
            const bf16x8 a = {l_[0], l_[1], l_[2], l_[3], h_[0], h_[1], h_[2], h_[3]};
            oa[4 + d4] = __builtin_amdgcn_mfma_f32_16x16x32_bf16(a, pba[s2], oa[4 + d4], 0, 0, 0); ob[4 + d4] = __builtin_amdgcn_mfma_f32_16x16x32_bf16(a, pbb[s2], ob[4 + d4], 0, 0, 0); }
}
__device__ __forceinline__ void l1_sel16(const Params& P, LAS unsigned char* lds, int tid, int lane, int wave, int wg, int G) {
    unsigned char* ws = P.ws; const float* ocw = (const float*)(ws + WS_OCW); const unsigned* selmask = (const unsigned*)(ws + WS_SELMASK);
    bf16* attnout = (bf16*)(ws + WS_XN);
    constexpr int TILE = AT<128>::TILE;
    LAS unsigned* selm = (LAS unsigned*)(lds + AT_BT_OFF + 4096);
    at_load_bt2(ws, lds, AT_BT_OFF, tid);
    const int r16 = lane & 15, gl = lane >> 4;
    for (int u = wg; u < 512; u += G) {
        const int g = u & 1, k = u >> 1, c = k < 128 ? k : 383 - k, t0 = 64 * c;
        const int head = 4 * g + (r16 & 3);
        const int ql0 = 8 * wave + (r16 >> 2), ql1 = ql0 + 4;
        const bf16* Kg = l1_tensor(ws, 12 + g); const bf16* Vg = l1_tensor(ws, 14 + g);
        bf16x8 qf0[4], qf1[4];
        { int lp = lane; asm volatile("" : "+v"(lp));
          const int r16p = lp & 15, glp = lp >> 4, headp = 4 * g + (r16p & 3), qlp = 8 * wave + (r16p >> 2);
          const bf16* q0 = l1_tensor(ws, headp) + (size_t)(t0 + qlp) * 128 + 8 * glp; const bf16* q1 = q0 + 4 * 128;
#pragma unroll
          for (int ks = 0; ks < 4; ++ks) { qf0[ks] = *(const bf16x8*)(q0 + 32 * ks); qf1[ks] = *(const bf16x8*)(q1 + 32 * ks); } }
        const LAS float* brow = (const LAS float*)(lds + AT_BT_OFF) + head * 128;
        f32x4v o0[8], o1[8];
#pragma unroll
        for (int dt = 0; dt < 8; ++dt) { o0[dt] = (f32x4v){0.f, 0.f, 0.f, 0.f}; o1[dt] = (f32x4v){0.f, 0.f, 0.f, 0.f}; }
        float m0 = -INFINITY, l0 = 0.f, m1 = -INFINITY, l1 = 0.f;
        u4 kra[2], vra[2];
        { int tl_ = tid; asm volatile("" : "+v"(tl_)); at_load<128>(Kg, Vg, 128, 0, T - 1, kra, vra, tl_); }
        __syncthreads();
        { int tp = tid; asm volatile("" : "+v"(tp)); selm[tp] = selmask[((size_t)(t0 + (tp >> 3)) * 2 + g) * 8 + (tp & 7)]; }
#define SEL16_STEP(KR, VR, BUF, J) do { const int j_ = (J); LAS unsigned char* Kl = lds + (BUF) * 2 * TILE; LAS unsigned char* Vl = Kl + TILE; \
            at_store<128>(Kl, Vl, KR, VR, tid); __syncthreads(); \
            if (j_ + 1 <= c) { int tl_ = tid; asm volatile("" : "+v"(tl_)); at_load<128>(Kg, Vg, 128, 64 * (j_ + 1), T - 1, KR, VR, tl_); }   \
            const bool rs0 = (selm[ql0 * 8 + (j_ >> 5)] >> (j_ & 31)) & 1u, rs1 = (selm[ql1 * 8 + (j_ >> 5)] >> (j_ & 31)) & 1u; \
            const bool fast_ = t0 + 8 * wave - (64 * j_ + 63) >= 113; \
            const bool a0_ = __any(rs0), a1_ = __any(rs1); \
            if (a0_ && a1_) at16_step2(Kl, Vl, qf0, qf1, o0, o1, m0, l0, m1, l1, fast_, 64 * j_, T, t0 + ql0, t0 + ql1, rs0, rs1, brow, SCALE_C * LOG2E, lane); \
            else if (a0_) at16_step(Kl, Vl, qf0, o0, m0, l0, fast_, 64 * j_, T, t0 + ql0, rs0, brow, SCALE_C * LOG2E, lane); \
            else if (a1_) at16_step(Kl, Vl, qf1, o1, m1, l1, fast_, 64 * j_, T, t0 + ql1, rs1, brow, SCALE_C * LOG2E, lane); } while (0)
#pragma unroll 1
        for (int j = 0; j <= c; ++j) { SEL16_STEP(kra, vra, (j & 1), j); }
#undef SEL16_STEP
        int le = lane; asm volatile("" : "+v"(le));
        const int r16e = le & 15, gle = le >> 4, heade = 4 * g + (r16e & 3), qle = 8 * wave + (r16e >> 2);
#pragma unroll
        for (int sb = 0; sb < 2; ++sb) {
            const int t_row = t0 + qle + 4 * sb; float lr = sb ? l1 : l0;
            lr += __shfl_xor(lr, 16); lr += __shfl_xor(lr, 32);
            const float f = l1_gate(ws, t_row, heade, 1) / fmaxf(lr, 1e-30f);
            const size_t ob = (size_t)t_row * 1024 + heade * 128 + 4 * gle;
#pragma unroll
            for (int dt = 0; dt < 8; ++dt) { const f32x4v ov = sb ? o1[dt] : o0[dt]; const float4 b = *(const float4*)(ocw + ob + 16 * dt);
                uint2 w; w.x = pk2(b.x + ov[0] * f, b.y + ov[1] * f); w.y = pk2(b.z + ov[2] * f, b.w + ov[3] * f);
                *(uint2*)(attnout + ob + 16 * dt) = w; }
        }
    }
}

constexpr int NPH = 21;
__global__ void __launch_bounds__(NTHR, 2) fwd(Params P) {
    extern __shared__ __attribute__((aligned(16))) unsigned char lds_raw[];
    LAS unsigned char* lds = (LAS unsigned char*)lds_raw;
    volatile LAS unsigned* MISC = (volatile LAS unsigned*)(lds + MISC_OFF);
    const int tid = threadIdx.x, lane = tid & 63, wave = __builtin_amdgcn_readfirstlane(tid >> 6), wg = blockIdx.x, G = gridDim.x;
    unsigned char* ws = P.ws;
    for (int u = tid; u < (LDS_BYTES - SCR_BYTES) / 4; u += NTHR) ((LAS unsigned*)(lds + SCR_BYTES))[u] = 0u;
    __syncthreads();
    const int lo = P.ph_lo, hi = P.ph_hi;
    XcdBarrier bar; bar.bar = (unsigned*)(ws + WS_CTL) + CW_BAR; bar.x = 0; bar.st = nullptr;
    if (hi - lo > 1) bar = xcd_barrier_post((unsigned*)(ws + WS_CTL) + CW_BAR, MISC + 8);
#ifndef PH_MASK
#define PH_MASK 0xFFFFFFFFu
#endif
#define IN(k) (lo <= (k) && (k) < hi && ((PH_MASK >> (k)) & 1u))
#ifndef REP_MASK
#define REP_MASK 0u
#endif
#define RPT(k) for (int rep_ = 0; rep_ < ((((REP_MASK) >> (k)) & 1u) ? 2 : 1); ++rep_)
#define RPTBAR do { if (rep_) xcd_barrier(bar); } while (0)
#define SEAM(k) do { if (IN(k) && IN((k) + 1)) xcd_barrier(bar); } while (0)
    const int gw = wg * NWAVES + wave, NGW = G * NWAVES;
    bf16* xn = (bf16*)(ws + WS_XN); bf16* proj = (bf16*)(ws + WS_PROJ); bf16* mb = (bf16*)(ws + WS_MB); bf16* ub = (bf16*)(ws + WS_U);

    if (IN(0)) { p0_prologue(P, lds, tid, lane, wave, wg, G); } SEAM(0);
    if (IN(1)) { run_gemm<0>(lds, xn, (const bf16*)(ws + WS_W0IN), T, N0IN, D, proj, 512, (size_t)T * 512, G, wg); } SEAM(1);
    if (IN(2)) { l0_stage_a(P, lds, tid, lane, wave, wg, G); } SEAM(2);
    if (IN(3)) { RPT(3) { RPTBAR; l0_stage_c(P, lds, tid, lane, wave, wg, G); l0_route(P, lds, tid, lane, wave, wg, G); } } SEAM(3);
    if (IN(4)) { l0_moba_gather(P, lds, tid, lane, wave, wg, G); } SEAM(4);
    if (IN(5)) { RPT(5) { RPTBAR; l0_moba_merge(P, tid, wg, G); } } SEAM(5);
    if (IN(6)) { run_gemm<0>(lds, xn, (const bf16*)(ws + WS_W0OUT), T, D, D, mb, 1024, 0, G, wg); } SEAM(6);
    if (IN(7)) { post_norm<0, 1>(P.in[I_X], P.out, mb, P.in[I_NMIXPOST], P.in[I_NMLPPRE], xn, lane, gw, NGW); } SEAM(7);
    if (IN(8)) { run_gemm<1>(lds, xn, (const bf16*)(ws + WS_W0UP), T, FF, D, ub, 4096, 0, G, wg); } SEAM(8);
    if (IN(9)) { run_gemm<0>(lds, ub, (const bf16*)(ws + WS_W0DN), T, D, FF, mb, 1024, 0, G, wg); } SEAM(9);
    if (IN(10)) { post_norm<1, 1>(P.out, P.out, mb, P.in[I_NMLPPOST], P.in[I_NMIXPRE] + D, xn, lane, gw, NGW); } SEAM(10);
    if (IN(11)) { run_gemm<0>(lds, xn, (const bf16*)(ws + WS_W1IN), T, N1IN, D, proj, 128, (size_t)T * 128, G, wg); } SEAM(11);
    if (IN(12)) { RPT(12) { RPTBAR; l1_compress_gemm(P, lds, tid, wg); __syncthreads(); l1_window_mfma(P, lds, tid, lane, wave, wg, G); } } SEAM(12);
    if (IN(13)) { l1_compress_out(P, lds, tid, wg, G); } SEAM(13);
    if (IN(14)) { l1_cmp_mfma(P, lds, tid, lane, wave, wg, G); } SEAM(14);
    if (IN(15)) { RPT(15) { RPTBAR; l1_sel16(P, lds, tid, lane, wave, wg, G); } } SEAM(15);
    if (IN(16)) { run_gemm<0>(lds, xn, (const bf16*)(ws + WS_W1OUT), T, D, D, mb, 1024, 0, G, wg); } SEAM(16);
    if (IN(17)) { post_norm<1, 1>(P.out, ws + WS_X3, mb, P.in[I_NMIXPOST] + D, P.in[I_NMLPPRE] + D, xn, lane, gw, NGW); } SEAM(17);
    if (IN(18)) { run_gemm<1>(lds, xn, (const bf16*)(ws + WS_W1UP), T, FF, D, ub, 4096, 0, G, wg); } SEAM(18);
    if (IN(19)) { run_gemm<0>(lds, ub, (const bf16*)(ws + WS_W1DN), T, D, FF, mb, 1024, 0, G, wg); } SEAM(19);
    if (IN(20)) { post_norm<1, 0>(ws + WS_X3, P.out, mb, P.in[I_NMLPPOST] + D, nullptr, xn, lane, gw, NGW); }
#undef IN
#undef SEAM
}

extern "C" void kernel_launch(void* const* d_in, const int* in_sizes, int n_in, void* d_out, int out_size, void* d_ws, size_t ws_size, hipStream_t stream) {
    static int grid = 0;
    if (grid == 0) {
        if (n_in != N_IN || in_sizes[0] != T * D || out_size != T * D || ws_size < WS_END) { fprintf(stderr, "kernel_launch: unexpected shapes (n_in %d, in0 %d, out %d, ws %zu); nothing launched\n", n_in, n_in > 0 ? in_sizes[0] : -1, out_size, ws_size); grid = -1; return; }
        int dev = 0, cus = 0, per_cu = 0;
        if (hipGetDevice(&dev) != hipSuccess || hipDeviceGetAttribute(&cus, hipDeviceAttributeMultiprocessorCount, dev) != hipSuccess) { grid = -1; return; }
        if (hipFuncSetAttribute((const void*)fwd, hipFuncAttributeMaxDynamicSharedMemorySize, LDS_BYTES) != hipSuccess) { fprintf(stderr, "kernel_launch: hipFuncSetAttribute failed\n"); grid = -1; return; }
        if (hipOccupancyMaxActiveBlocksPerMultiprocessor(&per_cu, (const void*)fwd, NTHR, LDS_BYTES) != hipSuccess || per_cu < 1) fprintf(stderr, "kernel_launch: occupancy query reports %d workgroups per CU\n", per_cu);
        (void)hipGetLastError();
        grid = cus;
        if (grid < 96) { fprintf(stderr, "kernel_launch: needs >= 96 CUs\n"); grid = -1; return; }
    }
    if (grid < 0) return;
    if (hipMemsetAsync((char*)d_ws + WS_CTL, 0, CTL_ZERO_BYTES, stream) != hipSuccess) return;
    Params p{};
    for (int i = 0; i < N_IN; ++i) p.in[i] = (const float*)d_in[i];
    p.out = (float*)d_out; p.ws = (unsigned char*)d_ws;
#if MK_ONE_LAUNCH
    p.ph_lo = 0; p.ph_hi = NPH;
    hipLaunchKernelGGL(fwd, dim3(grid), dim3(NTHR), LDS_BYTES, stream, p);
#else
    for (int k = 0; k < NPH; ++k) { p.ph_lo = k; p.ph_hi = k + 1; hipLaunchKernelGGL(fwd, dim3(grid), dim3(NTHR), LDS_BYTES, stream, p); }
#endif
}
```

```cpp
#include <hip/hip_runtime.h>
#include <cstdio>
#include <cstdint>
#ifndef MK_ONE_LAUNCH
#define MK_ONE_LAUNCH 1
#endif
#define GAS __attribute__((address_space(1)))
#define LAS __attribute__((address_space(3)))
namespace pg8 {
#define PG8_LAS __attribute__((address_space(3)))
typedef unsigned short bf16_t;
typedef short bf16x8 __attribute__((ext_vector_type(8)));
typedef float f32x4 __attribute__((ext_vector_type(4)));
typedef unsigned u32x4 __attribute__((ext_vector_type(4)));
constexpr int BM = 256, BK = 64, HALF = 128, HTB = HALF * BK * 2  , STAGE_BYTES = 8 * HTB, NXCD = 8, WGM = 8;

__host__ __device__ __forceinline__ int lds_byte(int r, int c) { const int st = (r >> 4) * 2 + (c >> 5), rr = r & 15, cc = c & 31, ob = rr * 64 + cc * 2; return st * 1024 + (ob ^ (((ob >> 9) & 1) << 5)); }
__host__ __device__ __forceinline__ void stage_rc(int b, int& R, int& C) { const int st = b / 1024, sb = b % 1024, swz = sb ^ (((sb >> 9) & 1) << 5); R = (st >> 1) * 16 + swz / 64; C = (st & 1) * 32 + (swz % 64) / 2; }
__host__ __device__ __forceinline__ int perm32(int rho) { const int n = rho >> 4, i = rho & 15; return 8 * (i >> 2) + 4 * n + (i & 3); }

struct Unit { int pm, pn; };
struct Gemm { const bf16_t* A; const bf16_t* Bt; int M, N, K, lda, ldb; };

struct StaticOrder {
    int nM, nN, nwg, G, c;
    __host__ __device__ void init(int M, int N, int G_, int c_) { nM = M / BM; nN = N / BM; nwg = nM * nN; G = G_; c = c_; }
    __host__ __device__ bool next(int i, Unit& u) const {
        const long L = (long)i * G + c; if (L >= nwg) return false;
        int wgid = (int)L; { const int q = nwg / NXCD, r = nwg % NXCD, xcd = wgid % NXCD, off = wgid / NXCD; wgid = (xcd < r ? xcd * (q + 1) : r * (q + 1) + (xcd - r) * q) + off; }
        const int nig = WGM * nN, gid = wgid / nig, fm = gid * WGM, gsz = (nM - fm) < WGM ? (nM - fm) : WGM;
        u.pm = fm + ((wgid % nig) % gsz); u.pn = (wgid % nig) / gsz; return true;
    }
    __device__ __forceinline__ void a_ready(const Unit&) const {}
    __device__ __forceinline__ void done(const Unit&) const {}
};

__device__ __forceinline__ unsigned cvt_pk_bf16(float lo, float hi) { unsigned r; asm volatile("v_cvt_pk_bf16_f32 %0, %1, %2" : "=v"(r) : "v"(lo), "v"(hi)); return r; }
template <class Epi, class Sched, bool ALIGN_EPI = false, bool SP2 = false>
__device__ __forceinline__ void gemm_phase(PG8_LAS unsigned char* lds, const Gemm g, const Sched& S, const Epi& E) {
    const int tid = threadIdx.x, wid = __builtin_amdgcn_readfirstlane(tid >> 6), lane = tid & 63, wr = wid >> 2, wc = wid & 3, fr = lane & 15, fq = lane >> 4;
    const int K = g.K, nt = K / BK;
    unsigned voffA[2], voffB[2];
#pragma unroll
    for (int i = 0; i < 2; ++i) { int R, C; stage_rc(tid * 16 + i * 8192, R, C); const int Rb = Epi::PERM ? ((R & ~31) + perm32(R & 31)) : R;
        voffA[i] = (unsigned)(R * g.lda + C) * 2u; voffB[i] = (unsigned)(Rb * g.ldb + C) * 2u; }
    const size_t kstep = (size_t)(BK * 2);
    const size_t hstepA = (size_t)HALF * g.lda * 2, hstepB = (size_t)HALF * g.ldb * 2;
    const size_t tstepA = 2 * hstepA, tstepB = 2 * hstepB;
    const unsigned ldsw = (unsigned)wid * 1024u;
    const int aoff = lds_byte(wr * 64 + fr, fq * 8), boff = lds_byte(wc * 32 + fr, fq * 8);
#define PG8_SA(b, h) (((b) * 2 + (h)) * HTB)
#define PG8_SB(b, h) ((4 + (b) * 2 + (h)) * HTB)
#define PG8_STAGE(bufoff, gbase, voff) do { _Pragma("unroll") for (int _i = 0; _i < 2; ++_i) \
        __builtin_amdgcn_global_load_lds((const unsigned*)((const char*)(gbase) + (voff)[_i]), (PG8_LAS unsigned*)(lds + (bufoff) + ldsw + _i * 8192), 16, 0, 0); } while (0)
#define PG8_LDA(dst, b, h) do { _Pragma("unroll") for (int m = 0; m < 4; ++m) _Pragma("unroll") for (int k = 0; k < 2; ++k) dst[m][k] = *(const PG8_LAS bf16x8*)(lds + PG8_SA(b, h) + aoff + m * 2048 + k * 1024); } while (0)
#define PG8_LDB(dst, b, h) do { _Pragma("unroll") for (int n = 0; n < 2; ++n) _Pragma("unroll") for (int k = 0; k < 2; ++k) dst[n][k] = *(const PG8_LAS bf16x8*)(lds + PG8_SB(b, h) + boff + n * 2048 + k * 1024); } while (0)
#define PG8_MMA(ai, bj, At, Bt) do { __builtin_amdgcn_s_setprio(1); _Pragma("unroll") for (int m = 0; m < 4; ++m) _Pragma("unroll") for (int n = 0; n < 2; ++n) _Pragma("unroll") for (int k = 0; k < 2; ++k) \
        acc[ai][bj][m][n] = __builtin_amdgcn_mfma_f32_16x16x32_bf16(Bt[n][k], At[m][k], acc[ai][bj][m][n], 0, 0, 0); __builtin_amdgcn_s_setprio(0); } while (0)
#define PG8_WAIT_V(n) asm volatile("s_waitcnt vmcnt(" #n ")" ::: "memory")
#define PG8_WAIT_L(n) asm volatile("s_waitcnt lgkmcnt(" #n ")" ::: "memory")
#define PG8_BAR __builtin_amdgcn_s_barrier()
#define PG8_SCHED __builtin_amdgcn_sched_barrier(0)
    Unit cur, nxt; int ui = 0;
    if (!S.next(0, cur)) return;
    f32x4 acc[2][2][4][2];
#pragma unroll
    for (int a = 0; a < 2; ++a)
#pragma unroll
        for (int b = 0; b < 2; ++b)
#pragma unroll
            for (int m = 0; m < 4; ++m)
#pragma unroll
                for (int n = 0; n < 2; ++n) acc[a][b][m][n] = (f32x4){0.f, 0.f, 0.f, 0.f};
    bf16x8 At[4][2], B0[2][2], B1[2][2];
    const char* cA = (const char*)g.A + (size_t)cur.pm * tstepA; const char* cB = (const char*)g.Bt + (size_t)cur.pn * tstepB;
    S.a_ready(cur);
    if constexpr (SP2) {
        PG8_STAGE(PG8_SB(0, 0), cB, voffB); PG8_STAGE(PG8_SB(0, 1), cB + hstepB, voffB); PG8_STAGE(PG8_SA(0, 0), cA, voffA); PG8_STAGE(PG8_SA(0, 1), cA + hstepA, voffA);
        if (wr == 1) PG8_BAR;
        PG8_WAIT_V(2); PG8_BAR;
        PG8_STAGE(PG8_SB(1, 0), cB + kstep, voffB); PG8_STAGE(PG8_SA(1, 0), cA + kstep, voffA); PG8_STAGE(PG8_SB(1, 1), cB + hstepB + kstep, voffB);
        PG8_WAIT_V(6); PG8_BAR;
    } else {
        PG8_STAGE(PG8_SB(0, 0), cB, voffB); PG8_STAGE(PG8_SA(0, 0), cA, voffA); PG8_STAGE(PG8_SB(0, 1), cB + hstepB, voffB); PG8_STAGE(PG8_SA(0, 1), cA + hstepA, voffA);
        if (wr == 1) PG8_BAR;
        PG8_WAIT_V(4); PG8_BAR;
        PG8_STAGE(PG8_SB(1, 0), cB + kstep, voffB); PG8_STAGE(PG8_SA(1, 0), cA + kstep, voffA); PG8_STAGE(PG8_SB(1, 1), cB + hstepB + kstep, voffB);
        PG8_WAIT_V(6); PG8_BAR;
    }
    for (;;) {
        const bool has_next = S.next(ui + 1, nxt);
        const char* nA = has_next ? (const char*)g.A + (size_t)nxt.pm * tstepA : cA; const char* nB = has_next ? (const char*)g.Bt + (size_t)nxt.pn * tstepB : cB;
        for (int t = 0; t < nt; t += 2) {
            const bool last = (t == nt - 2);
            const char* a1 = cA + (size_t)(t + 1) * kstep;
            const char* a2 = last ? nA : cA + (size_t)(t + 2) * kstep; const char* b2 = last ? nB : cB + (size_t)(t + 2) * kstep;
            const char* a3 = a2 + kstep; const char* b3 = b2 + kstep;
            if (last && has_next) S.a_ready(nxt);
            if constexpr (SP2) {
            PG8_LDB(B0, 0, 0); PG8_LDB(B1, 0, 1); PG8_SCHED; PG8_LDA(At, 0, 0); PG8_STAGE(PG8_SA(1, 1), a1 + hstepA, voffA);
            PG8_WAIT_V(8); PG8_WAIT_L(0); PG8_BAR; PG8_MMA(0, 0, At, B0); PG8_MMA(0, 1, At, B1); PG8_BAR; PG8_SCHED;
            PG8_LDA(At, 0, 1); PG8_STAGE(PG8_SB(0, 0), b2, voffB); PG8_STAGE(PG8_SB(0, 1), b2 + hstepB, voffB); PG8_STAGE(PG8_SA(0, 0), a2, voffA);
            PG8_WAIT_V(8); PG8_WAIT_L(0); PG8_BAR; PG8_MMA(1, 0, At, B0); PG8_MMA(1, 1, At, B1); PG8_BAR; PG8_SCHED;
            PG8_LDB(B0, 1, 0); PG8_LDB(B1, 1, 1); PG8_SCHED; PG8_LDA(At, 1, 0); PG8_STAGE(PG8_SA(0, 1), a2 + hstepA, voffA);
            PG8_WAIT_V(8); PG8_WAIT_L(0); PG8_BAR; PG8_MMA(0, 0, At, B0); PG8_MMA(0, 1, At, B1); PG8_BAR; PG8_SCHED;
            PG8_LDA(At, 1, 1); PG8_STAGE(PG8_SB(1, 0), b3, voffB); PG8_STAGE(PG8_SB(1, 1), b3 + hstepB, voffB); PG8_STAGE(PG8_SA(1, 0), a3, voffA);
            PG8_WAIT_V(8); PG8_WAIT_L(0); PG8_BAR; PG8_MMA(1, 0, At, B0); PG8_MMA(1, 1, At, B1); PG8_BAR; PG8_SCHED;
            } else {
            PG8_LDB(B0, 0, 0); PG8_SCHED; PG8_LDA(At, 0, 0); PG8_STAGE(PG8_SA(1, 1), a1 + hstepA, voffA);
            PG8_WAIT_L(8); PG8_BAR; PG8_WAIT_L(0); PG8_MMA(0, 0, At, B0); PG8_BAR; PG8_SCHED;
            PG8_LDB(B1, 0, 1); PG8_STAGE(PG8_SB(0, 0), b2, voffB);
            PG8_BAR; PG8_WAIT_L(0); PG8_MMA(0, 1, At, B1); PG8_BAR;
            PG8_LDA(At, 0, 1); PG8_STAGE(PG8_SA(0, 0), a2, voffA);
            PG8_BAR; PG8_WAIT_L(0); PG8_MMA(1, 0, At, B0); PG8_BAR; PG8_SCHED;
            PG8_STAGE(PG8_SB(0, 1), b2 + hstepB, voffB);
            PG8_WAIT_V(6); PG8_BAR; PG8_MMA(1, 1, At, B1); PG8_BAR;
            PG8_LDB(B0, 1, 0); PG8_SCHED; PG8_LDA(At, 1, 0); PG8_STAGE(PG8_SA(0, 1), a2 + hstepA, voffA);
            PG8_WAIT_L(8); PG8_BAR; PG8_WAIT_L(0); PG8_MMA(0, 0, At, B0); PG8_BAR; PG8_SCHED;
            PG8_LDB(B1, 1, 1); PG8_STAGE(PG8_SB(1, 0), b3, voffB);
            PG8_BAR; PG8_WAIT_L(0); PG8_MMA(0, 1, At, B1); PG8_BAR;
            PG8_LDA(At, 1, 1); PG8_STAGE(PG8_SA(1, 0), a3, voffA);
            PG8_BAR; PG8_WAIT_L(0); PG8_MMA(1, 0, At, B0); PG8_BAR; PG8_SCHED;
            PG8_STAGE(PG8_SB(1, 1), b3 + hstepB, voffB);
            PG8_WAIT_V(6); PG8_BAR; PG8_MMA(1, 1, At, B1); PG8_BAR;
            }
        }
        if constexpr (ALIGN_EPI) { if (wr == 0) PG8_BAR; }
        if constexpr (!Epi::AFTER_DRAIN) { E(acc, cur, wr, wc, fr, fq); S.done(cur); }
        if (!has_next) break;
#pragma unroll
        for (int a = 0; a < 2; ++a)
#pragma unroll
            for (int b = 0; b < 2; ++b)
#pragma unroll
                for (int m = 0; m < 4; ++m)
#pragma unroll
                    for (int n = 0; n < 2; ++n) acc[a][b][m][n] = (f32x4){0.f, 0.f, 0.f, 0.f};
        cur = nxt; cA = nA; cB = nB; ++ui;
        if constexpr (ALIGN_EPI) { if (wr == 1) PG8_BAR; }
    }
    PG8_WAIT_V(0);
    if constexpr (!ALIGN_EPI) { if (wr == 0) PG8_BAR; }
    PG8_BAR;
    if constexpr (Epi::AFTER_DRAIN) { E.fused(acc, cur, wr, wc, fr, fq, lds, wid, lane); S.done(cur); }
#undef PG8_SA
#undef PG8_SB
#undef PG8_STAGE
#undef PG8_LDA
#undef PG8_LDB
#undef PG8_MMA
#undef PG8_WAIT_V
#undef PG8_WAIT_L
#undef PG8_BAR
#undef PG8_SCHED
}
}
#define XB_TMO      128
#define XB_XCNT(j)  (256  + 64 * (j))
#define XB_XSUB(j)  (1280 + 64 * (j))
#define XB_XGEN(j)  (2304 + 64 * (j))
#define XB_TOP      3328
#define XB_TOPGEN   3392
#define XCD_BAR_WORDS 3456
#define XB_SPIN_CAP (1u << 22)

__device__ __forceinline__ unsigned xb_ld(unsigned* p)              { return __hip_atomic_load(p, __ATOMIC_RELAXED, __HIP_MEMORY_SCOPE_AGENT); }
__device__ __forceinline__ unsigned xb_add(unsigned* p, unsigned v) { return __hip_atomic_fetch_add(p, v, __ATOMIC_RELAXED, __HIP_MEMORY_SCOPE_AGENT); }
__device__ __forceinline__ unsigned xb_xcc_id() { return (unsigned)__builtin_amdgcn_s_getreg((3 << 11) | 20) & 0xFu; }
#define XB_SPIN(cond, bar) do { unsigned _sp = 0; while (cond) { __builtin_amdgcn_s_sleep(1); \
    if ((++_sp & 255u) == 0u) { if (xb_ld(&(bar)[XB_TMO])) break; if (_sp > XB_SPIN_CAP) { atomicAdd(&(bar)[XB_TMO], 1u); break; } } } } while (0)

struct XcdBarrier {
    unsigned* bar; unsigned x;
    volatile LAS unsigned* st;
};

__device__ __forceinline__ XcdBarrier xcd_barrier_post(unsigned* bar, volatile LAS unsigned* st) {
    XcdBarrier b; b.bar = bar; b.x = xb_xcc_id(); b.st = st;
    if (threadIdx.x == 0) (void)xb_add(&bar[XB_XCNT(b.x)], 1u);
    return b;
}
__device__ __forceinline__ void xcd_barrier_complete(unsigned* bar, unsigned x, unsigned& nloc, unsigned& nx) {
    const unsigned G = gridDim.x * gridDim.y * gridDim.z;
    unsigned sum, cnt, mine, sp = 0u;
    for (;;) {
        sum = 0u; cnt = 0u; mine = 0u;
#pragma unroll
        for (unsigned j = 0; j < 16; ++j) { const unsigned c = xb_ld(&bar[XB_XCNT(j)]); sum += c; cnt += (c > 0u) ? 1u : 0u; mine = (j == x) ? c : mine; }
        if (sum == G) break;
        __builtin_amdgcn_s_sleep(1);
        if ((++sp & 255u) == 0u) { if (xb_ld(&bar[XB_TMO])) break; if (sp > XB_SPIN_CAP) { atomicAdd(&bar[XB_TMO], 1u); break; } }
    }
    nloc = mine > 0u ? mine : 1u; nx = cnt > 0u ? cnt : 1u;
}

__device__ __forceinline__ void xcd_barrier(const XcdBarrier& b) {
    asm volatile("s_waitcnt vmcnt(0)" ::: "memory");
    __syncthreads();
    if (threadIdx.x == 0) {
        unsigned* bar = b.bar;
        __builtin_amdgcn_s_waitcnt(0);
        unsigned nloc = b.st[0], nx = b.st[1];
        if (nloc == 0u) { xcd_barrier_complete(bar, b.x, nloc, nx); b.st[0] = nloc; b.st[1] = nx; }
        const unsigned old = xb_add(&bar[XB_XSUB(b.x)], 1u);
        const unsigned gen = old / nloc;
        if (old + 1u == (gen + 1u) * nloc) {
            __builtin_amdgcn_fence(__ATOMIC_RELEASE, "agent");
            asm volatile("s_waitcnt vmcnt(0)" ::: "memory");
            const unsigned og = xb_add(&bar[XB_TOP], 1u);
            const unsigned tg = og / nx;
            if (og + 1u == (tg + 1u) * nx) xb_add(&bar[XB_TOPGEN], 1u);
            else XB_SPIN(xb_ld(&bar[XB_TOPGEN]) == tg, bar);
            __builtin_amdgcn_fence(__ATOMIC_ACQUIRE, "agent");
            xb_add(&bar[XB_XGEN(b.x)], 1u);
            asm volatile("s_waitcnt vmcnt(0)" ::: "memory");
        } else {
            XB_SPIN(xb_ld(&bar[XB_XGEN(b.x)]) == gen, bar);
            __builtin_amdgcn_fence(__ATOMIC_ACQUIRE, "agent");
            asm volatile("s_waitcnt vmcnt(0)" ::: "memory");
        }
    }
    __syncthreads();
}

constexpr int T = 16384, D = 1024, FF = 4096;
constexpr int NWAVES = 8, NTHR = 512;
constexpr float EPS = 1e-6f;
constexpr int N0IN = 2560, N1IN = 2816, C_IN = 2584;
enum { I_X = 0, I_RELB, I_ABWIN, I_CONVW, I_CONVB, I_WRG, I_BRG, I_WIG, I_BIG, I_LAM, I_ABWOUT, I_CWIN, I_POSK, I_POSV, I_K1, I_K2, I_V1, I_V2, I_CWOUT,
       I_NMIXPRE, I_NMIXPOST, I_NMLPPRE, I_NMLPPOST, I_WUP, I_WDN, N_IN };

constexpr size_t MiB = 1u << 20;
constexpr size_t WS_CTL = 0, CTL_ZERO_BYTES = 1 * MiB;
constexpr size_t WS_BT = 1 * MiB;
constexpr size_t WS_KMEAN = 1 * MiB + 65536;
constexpr size_t WS_CARRY = 2 * MiB;
constexpr size_t WS_SELMASK = 3 * MiB;
constexpr size_t WS_SELQ = 4 * MiB;
constexpr size_t WS_SELT = 5 * MiB;
constexpr size_t WS_PO = 172 * MiB;
constexpr size_t WS_PML = 236 * MiB;
constexpr int CW_QUEUE = 8192;
constexpr size_t WS_W0IN = 8 * MiB, WS_W0OUT = 13 * MiB, WS_W0UP = 15 * MiB, WS_W0DN = 23 * MiB;
constexpr size_t WS_W1IN = 31 * MiB, WS_W1OUT = 37 * MiB, WS_W1UP = 39 * MiB, WS_W1DN = 47 * MiB;
constexpr size_t WS_CW1K = 55 * MiB, WS_CW1V = 57 * MiB;
constexpr size_t WS_CPART = 60 * MiB;
constexpr size_t WS_POSP = 76 * MiB;
constexpr size_t WS_XN = 60 * MiB;
constexpr size_t WS_PROJ = 92 * MiB;
constexpr size_t WS_HLOC = 172 * MiB;
constexpr size_t WS_OCW = 180 * MiB;
constexpr size_t WS_HID = 244 * MiB;
constexpr size_t WS_KCMP = 250 * MiB;
constexpr size_t WS_MB = 92 * MiB;
constexpr size_t WS_U = 124 * MiB;
constexpr size_t WS_X3 = 1 * MiB;
constexpr size_t WS_END = 256 * MiB;
constexpr int CW_BAR = 4096;

constexpr int SCR_BYTES = 131072;
constexpr int MISC_OFF = SCR_BYTES + 320;
constexpr int LDS_BYTES = 147456;

typedef unsigned short bf16;
typedef float f4 __attribute__((ext_vector_type(4)));
#define LDS_WAIT() asm volatile("s_waitcnt lgkmcnt(0)" ::: "memory")
#define VM_WAIT() asm volatile("s_waitcnt vmcnt(0)" ::: "memory")
__device__ __forceinline__ unsigned f2bf(float f) { unsigned u = __builtin_bit_cast(unsigned, f); return (u + 0x7fffu + ((u >> 16) & 1u)) >> 16; }
__device__ __forceinline__ unsigned pk2(float lo, float hi) { return f2bf(lo) | (f2bf(hi) << 16); }
__device__ __forceinline__ float bf2f(bf16 b) { return __builtin_bit_cast(float, ((unsigned)b) << 16); }
__device__ __forceinline__ float bflo(unsigned w) { return __builtin_bit_cast(float, w << 16); }
__device__ __forceinline__ float bfhi(unsigned w) { return __builtin_bit_cast(float, w & 0xffff0000u); }
__device__ __forceinline__ float wave_sum(float v) {
#pragma unroll
    for (int o = 1; o < 64; o <<= 1) v += __shfl_xor(v, o);
    return v;
}
__device__ __forceinline__ float wave_max(float v) {
#pragma unroll
    for (int o = 1; o < 64; o <<= 1) v = fmaxf(v, __shfl_xor(v, o));
    return v;
}
__device__ __forceinline__ void wave_argmax(float& v, int& i) {
#pragma unroll
    for (int o = 1; o < 64; o <<= 1) { const float ov = __shfl_xor(v, o); const int oi = __shfl_xor(i, o); if (ov > v || (ov == v && oi < i)) { v = ov; i = oi; } }
}
__device__ __forceinline__ float gelu_tanh(float x) { return 0.5f * x * (1.f + tanhf(0.7978845608028654f * (x + 0.044715f * x * x * x))); }
__device__ __forceinline__ float sigmoidf_(float x) { return 1.f / (1.f + __expf(-x)); }
__device__ __forceinline__ int t5_bucket(int d) {
    if (d < 16) return d;
    return 16 + (d >= 19) + (d >= 21) + (d >= 24) + (d >= 27) + (d >= 31) + (d >= 35) + (d >= 40) + (d >= 46) + (d >= 52) + (d >= 59) + (d >= 67) + (d >= 77) + (d >= 87) + (d >= 99) + (d >= 113);
}

#ifndef MOBA_MFMA
#define MOBA_MFMA 1
#endif
struct Params { const float* in[N_IN]; float* out; unsigned char* ws; int ph_lo, ph_hi; };

typedef unsigned v4u_t __attribute__((ext_vector_type(4)));
template <int ACT  > struct EpiT {
    static constexpr bool PERM = true, AFTER_DRAIN = false;
    bf16* O; int tcols; size_t tstride;
    __device__ __forceinline__ void operator()(const pg8::f32x4 (&acc)[2][2][4][2], const pg8::Unit& u, int wr, int wc, int fr, int fq) const {
        const int row0 = u.pm * 256 + wr * 64 + fr;
        const __amdgpu_buffer_rsrc_t rs = __builtin_amdgcn_make_buffer_rsrc((void*)O, 0, 0x7FFFFFF0, 0x00020000);
#pragma unroll
        for (int bj = 0; bj < 2; ++bj) {
            const int c0 = u.pn * 256 + bj * 128; const int tt = c0 / tcols; const int cw = c0 - tt * tcols;
            const unsigned base = (unsigned)(((size_t)tt * tstride + cw + wc * 32 + 8 * fq) * 2);
#pragma unroll
            for (int ai = 0; ai < 2; ++ai)
#pragma unroll
                for (int m = 0; m < 4; ++m) {
                    pg8::f32x4 v0 = acc[ai][bj][m][0], v1 = acc[ai][bj][m][1];
                    if (ACT == 1) {
#pragma unroll
                        for (int j = 0; j < 4; ++j) { const float a = fmaxf(v0[j], 0.f), b = fmaxf(v1[j], 0.f); v0[j] = a * a; v1[j] = b * b; } }
                    pg8::u32x4 w; w.x = pg8::cvt_pk_bf16(v0[0], v0[1]); w.y = pg8::cvt_pk_bf16(v0[2], v0[3]); w.z = pg8::cvt_pk_bf16(v1[0], v1[1]); w.w = pg8::cvt_pk_bf16(v1[2], v1[3]);
                    __builtin_amdgcn_raw_buffer_store_b128(__builtin_bit_cast(v4u_t, w), rs, base + (unsigned)((row0 + ai * 128 + m * 16) * tcols * 2), 0, 16);
                }
        }
    }
};
template <int ACT> __device__ __forceinline__ void run_gemm(LAS unsigned char* lds, const bf16* A, const bf16* Bt, int M, int N, int K, bf16* O, int tcols, size_t tstride, int G, int wg) {
    pg8::Gemm g{A, Bt, M, N, K, K, K}; pg8::StaticOrder S; S.init(M, N, G, wg); EpiT<ACT> E{O, tcols, tstride};
    pg8::gemm_phase<EpiT<ACT>, pg8::StaticOrder, true, true>((PG8_LAS unsigned char*)lds, g, S, E);
}

__device__ __forceinline__ void tr_load(const float* __restrict__ W, int K, int N, int item, int nblk, float (&wv)[32], int lane) {
    const int kb = item / nblk, nb = item % nblk, k0 = 64 * kb, n0 = 32 * nb;
    const int nn = n0 + (lane & 31); const bool ok = nn < N;
#pragma unroll
    for (int i = 0; i < 32; ++i) { const int kk = 2 * i + (lane >> 5); wv[i] = ok ? W[(size_t)(k0 + kk) * N + nn] : 0.f; }
}
__device__ __forceinline__ void tr_finish(int K, bf16* __restrict__ WT, int item, int nblk, const float (&wv)[32], LAS float* scr, int lane) {
    const int kb = item / nblk, nb = item % nblk, k0 = 64 * kb, n0 = 32 * nb;
#pragma unroll
    for (int i = 0; i < 32; ++i) { const int kk = 2 * i + (lane >> 5); scr[kk * 33 + (lane & 31)] = wv[i]; }
    LDS_WAIT(); asm volatile("" ::: "memory");
    const int c = lane & 7;
#pragma unroll
    for (int j = 0; j < 4; ++j) { const int n = (lane >> 3) + 8 * j; const LAS float* s = scr + (8 * c) * 33 + n;
        uint4 o; o.x = pk2(s[0 * 33], s[1 * 33]); o.y = pk2(s[2 * 33], s[3 * 33]); o.z = pk2(s[4 * 33], s[5 * 33]); o.w = pk2(s[6 * 33], s[7 * 33]);
        *(uint4*)(WT + (size_t)(n0 + n) * K + k0 + 8 * c) = o; }
    LDS_WAIT(); asm volatile("" ::: "memory");
}
struct WSel { const float* src; bf16* dst; int K, N, nblk, r; };
__device__ __forceinline__ WSel w_select(const Params& P, unsigned char* ws, int it) {
    WSel w; int r = it;
#define TRY_W(src_, K_, N_, NP_, dst_) { constexpr int cnt = ((K_) / 64) * ((NP_) / 32); if (r < cnt) { w.src = (src_); w.dst = (bf16*)(ws + (dst_)); w.K = (K_); w.N = (N_); w.nblk = (NP_) / 32; w.r = r; return w; } r -= cnt; }
    TRY_W(P.in[I_ABWIN], 1024, 2560, 2560, WS_W0IN)
    TRY_W(P.in[I_ABWOUT], 1024, 1024, 1024, WS_W0OUT)
    TRY_W(P.in[I_WUP], 1024, 4096, 4096, WS_W0UP)
    TRY_W(P.in[I_WDN], 4096, 1024, 1024, WS_W0DN)
    TRY_W(P.in[I_CWIN], 1024, C_IN, N1IN, WS_W1IN)
    TRY_W(P.in[I_CWOUT], 1024, 1024, 1024, WS_W1OUT)
    TRY_W(P.in[I_WUP] + (size_t)1024 * 4096, 1024, 4096, 4096, WS_W1UP)
    TRY_W(P.in[I_WDN] + (size_t)4096 * 1024, 4096, 1024, 1024, WS_W1DN)
    TRY_W(P.in[I_K1], 4096, 256, 256, WS_CW1K)
#undef TRY_W
    w.src = P.in[I_V1]; w.dst = (bf16*)(ws + WS_CW1V); w.K = 4096; w.N = 256; w.nblk = 8; w.r = r; return w;
}
__device__ __forceinline__ void rms_to_bf16(const float4 (&v)[4], const float* __restrict__ g, bf16* __restrict__ orow, int lane) {
    float ss = 0.f;
#pragma unroll
    for (int j = 0; j < 4; ++j) ss += (v[j].x * v[j].x + v[j].y * v[j].y) + (v[j].z * v[j].z + v[j].w * v[j].w);
    const float r = 1.f / sqrtf(wave_sum(ss) * (1.f / D) + EPS);
#pragma unroll
    for (int j = 0; j < 4; ++j) { const float4 gg = ((const float4*)g)[lane + 64 * j];
        uint2 o; o.x = pk2(v[j].x * r * gg.x, v[j].y * r * gg.y); o.y = pk2(v[j].z * r * gg.z, v[j].w * r * gg.w);
        ((uint2*)orow)[lane + 64 * j] = o; }
}
__device__ __forceinline__ void p0_prologue(const Params& P, LAS unsigned char* lds, int tid, int lane, int wave, int wg, int G) {
    unsigned char* ws = P.ws;
    LAS float* scr = (LAS float*)(lds + wave * 16384);
    const int gw = wg * NWAVES + wave, NGW = G * NWAVES;
    constexpr int NITEMS = 16 * 80 + 16 * 32 + 16 * 128 + 64 * 32 + 16 * 88 + 16 * 32 + 16 * 128 + 64 * 32 + 2 * 64 * 8;
    {
        float wa[32], wb[32];
        int it = gw;
        WSel cur = w_select(P, ws, it < NITEMS ? it : 0);
        if (it < NITEMS) tr_load(cur.src, cur.K, cur.N, cur.r, cur.nblk, wa, lane);
        while (it < NITEMS) {
            const int itn = it + NGW; WSel nx = w_select(P, ws, itn < NITEMS ? itn : 0);
            if (itn < NITEMS) tr_load(nx.src, nx.K, nx.N, nx.r, nx.nblk, wb, lane);
            tr_finish(cur.K, cur.dst, cur.r, cur.nblk, wa, scr, lane);
            if (itn >= NITEMS) break;
            const int it2 = itn + NGW; cur = w_select(P, ws, it2 < NITEMS ? it2 : 0);
            if (it2 < NITEMS) tr_load(cur.src, cur.K, cur.N, cur.r, cur.nblk, wa, lane);
            tr_finish(nx.K, nx.dst, nx.r, nx.nblk, wb, scr, lane);
            it = it2;
        }
    }
    if (wg == 0) { float* bt = (float*)(ws + WS_BT); for (int i = tid; i < 1024; i += NTHR) { const int h = i >> 7, d = i & 127; bt[i] = P.in[I_RELB][t5_bucket(d) * 8 + h]; } }
    for (int m = gw; m < T; m += 2 * NGW) {
        const float4* xr0 = (const float4*)(P.in[I_X] + (size_t)m * D); const float4* xr1 = (const float4*)(P.in[I_X] + (size_t)((m + NGW < T) ? (m + NGW) : m) * D); float4 v0[4], v1[4];
#pragma unroll
        for (int j = 0; j < 4; ++j) { v0[j] = xr0[lane + 64 * j]; v1[j] = xr1[lane + 64 * j]; }
        rms_to_bf16(v0, P.in[I_NMIXPRE], (bf16*)(ws + WS_XN) + (size_t)m * D, lane);
        if (m + NGW < T) rms_to_bf16(v1, P.in[I_NMIXPRE], (bf16*)(ws + WS_XN) + (size_t)(m + NGW) * D, lane);
    }
}

template <int XIN, int XOUT>
__device__ __forceinline__ void post_norm(const void* xin_, void* xout_, const bf16* __restrict__ y, const float* __restrict__ g1, const float* __restrict__ g2  ,
                                          bf16* __restrict__ xn, int lane, int gw, int NGW) {
    for (int m0 = gw; m0 < T; m0 += 2 * NGW) {
        const int m1 = (m0 + NGW < T) ? (m0 + NGW) : m0; const bool two = (m0 + NGW < T);
        const uint2* yr0 = (const uint2*)(y + (size_t)m0 * D); const uint2* yr1 = (const uint2*)(y + (size_t)m1 * D);
        uint2 yw0[4], yw1[4]; float4 xv0[4], xv1[4];
        if (XIN == 0) {
            const float4* xr0 = (const float4*)((const float*)xin_ + (size_t)m0 * D); const float4* xr1 = (const float4*)((const float*)xin_ + (size_t)m1 * D);
#pragma unroll
            for (int j = 0; j < 4; ++j) { yw0[j] = yr0[lane + 64 * j]; yw1[j] = yr1[lane + 64 * j]; xv0[j] = xr0[lane + 64 * j]; xv1[j] = xr1[lane + 64 * j]; }
        } else {
            const uint2* xr0 = (const uint2*)((const bf16*)xin_ + (size_t)m0 * D); const uint2* xr1 = (const uint2*)((const bf16*)xin_ + (size_t)m1 * D);
            uint2 xw0[4], xw1[4];
#pragma unroll
            for (int j = 0; j < 4; ++j) { yw0[j] = yr0[lane + 64 * j]; yw1[j] = yr1[lane + 64 * j]; xw0[j] = xr0[lane + 64 * j]; xw1[j] = xr1[lane + 64 * j]; }
#pragma unroll
            for (int j = 0; j < 4; ++j) { xv0[j] = make_float4(bflo(xw0[j].x), bfhi(xw0[j].x), bflo(xw0[j].y), bfhi(xw0[j].y)); xv1[j] = make_float4(bflo(xw1[j].x), bfhi(xw1[j].x), bflo(xw1[j].y), bfhi(xw1[j].y)); }
        }
#pragma unroll
        for (int rr = 0; rr < 2; ++rr) {
            if (rr == 1 && !two) break;
            const int m = rr ? m1 : m0; float4 yv[4]; float ss = 0.f;
#pragma unroll
            for (int j = 0; j < 4; ++j) { const uint2 w = rr ? yw1[j] : yw0[j]; yv[j] = make_float4(bflo(w.x), bfhi(w.x), bflo(w.y), bfhi(w.y));
                ss += (yv[j].x * yv[j].x + yv[j].y * yv[j].y) + (yv[j].z * yv[j].z + yv[j].w * yv[j].w); }
            const float r = 1.f / sqrtf(wave_sum(ss) * (1.f / D) + EPS);
            float4 v[4];
#pragma unroll
            for (int j = 0; j < 4; ++j) { const float4 xv = rr ? xv1[j] : xv0[j]; const float4 gg = ((const float4*)g1)[lane + 64 * j];
                v[j] = make_float4(xv.x + yv[j].x * r * gg.x, xv.y + yv[j].y * r * gg.y, xv.z + yv[j].z * r * gg.z, xv.w + yv[j].w * r * gg.w);
                if (XOUT == 0) ((float4*)((float*)xout_ + (size_t)m * D))[lane + 64 * j] = v[j];
                else { uint2 o; o.x = pk2(v[j].x, v[j].y); o.y = pk2(v[j].z, v[j].w); ((uint2*)((bf16*)xout_ + (size_t)m * D))[lane + 64 * j] = o; } }
            if (g2) rms_to_bf16(v, g2, xn + (size_t)m * D, lane);
        }
    }
}

template <int DH, int NP, int MODE>
__device__ __forceinline__ void wattn_tile(const bf16* __restrict__ Kt, const bf16* __restrict__ Vt, int ldk, int key0, int kend, int t, int posmul, int posadd, int dmax,
                                           const LAS float* qs, const float* __restrict__ btab, int h0, float scale,
                                           float (&m)[NP], float (&l)[NP], float (&o)[NP][DH / 64], LAS float* cs, int lane) {
    const int k = key0 + lane; const bool inb = k < kend; const int kc = inb ? k : (kend - 1);
    const int d = t - (posmul * kc + posadd);
    const bool valid = inb && d >= 0 && d < dmax;
    float s[NP];
#pragma unroll
    for (int p = 0; p < NP; ++p) s[p] = 0.f;
    const uint4* krow = (const uint4*)(Kt + (size_t)kc * ldk);
    uint4 kr[DH / 8];
#pragma unroll
    for (int c = 0; c < DH / 8; ++c) kr[c] = krow[c];
#pragma unroll
    for (int c = 0; c < DH / 8; ++c) {
        asm volatile("" ::: "memory");
        const uint4 kv = kr[c];
        const float k0 = bflo(kv.x), k1 = bfhi(kv.x), k2 = bflo(kv.y), k3 = bfhi(kv.y), k4 = bflo(kv.z), k5 = bfhi(kv.z), k6 = bflo(kv.w), k7 = bfhi(kv.w);
#pragma unroll
        for (int p = 0; p < NP; ++p) { const f4 qa = *(const volatile LAS f4*)(qs + p * DH + 8 * c), qb = *(const volatile LAS f4*)(qs + p * DH + 8 * c + 4);
            s[p] += (k0 * qa.x + k1 * qa.y) + (k2 * qa.z + k3 * qa.w) + (k4 * qb.x + k5 * qb.y) + (k6 * qb.z + k7 * qb.w);
            asm volatile("" : "+v"(s[p]) :: "memory"); }
    }
    const int dd = d < 0 ? 0 : (d > 127 ? 127 : d);
    float pe[NP];
#pragma unroll
    for (int p = 0; p < NP; ++p) {
        const float sc = valid ? s[p] * scale + btab[(h0 + p) * 128 + dd] : -INFINITY;
        if (MODE == 2) { pe[p] = valid ? __expf(sc - m[p]) * l[p] : 0.f; }
        else {
            const float tm = wave_max(sc); const float mn = fmaxf(m[p], tm);
            float alpha = 1.f; pe[p] = 0.f;
            if (mn != -INFINITY) { alpha = __expf(m[p] - mn); pe[p] = valid ? __expf(sc - mn) : 0.f; }
            l[p] = l[p] * alpha + wave_sum(pe[p]); m[p] = mn;
            if (MODE == 0) {
#pragma unroll
                for (int i = 0; i < DH / 64; ++i) o[p][i] *= alpha; }
        }
    }
    if (MODE == 2) { float csum = 0.f;
#pragma unroll
        for (int p = 0; p < NP; ++p) csum += pe[p];
        if (inb) cs[k] = csum; }
    if (MODE != 1) {
        const int nk = (kend - key0) < 64 ? (kend - key0) : 64;
        for (int kk = 0; kk < nk; ++kk) {
            const bf16* vrow = Vt + (size_t)(key0 + kk) * ldk;
            float v0, v1 = 0.f;
            if (DH == 128) { const unsigned w = ((const unsigned*)vrow)[lane]; v0 = bflo(w); v1 = bfhi(w); } else { v0 = bf2f(vrow[lane]); }
#pragma unroll
            for (int p = 0; p < NP; ++p) { const float pk = __builtin_bit_cast(float, __builtin_amdgcn_readlane(__builtin_bit_cast(int, pe[p]), kk));
                o[p][0] += pk * v0; if (DH == 128) o[p][DH / 64 - 1] += pk * v1; }
        }
    }
}

__device__ __forceinline__ void l0_stage_a(const Params& P, LAS unsigned char* lds, int tid, int lane, int wave, int wg, int G) {
    unsigned char* ws = P.ws;
    const bf16* proj = (const bf16*)(ws + WS_PROJ);
    const bf16* xr = proj + (size_t)3 * T * 512;
    LAS float* xc = (LAS float*)lds;
    unsigned* hp = (unsigned*)(ws + WS_HLOC);
    const int c = tid, b = c >> 6;
    LAS bf16* rp = (LAS bf16*)(lds + 65536); LAS bf16* ip = (LAS bf16*)(lds + 98304);
    const int r16 = lane & 15, gl = lane >> 4;
    pg8::bf16x8 wfr[4][2], wfi[4][2];
    {
        const float* Wr = P.in[I_WRG] + (size_t)b * 4096; const float* Wi = P.in[I_WIG] + (size_t)b * 4096;
#pragma unroll
        for (int nt = 0; nt < 4; ++nt)
#pragma unroll
            for (int ks = 0; ks < 2; ++ks) { float fr[8], fi[8];
#pragma unroll
                for (int j = 0; j < 8; ++j) { const int idx = (32 * ks + 8 * gl + j) * 64 + 16 * nt + r16; fr[j] = Wr[idx]; fi[j] = Wi[idx]; }
                pg8::u32x4 wr4, wi4; wr4.x = pk2(fr[0], fr[1]); wr4.y = pk2(fr[2], fr[3]); wr4.z = pk2(fr[4], fr[5]); wr4.w = pk2(fr[6], fr[7]);
                wi4.x = pk2(fi[0], fi[1]); wi4.y = pk2(fi[2], fi[3]); wi4.z = pk2(fi[4], fi[5]); wi4.w = pk2(fi[6], fi[7]);
                wfr[nt][ks] = __builtin_bit_cast(pg8::bf16x8, wr4); wfi[nt][ks] = __builtin_bit_cast(pg8::bf16x8, wi4); }
    }
    float brg4[4], big4[4];
#pragma unroll
    for (int nt = 0; nt < 4; ++nt) { brg4[nt] = P.in[I_BRG][64 * b + 16 * nt + r16]; big4[nt] = P.in[I_BIG][64 * b + 16 * nt + r16]; }
    const float sp = log1pf(expf(-P.in[I_LAM][c]));
    const float* cw = P.in[I_CONVW]; const float w0 = cw[c], w1 = cw[512 + c], w2 = cw[1024 + c], w3 = cw[1536 + c], cb = P.in[I_CONVB][c];
    for (int ch = wg; ch < T / 64; ch += G) {
        const int t0 = ch * 64;
        float xm3 = (t0 >= 3) ? bf2f(xr[(size_t)(t0 - 3) * 512 + c]) : 0.f, xm2 = (t0 >= 2) ? bf2f(xr[(size_t)(t0 - 2) * 512 + c]) : 0.f, xm1 = (t0 >= 1) ? bf2f(xr[(size_t)(t0 - 1) * 512 + c]) : 0.f;
        float h = 0.f, Pc = 1.f;
#pragma unroll 1
        for (int hf = 0; hf < 2; ++hf) {
            const int ts = t0 + 32 * hf;
            for (int t16 = 0; t16 < 32; t16 += 16) { bf16 xv[16];
#pragma unroll
                for (int i = 0; i < 16; ++i) xv[i] = xr[(size_t)(ts + t16 + i) * 512 + c];
#pragma unroll
                for (int i = 0; i < 16; ++i) { const float x0 = bf2f(xv[i]); xc[(t16 + i) * 512 + c] = cb + w0 * xm3 + w1 * xm2 + w2 * xm1 + w3 * x0; xm3 = xm2; xm2 = xm1; xm1 = x0; } }
            __syncthreads();
#pragma unroll
            for (int mt = 0; mt < 2; ++mt) {
                pg8::bf16x8 af[2];
#pragma unroll
                for (int ks = 0; ks < 2; ++ks) { const LAS f4* xp = (const LAS f4*)(xc + (16 * mt + r16) * 512 + 64 * b + 32 * ks + 8 * gl); const f4 x0 = xp[0], x1 = xp[1];
                    pg8::u32x4 w; w.x = pk2(x0.x, x0.y); w.y = pk2(x0.z, x0.w); w.z = pk2(x1.x, x1.y); w.w = pk2(x1.z, x1.w); af[ks] = __builtin_bit_cast(pg8::bf16x8, w); }
#pragma unroll
                for (int nt = 0; nt < 4; ++nt) {
                    pg8::f32x4 ar = {0.f, 0.f, 0.f, 0.f}, ai = {0.f, 0.f, 0.f, 0.f};
                    ar = __builtin_amdgcn_mfma_f32_16x16x32_bf16(af[0], wfr[nt][0], ar, 0, 0, 0); ar = __builtin_amdgcn_mfma_f32_16x16x32_bf16(af[1], wfr[nt][1], ar, 0, 0, 0);
                    ai = __builtin_amdgcn_mfma_f32_16x16x32_bf16(af[0], wfi[nt][0], ai, 0, 0, 0); ai = __builtin_amdgcn_mfma_f32_16x16x32_bf16(af[1], wfi[nt][1], ai, 0, 0, 0);
#pragma unroll
                    for (int i = 0; i < 4; ++i) { const int o_ = (16 * mt + 4 * gl + i) * 512 + 64 * b + 16 * nt + r16; rp[o_] = (bf16)f2bf(ar[i] + brg4[nt]); ip[o_] = (bf16)f2bf(ai[i] + big4[nt]); }
                }
            }
            __syncthreads();
#pragma unroll 4
            for (int t = 0; t < 32; ++t) {
                const float r = __builtin_amdgcn_rcpf(1.f + __builtin_amdgcn_exp2f(-1.4426950408889634f * bf2f(rp[t * 512 + c]))), ig = __builtin_amdgcn_rcpf(1.f + __builtin_amdgcn_exp2f(-1.4426950408889634f * bf2f(ip[t * 512 + c])));
                const float la = -8.f * r * sp; const float a = __builtin_amdgcn_exp2f(1.4426950408889634f * la); const float x2 = 2.f * la;
                const float em_s = -x2 * (1.f + x2 * 0.5f * (1.f + x2 * (1.f / 3.f) * (1.f + x2 * 0.25f * (1.f + x2 * 0.2f * (1.f + x2 * (1.f / 6.f))))));
                const float em = (x2 > -0.25f) ? em_s : 1.f - a * a;
                const float bb = __builtin_amdgcn_sqrtf(em) * ig * xc[t * 512 + c];
                h = a * h + bb; Pc *= a;
                hp[(size_t)(ts + t) * 512 + c] = pk2(h, Pc);
            }
            __syncthreads();
        }
        float* car = (float*)(ws + WS_CARRY) + (size_t)ch * 1024; car[c] = Pc; car[512 + c] = h;
    }
    const bf16* kt = proj + (size_t)1 * T * 512; float* kmean = (float*)(ws + WS_KMEAN);
    LAS float* red = (LAS float*)lds;
    for (int task = wg; task < 512; task += G) {
        const int h = task >> 6, j = task & 63, d = tid & 63, rg = tid >> 6; const bf16* kk = kt + (size_t)(256 * j + rg) * 512 + 64 * h + d; float sacc = 0.f;
#pragma unroll
        for (int r8 = 0; r8 < 32; r8 += 8) { bf16 v[8];
#pragma unroll
            for (int i = 0; i < 8; ++i) v[i] = kk[(size_t)(8 * (r8 + i)) * 512];
#pragma unroll
            for (int i = 0; i < 8; ++i) sacc += bf2f(v[i]); }
        __syncthreads();
        red[rg * 64 + d] = sacc;
        __syncthreads();
        if (tid < 64) { float t_ = 0.f;
#pragma unroll
            for (int g8 = 0; g8 < 8; ++g8) t_ += red[g8 * 64 + tid];
            kmean[(h * 64 + j) * 64 + tid] = t_ * (1.f / 256.f); }
    }
}

__device__ __forceinline__ void l0_stage_c(const Params& P, LAS unsigned char* lds, int tid, int lane, int wave, int wg, int G) {
    unsigned char* ws = P.ws;
    const bf16* proj = (const bf16*)(ws + WS_PROJ);
    bf16* attnout = (bf16*)(ws + WS_XN);
    {
        const unsigned* hp = (const unsigned*)(ws + WS_HLOC); const float* car = (const float*)(ws + WS_CARRY);
        const bf16* gr = proj + (size_t)4 * T * 512;
        for (int ch = wg; ch < T / 64; ch += G) {
            const int c = tid, t0 = ch * 64; float H = 0.f;
            int cc = 0;
            for (; cc + 16 <= ch; cc += 16) {
                float a_[16], b_[16];
#pragma unroll
                for (int i = 0; i < 16; ++i) { a_[i] = car[(size_t)(cc + i) * 1024 + c]; b_[i] = car[(size_t)(cc + i) * 1024 + 512 + c]; }
#pragma unroll
                for (int i = 0; i < 16; ++i) H = a_[i] * H + b_[i];
            }
            for (; cc < ch; ++cc) H = car[(size_t)cc * 1024 + c] * H + car[(size_t)cc * 1024 + 512 + c];
            for (int t8 = 0; t8 < 64; t8 += 16) {
                unsigned hw[16]; bf16 gv[16];
#pragma unroll
                for (int i = 0; i < 16; ++i) { const size_t ix = (size_t)(t0 + t8 + i) * 512 + c; hw[i] = hp[ix]; gv[i] = gr[ix]; }
#pragma unroll
                for (int i = 0; i < 16; ++i) attnout[(size_t)(t0 + t8 + i) * 1024 + 512 + c] = (bf16)f2bf((bflo(hw[i]) + bfhi(hw[i]) * H) * gelu_tanh(bf2f(gv[i])));
            }
        }
    }
#if !MOBA_MFMA
    const bf16* qt = proj; const bf16* kt = proj + (size_t)1 * T * 512; const bf16* vt = proj + (size_t)2 * T * 512;
    const float* kmean = (const float*)(ws + WS_KMEAN); const float* btab = (const float*)(ws + WS_BT);
    LAS float* qs = (LAS float*)(lds + wave * 8192);
    for (int task = wg * NWAVES + wave; task < T * 8; task += G * NWAVES) {
        const int t = task >> 3, h = task & 7, own = t >> 8;
        qs[lane] = bf2f(qt[(size_t)t * 512 + 64 * h + lane]);
        LDS_WAIT(); asm volatile("" ::: "memory");
        float rv = -1e30f;
        if (lane < own) { const float4* km = (const float4*)(kmean + (size_t)(h * 64 + lane) * 64); float s = 0.f;
#pragma unroll
            for (int i = 0; i < 16; ++i) { const float4 kv = km[i]; const f4 qv = *(const LAS f4*)(qs + 4 * i); s += (kv.x * qv.x + kv.y * qv.y) + (kv.z * qv.z + kv.w * qv.w); }
            rv = s; }
        int sel[3];
#pragma unroll
        for (int r = 0; r < 3; ++r) { float bv = rv; int bi = lane; wave_argmax(bv, bi); bi = __builtin_amdgcn_readfirstlane(bi); sel[r] = (bv > -5e29f) ? bi : -1; if (lane == bi) rv = -INFINITY; }
        float m[1] = {-INFINITY}, l[1] = {0.f}, o[1][1] = {{0.f}};
#pragma unroll
        for (int r = 0; r < 3; ++r) if (sel[r] >= 0) for (int tile = 0; tile < 4; ++tile) { const int key0 = sel[r] * 256 + 64 * tile;
            wattn_tile<64, 1, 0>(kt + 64 * h, vt + 64 * h, 512, key0, key0 + 64, t, 1, 0, 0x7fffffff, qs, btab, h, 0.125f, m, l, o, nullptr, lane); }
        for (int key0 = own * 256; key0 <= t; key0 += 64)
            wattn_tile<64, 1, 0>(kt + 64 * h, vt + 64 * h, 512, key0, t + 1, t, 1, 0, 0x7fffffff, qs, btab, h, 0.125f, m, l, o, nullptr, lane);
        attnout[(size_t)t * 1024 + 64 * h + lane] = (bf16)f2bf(o[0][0] / fmaxf(l[0], 1e-30f));
        asm volatile("" ::: "memory");
    }
#endif
}

__device__ __forceinline__ const bf16* l1_tensor(const unsigned char* ws, int i) { return (const bf16*)(ws + WS_PROJ) + (size_t)i * T * 128; }
__device__ __forceinline__ void l1_load_q(const unsigned char* ws, int t, int g, LAS float* qs, int lane) {
#pragma unroll
    for (int p = 0; p < 4; ++p) { const unsigned w = ((const unsigned*)(l1_tensor(ws, 4 * g + p) + (size_t)t * 128))[lane]; qs[p * 128 + 2 * lane] = bflo(w); qs[p * 128 + 2 * lane + 1] = bfhi(w); }
    LDS_WAIT(); asm volatile("" ::: "memory");
}
__device__ __forceinline__ bf16 l1_gate_raw(const unsigned char* ws, int t, int h, int i) { return l1_tensor(ws, 20)[(size_t)t * 128 + 3 * h + i]; }
__device__ __forceinline__ float l1_gate(const unsigned char* ws, int t, int h, int i) { return sigmoidf_(bf2f(l1_tensor(ws, 20)[(size_t)t * 128 + 3 * h + i])); }
constexpr float SCALE_C = 0.08838834764831845f;
#ifndef WIN_MFMA
#define WIN_MFMA 1
#endif
#ifndef COMPRESS_MFMA
#define COMPRESS_MFMA 1
#endif

__device__ __forceinline__ void l1_stage_a(const Params& P, LAS unsigned char* lds, int tid, int lane, int wave, int wg, int G) {
    unsigned char* ws = P.ws;
#if !COMPRESS_MFMA
    {
        LAS float* kts = (LAS float*)lds;
        LAS float* pos_s = (LAS float*)(lds + 73728);
        LAS float* red = (LAS float*)(lds + 90112);
        float* hid = (float*)(ws + WS_HID);
        for (int task = wg; task < 512; task += G) {
            const int kv = task >> 8, g = (task >> 7) & 1, n0 = (task & 127) * 8;
            const bf16* src = l1_tensor(ws, (kv ? 10 : 8) + g); const float* pos = P.in[kv ? I_POSV : I_POSK]; const float* w1 = P.in[kv ? I_V1 : I_K1];
            for (int i = tid; i < 144 * 128; i += NTHR) { const int tok = 16 * n0 + (i >> 7); kts[i] = tok < T ? bf2f(src[(size_t)tok * 128 + (i & 127)]) : 0.f; }
            for (int i = tid; i < 32 * 128; i += NTHR) pos_s[i] = pos[i];
            __syncthreads();
            const int j = tid & 255, half = tid >> 8;
            float acc[8];
#pragma unroll
            for (int i = 0; i < 8; ++i) acc[i] = 0.f;
            for (int l = half * 16; l < half * 16 + 16; ++l)
                for (int d4 = 0; d4 < 32; ++d4) {
                    const float* wp = w1 + (size_t)(l * 128 + 4 * d4) * 256 + j; const float wa = wp[0], wb = wp[256], wc_ = wp[512], wd = wp[768];
                    const f4 pv = *(const LAS f4*)(pos_s + l * 128 + 4 * d4);
#pragma unroll
                    for (int i = 0; i < 8; ++i) { const f4 kk = *(const LAS f4*)(kts + (16 * i + l) * 128 + 4 * d4);
                        acc[i] += ((kk.x + pv.x) * wa + (kk.y + pv.y) * wb) + ((kk.z + pv.z) * wc_ + (kk.w + pv.w) * wd); }
                }
            if (half == 1) {
#pragma unroll
                for (int i = 0; i < 8; ++i) red[i * 256 + j] = acc[i]; }
            __syncthreads();
            if (half == 0) {
#pragma unroll
                for (int i = 0; i < 8; ++i) { const int n = n0 + i; if (n < 1023) hid[((size_t)(kv * 1024 + n) * 2 + g) * 256 + j] = gelu_tanh(acc[i] + red[i * 256 + j]); } }
            __syncthreads();
        }
    }
#endif
#if !WIN_MFMA
    const float* btab = (const float*)(ws + WS_BT); float* ocw = (float*)(ws + WS_OCW);
    LAS float* qs = (LAS float*)(lds + wave * 8192);
    for (int task = wg * NWAVES + wave; task < T * 2; task += G * NWAVES) {
        const int t = task >> 1, g = task & 1;
        l1_load_q(ws, t, g, qs, lane);
        float m[4], l[4], o[4][2];
#pragma unroll
        for (int p = 0; p < 4; ++p) { m[p] = -INFINITY; l[p] = 0.f; o[p][0] = 0.f; o[p][1] = 0.f; }
        const int lo = t >= 511 ? t - 511 : 0;
        for (int key0 = lo; key0 <= t; key0 += 64)
            wattn_tile<128, 4, 0>(l1_tensor(ws, 16 + g), l1_tensor(ws, 18 + g), 128, key0, t + 1, t, 1, 0, 512, qs, btab, 4 * g, SCALE_C, m, l, o, nullptr, lane);
#pragma unroll
        for (int p = 0; p < 4; ++p) { const float gt = l1_gate(ws, t, 4 * g + p, 2) / fmaxf(l[p], 1e-30f);
            *(float2*)(ocw + (size_t)t * 1024 + (4 * g + p) * 128 + 2 * lane) = make_float2(gt * o[p][0], gt * o[p][1]); }
        asm volatile("" ::: "memory");
    }
#endif
}
__device__ __forceinline__ void l1_stage_b(const Params& P, int tid, int wg, int G) {
    unsigned char* ws = P.ws; const float* hid = (const float*)(ws + WS_HID); bf16* kc = (bf16*)(ws + WS_KCMP);
    for (int idx = wg * NTHR + tid; idx < 2 * 2 * 1023 * 128; idx += G * NTHR) {
        const int d = idx & 127; int r = idx >> 7; const int n = r % 1023; r /= 1023; const int g = r & 1, kv = r >> 1;
        const float* hp = hid + ((size_t)(kv * 1024 + n) * 2 + g) * 256; const float* w2 = P.in[kv ? I_V2 : I_K2] + d; float s = 0.f;
#pragma unroll 8
        for (int j = 0; j < 256; ++j) s += hp[j] * w2[(size_t)j * 128];
        kc[((size_t)(kv * 2 + g) * 1024 + n) * 128 + d] = (bf16)f2bf(s);
    }
}
__device__ __forceinline__ void l1_stage_c(const Params& P, LAS unsigned char* lds, int tid, int lane, int wave, int wg, int G) {
    unsigned char* ws = P.ws;
    const float* btab = (const float*)(ws + WS_BT); float* ocw = (float*)(ws + WS_OCW); unsigned* selmask = (unsigned*)(ws + WS_SELMASK);
    LAS float* qs = (LAS float*)(lds + wave * 8192); LAS float* cs = qs + 512 + 8;
    for (int task = wg * NWAVES + wave; task < T * 2; task += G * NWAVES) {
        const int t = task >> 1, g = task & 1, cur = t >> 6;
        l1_load_q(ws, t, g, qs, lane);
        for (int i = lane; i < 1040; i += 64) cs[i - 4] = 0.f;
        LDS_WAIT(); asm volatile("" ::: "memory");
        const bf16* kc = (const bf16*)(ws + WS_KCMP) + (size_t)(0 * 2 + g) * 1024 * 128; const bf16* vc = (const bf16*)(ws + WS_KCMP) + (size_t)(1 * 2 + g) * 1024 * 128;
        int nvalid = t >= 31 ? ((t - 31) >> 4) + 1 : 0; if (nvalid > 1023) nvalid = 1023;
        float m[4], l[4], o[4][2];
#pragma unroll
        for (int p = 0; p < 4; ++p) { m[p] = -INFINITY; l[p] = 0.f; o[p][0] = 0.f; o[p][1] = 0.f; }
        for (int key0 = 0; key0 < nvalid; key0 += 64)
            wattn_tile<128, 4, 1>(kc, vc, 128, key0, nvalid, t, 16, 31, 0x7fffffff, qs, btab, 4 * g, SCALE_C, m, l, o, cs, lane);
#pragma unroll
        for (int p = 0; p < 4; ++p) l[p] = 1.f / fmaxf(l[p], 1e-30f);
        for (int key0 = 0; key0 < nvalid; key0 += 64)
            wattn_tile<128, 4, 2>(kc, vc, 128, key0, nvalid, t, 16, 31, 0x7fffffff, qs, btab, 4 * g, SCALE_C, m, l, o, cs, lane);
#pragma unroll
        for (int p = 0; p < 4; ++p) { const float gt = l1_gate(ws, t, 4 * g + p, 0); float2* op = (float2*)(ocw + (size_t)t * 1024 + (4 * g + p) * 128 + 2 * lane);
            float2 v = *op; v.x += gt * o[p][0]; v.y += gt * o[p][1]; *op = v; }
        LDS_WAIT(); asm volatile("" ::: "memory");
        float iv[4];
#pragma unroll
        for (int i = 0; i < 4; ++i) { const int j = lane + 64 * i; float v = cs[4 * j - 1] + cs[4 * j] + cs[4 * j + 1] + cs[4 * j + 2] + cs[4 * j + 3];
            if (j == 0 || j == cur || j == cur - 1) v += 1e4f;
            if (j > cur) v = -1e30f;
            iv[i] = v; }
        unsigned mk[4] = {0u, 0u, 0u, 0u};
        for (int r = 0; r < 16; ++r) {
            float bv = iv[0]; int bi = lane;
#pragma unroll
            for (int i = 1; i < 4; ++i) if (iv[i] > bv) { bv = iv[i]; bi = lane + 64 * i; }
            wave_argmax(bv, bi); bi = __builtin_amdgcn_readfirstlane(bi);
            if (!(bv > -5e29f)) break;
#pragma unroll
            for (int i = 0; i < 4; ++i) if (lane + 64 * i == bi) { iv[i] = -INFINITY; mk[i] = 1u; }
        }
#pragma unroll
        for (int i = 0; i < 4; ++i) { const unsigned long long bal = __ballot(mk[i] != 0u);
            if (lane == 0) { selmask[((size_t)t * 2 + g) * 8 + 2 * i] = (unsigned)bal; selmask[((size_t)t * 2 + g) * 8 + 2 * i + 1] = (unsigned)(bal >> 32); } }
        asm volatile("" ::: "memory");
    }
}
__device__ __forceinline__ void l1_stage_d(const Params& P, LAS unsigned char* lds, int tid, int lane, int wave, int wg, int G) {
    unsigned char* ws = P.ws;
    const float* btab = (const float*)(ws + WS_BT); const float* ocw = (const float*)(ws + WS_OCW); const unsigned* selmask = (const unsigned*)(ws + WS_SELMASK);
    bf16* attnout = (bf16*)(ws + WS_XN);
    LAS float* qs = (LAS float*)(lds + wave * 8192);
    for (int task = wg * NWAVES + wave; task < T * 2; task += G * NWAVES) {
        const int t = task >> 1, g = task & 1;
        l1_load_q(ws, t, g, qs, lane);
        float m[4], l[4], o[4][2];
#pragma unroll
        for (int p = 0; p < 4; ++p) { m[p] = -INFINITY; l[p] = 0.f; o[p][0] = 0.f; o[p][1] = 0.f; }
        for (int w = 0; w < 8; ++w) {
            unsigned bits = __builtin_amdgcn_readfirstlane(selmask[((size_t)t * 2 + g) * 8 + w]);
            while (bits) { const int b = __builtin_ctz(bits); bits &= bits - 1u; const int key0 = (32 * w + b) * 64; const int kend = (key0 + 64) < (t + 1) ? (key0 + 64) : (t + 1);
                wattn_tile<128, 4, 0>(l1_tensor(ws, 12 + g), l1_tensor(ws, 14 + g), 128, key0, kend, t, 1, 0, 0x7fffffff, qs, btab, 4 * g, SCALE_C, m, l, o, nullptr, lane); }
        }
#pragma unroll
        for (int p = 0; p < 4; ++p) { const float gt = l1_gate(ws, t, 4 * g + p, 1) / fmaxf(l[p], 1e-30f); const float2 base = *(const float2*)(ocw + (size_t)t * 1024 + (4 * g + p) * 128 + 2 * lane);
            *(unsigned*)(attnout + (size_t)t * 1024 + (4 * g + p) * 128 + 2 * lane) = pk2(base.x + gt * o[p][0], base.y + gt * o[p][1]); }
        asm volatile("" ::: "memory");
    }
}

typedef short bf16x8 __attribute__((ext_vector_type(8)));
typedef short v4i16_t __attribute__((ext_vector_type(4)));
typedef float f32x16 __attribute__((ext_vector_type(16)));
typedef unsigned u4 __attribute__((ext_vector_type(4)));
template <int DH> struct AT { static constexpr int PK = DH * 2 + 16, TILE = 64 * PK, NKS = DH / 16, NDT = DH / 32, CPT = DH / 64; };
template <int DH> __device__ __forceinline__ int v_off(int row, int ch) {
    if (DH == 128) return 256 * row + 16 * (ch ^ (((row & 3) << 2) | ((row >> 2) & 3)));
    else return 128 * row + 16 * (ch ^ ((((row >> 1) & 1) << 2) | (((row >> 2) & 1) << 1) | ((row >> 3) & 1)));
}
constexpr int AT_BT_OFF = 4 * AT<128>::TILE;

template <int DH> __device__ __forceinline__ void at_load(const bf16* __restrict__ Kg, const bf16* __restrict__ Vg, int ldk, int key0, int kmax, u4 (&kr)[AT<DH>::CPT], u4 (&vr)[AT<DH>::CPT], int tid) {
#pragma unroll
    for (int i = 0; i < AT<DH>::CPT; ++i) { const int cid = tid + 512 * i, key = cid / (DH / 8), cc = cid % (DH / 8); int row = key0 + key; row = row < kmax ? row : kmax;
        kr[i] = *(const u4*)(Kg + (size_t)row * ldk + cc * 8); vr[i] = *(const u4*)(Vg + (size_t)row * ldk + cc * 8); }
}
template <int DH> __device__ __forceinline__ void at_load_k(const bf16* __restrict__ Kg, int ldk, int key0, int kmax, u4 (&kr)[AT<DH>::CPT], int tid) {
#pragma unroll
    for (int i = 0; i < AT<DH>::CPT; ++i) { const int cid = tid + 512 * i, key = cid / (DH / 8), cc = cid % (DH / 8); int row = key0 + key; row = row < kmax ? row : kmax;
        kr[i] = *(const u4*)(Kg + (size_t)row * ldk + cc * 8); }
}
template <int DH> __device__ __forceinline__ void at_store_k(LAS unsigned char* Kl, const u4 (&kr)[AT<DH>::CPT], int tid) {
#pragma unroll
    for (int i = 0; i < AT<DH>::CPT; ++i) { const int cid = tid + 512 * i, key = cid / (DH / 8), cc = cid % (DH / 8); *(LAS u4*)(Kl + key * AT<DH>::PK + cc * 16) = kr[i]; }
}
template <int DH> __device__ __forceinline__ void at_store(LAS unsigned char* Kl, LAS unsigned char* Vl, const u4 (&kr)[AT<DH>::CPT], const u4 (&vr)[AT<DH>::CPT], int tid) {
#pragma unroll
    for (int i = 0; i < AT<DH>::CPT; ++i) { const int cid = tid + 512 * i, key = cid / (DH / 8), cc = cid % (DH / 8);
        *(LAS u4*)(Kl + key * AT<DH>::PK + cc * 16) = kr[i]; *(LAS u4*)(Vl + v_off<DH>(key, cc)) = vr[i]; }
}
template <int DH, int KB = AT<DH>::NKS> __device__ __forceinline__ void at_qk(const LAS unsigned char* Kl, const bf16x8 (&qf)[AT<DH>::NKS], f32x16 (&s)[2], int r, int h) {
#pragma unroll
    for (int kt = 0; kt < 2; ++kt) {
        f32x16 a0;
#pragma unroll
        for (int i = 0; i < 16; ++i) a0[i] = 0.f;
#pragma unroll
        for (int k0 = 0; k0 < AT<DH>::NKS; k0 += KB) {
            bf16x8 kf[KB];
#pragma unroll
            for (int ks = 0; ks < KB; ++ks) kf[ks] = *(const LAS bf16x8*)(Kl + (32 * kt + r) * AT<DH>::PK + (16 * (k0 + ks) + 8 * h) * 2);
            asm volatile("" ::: "memory");
#pragma unroll
            for (int ks = 0; ks < KB; ++ks) a0 = __builtin_amdgcn_mfma_f32_32x32x16_bf16(kf[ks], qf[k0 + ks], a0, 0, 0, 0);
        }
        s[kt] = a0; }
}
template <int POSMUL, int POSADD, int DMAX> __device__ __forceinline__ float at_mask(f32x16 (&s)[2], int key0, int kend, int t_row, bool rowsel, const LAS float* brow, float scale, int h) {
    float lm = -INFINITY;
#pragma unroll
    for (int kt = 0; kt < 2; ++kt)
#pragma unroll
        for (int i4 = 0; i4 < 16; i4 += 4) {
            float bv[4];
#pragma unroll
            for (int i = i4; i < i4 + 4; ++i) { const int key = key0 + 32 * kt + (i & 3) + 8 * (i >> 2) + 4 * h; const int d = t_row - (POSMUL * key + POSADD); const int dd = d < 0 ? 0 : (d > 127 ? 127 : d); bv[i - i4] = brow[dd]; }
            asm volatile("" ::: "memory");
#pragma unroll
            for (int i = i4; i < i4 + 4; ++i) { const int key = key0 + 32 * kt + (i & 3) + 8 * (i >> 2) + 4 * h; const int d = t_row - (POSMUL * key + POSADD);
                const bool valid = rowsel && key < kend && (unsigned)d < (unsigned)DMAX;
                const float v = valid ? s[kt][i] * scale + bv[i - i4] : -INFINITY; s[kt][i] = v; lm = fmaxf(lm, v); }
        }
    return lm;
}
template <int DH, int DB = ((DH == 128) ? 1 : 2)> __device__ __forceinline__ void at_pv(const LAS unsigned char* Vl, const f32x16 (&s)[2], f32x16 (&o)[AT<DH>::NDT], int lane) {
    bf16x8 pb[4];
#pragma unroll
    for (int kt = 0; kt < 2; ++kt)
#pragma unroll
        for (int s2 = 0; s2 < 2; ++s2) { u4 w; w.x = pg8::cvt_pk_bf16(s[kt][8 * s2 + 0], s[kt][8 * s2 + 1]); w.y = pg8::cvt_pk_bf16(s[kt][8 * s2 + 2], s[kt][8 * s2 + 3]);
            w.z = pg8::cvt_pk_bf16(s[kt][8 * s2 + 4], s[kt][8 * s2 + 5]); w.w = pg8::cvt_pk_bf16(s[kt][8 * s2 + 6], s[kt][8 * s2 + 7]); pb[2 * kt + s2] = __builtin_bit_cast(bf16x8, w); }
    const int i16 = lane & 15, q4 = i16 >> 2, p4 = i16 & 3, half = (lane >> 4) & 1, h = lane >> 5;
#pragma unroll
    for (int dp = 0; dp < AT<DH>::NDT; dp += DB) {
        v4i16_t lo[4 * DB], hi[4 * DB];
#pragma unroll
        for (int d2 = 0; d2 < DB; ++d2)
#pragma unroll
            for (int ks4 = 0; ks4 < 4; ++ks4) {
                const int row = 16 * ks4 + 4 * h + q4, ch = 4 * (dp + d2) + 2 * half + (p4 >> 1);
                lo[4 * d2 + ks4] = __builtin_amdgcn_ds_read_tr16_b64_v4i16((LAS v4i16_t*)(Vl + v_off<DH>(row, ch) + 8 * (p4 & 1)));
                hi[4 * d2 + ks4] = __builtin_amdgcn_ds_read_tr16_b64_v4i16((LAS v4i16_t*)(Vl + v_off<DH>(row + 8, ch) + 8 * (p4 & 1))); }
        if (DB == 2) asm volatile("s_waitcnt lgkmcnt(0)" : "+v"(lo[0]), "+v"(lo[1]), "+v"(lo[2]), "+v"(lo[3]), "+v"(lo[4 * (DB - 1)]), "+v"(lo[4 * (DB - 1) + 1]), "+v"(lo[4 * (DB - 1) + 2]), "+v"(lo[4 * (DB - 1) + 3]),
                                  "+v"(hi[0]), "+v"(hi[1]), "+v"(hi[2]), "+v"(hi[3]), "+v"(hi[4 * (DB - 1)]), "+v"(hi[4 * (DB - 1) + 1]), "+v"(hi[4 * (DB - 1) + 2]), "+v"(hi[4 * (DB - 1) + 3]) :: "memory");
        else asm volatile("s_waitcnt lgkmcnt(0)" : "+v"(lo[0]), "+v"(lo[1]), "+v"(lo[2]), "+v"(lo[3]), "+v"(hi[0]), "+v"(hi[1]), "+v"(hi[2]), "+v"(hi[3]) :: "memory");
#pragma unroll
        for (int ks4 = 0; ks4 < 4; ++ks4)
#pragma unroll
            for (int d2 = 0; d2 < DB; ++d2) { const v4i16_t l_ = lo[4 * d2 + ks4], h_ = hi[4 * d2 + ks4];
                const bf16x8 a = {l_[0], l_[1], l_[2], l_[3], h_[0], h_[1], h_[2], h_[3]};
                o[dp + d2] = __builtin_amdgcn_mfma_f32_32x32x16_bf16(a, pb[ks4], o[dp + d2], 0, 0, 0); }
#pragma unroll
        for (int d2 = 0; d2 < DB; ++d2) asm volatile("" : "+v"(o[dp + d2]) :: "memory");
    }
}
template <int DH> __device__ __forceinline__ void at_softmax(f32x16 (&s)[2], float lm, float& m_run, float& l_run, f32x16 (&o)[AT<DH>::NDT]) {
    lm = fmaxf(lm, __shfl_xor(lm, 32));
    const float mn = fmaxf(m_run, lm); const float ms = (mn == -INFINITY) ? 0.f : mn;
    const float alpha = __expf(m_run - ms); m_run = mn;
    float ps = 0.f;
#pragma unroll
    for (int kt = 0; kt < 2; ++kt)
#pragma unroll
        for (int i = 0; i < 16; ++i) { const float p = __expf(s[kt][i] - ms); s[kt][i] = p; ps += p; }
    l_run = l_run * alpha + ps;
#pragma unroll
    for (int dt = 0; dt < AT<DH>::NDT; ++dt)
#pragma unroll
        for (int i = 0; i < 16; ++i) o[dt][i] *= alpha;
}
__device__ __forceinline__ void at_load_bt(const unsigned char* ws, LAS unsigned char* lds, int tid) {
    const float* bt = (const float*)(ws + WS_BT); LAS float* d = (LAS float*)(lds + AT_BT_OFF);
    for (int i = tid; i < 1024; i += NTHR) d[i] = bt[i];
}

constexpr float LOG2E = 1.4426950408889634f;
__device__ __forceinline__ float dpp_quad_xor1(float v) { return __builtin_bit_cast(float, __builtin_amdgcn_update_dpp(0, __builtin_bit_cast(int, v), 0xB1, 0xf, 0xf, false)); }
__device__ __forceinline__ float dpp_quad_xor2(float v) { return __builtin_bit_cast(float, __builtin_amdgcn_update_dpp(0, __builtin_bit_cast(int, v), 0x4E, 0xf, 0xf, false)); }
__device__ __forceinline__ unsigned wave_max_u32(unsigned v) {
    v = max(v, (unsigned)__builtin_amdgcn_update_dpp(0, (int)v, 0x128, 0xf, 0xf, false));
    v = max(v, (unsigned)__builtin_amdgcn_update_dpp(0, (int)v, 0x124, 0xf, 0xf, false));
    v = max(v, (unsigned)__builtin_amdgcn_update_dpp(0, (int)v, 0x122, 0xf, 0xf, false));
    v = max(v, (unsigned)__builtin_amdgcn_update_dpp(0, (int)v, 0x121, 0xf, 0xf, false));
    const auto a = __builtin_amdgcn_permlane16_swap(v, v, false, false); v = max(a[0], a[1]);
    const auto b = __builtin_amdgcn_permlane32_swap(v, v, false, false); v = max(b[0], b[1]);
    return v; }
__device__ __forceinline__ float max_xor32(float v) { const auto rr = __builtin_amdgcn_permlane32_swap(__builtin_bit_cast(unsigned, v), __builtin_bit_cast(unsigned, v), false, false);
    return fmaxf(__builtin_bit_cast(float, rr[0]), __builtin_bit_cast(float, rr[1])); }
__device__ __forceinline__ float max_xor16(float v) { const auto rr = __builtin_amdgcn_permlane16_swap(__builtin_bit_cast(unsigned, v), __builtin_bit_cast(unsigned, v), false, false);
    return fmaxf(__builtin_bit_cast(float, rr[0]), __builtin_bit_cast(float, rr[1])); }
constexpr float AT_THR = 8.f;
__device__ __forceinline__ void at_load_bt2(const unsigned char* ws, LAS unsigned char* lds, int off, int tid) {
    const float* bt = (const float*)(ws + WS_BT); LAS float* d = (LAS float*)(lds + off);
    for (int i = tid; i < 1024; i += NTHR) d[i] = bt[i] * LOG2E;
}
template <int POSMUL, int POSADD, int DMAX> __device__ __forceinline__ float at_scores(f32x16 (&s)[2], bool fast, int key0, int kend, int t_row, bool rowsel, const LAS float* brow2, float c1, int h) {
    float lm = -INFINITY;
    if (fast) {
#pragma unroll
        for (int kt = 0; kt < 2; ++kt)
#pragma unroll
            for (int i = 0; i < 16; ++i) lm = fmaxf(lm, s[kt][i]);
        lm = rowsel ? fmaf(lm, c1, brow2[127]) : -INFINITY;
    } else {
#pragma unroll
        for (int kt = 0; kt < 2; ++kt)
#pragma unroll
            for (int i4 = 0; i4 < 16; i4 += 4) {
                float bv[4];
#pragma unroll
                for (int i = i4; i < i4 + 4; ++i) { const int key = key0 + 32 * kt + (i & 3) + 8 * (i >> 2) + 4 * h; const int d = t_row - (POSMUL * key + POSADD); const int dd = d < 0 ? 0 : (d > 127 ? 127 : d); bv[i - i4] = brow2[dd]; }
                asm volatile("" ::: "memory");
#pragma unroll
                for (int i = i4; i < i4 + 4; ++i) { const int key = key0 + 32 * kt + (i & 3) + 8 * (i >> 2) + 4 * h; const int d = t_row - (POSMUL * key + POSADD);
                    const bool valid = rowsel && key < kend && (unsigned)d < (unsigned)DMAX;
                    const float v = valid ? fmaf(s[kt][i], c1, bv[i - i4]) : -INFINITY; s[kt][i] = v; lm = fmaxf(lm, v); }
            }
    }
    return max_xor32(lm);
}
__device__ __forceinline__ float at_probs(f32x16 (&s)[2], bool fast, bool rowsel, float bfar2, float c1, float sub) {
    float ps = 0.f;
    if (fast) { const float bb = rowsel ? (bfar2 - sub) : -INFINITY;
#pragma unroll
        for (int kt = 0; kt < 2; ++kt)
#pragma unroll
            for (int i = 0; i < 16; ++i) { const float p = __builtin_amdgcn_exp2f(fmaf(s[kt][i], c1, bb)); s[kt][i] = p; ps += p; }
    } else {
#pragma unroll
        for (int kt = 0; kt < 2; ++kt)
#pragma unroll
            for (int i = 0; i < 16; ++i) { const float p = __builtin_amdgcn_exp2f(s[kt][i] - sub); s[kt][i] = p; ps += p; }
    }
    return ps;
}
template <int DH, int POSMUL, int POSADD, int DMAX, int DB = ((DH == 128) ? 1 : 2), int KB = AT<DH>::NKS>
__device__ __forceinline__ void at_step(const LAS unsigned char* Kl, const LAS unsigned char* Vl, const bf16x8 (&qf)[AT<DH>::NKS], f32x16 (&o)[AT<DH>::NDT], float& m_run, float& l_run,
                                        bool fast, int key0, int kend, int t_row, bool rowsel, const LAS float* brow2, float c1, int r, int h, int lane) {
    f32x16 s[2];
    at_qk<DH, KB>(Kl, qf, s, r, h);
    const float lm = at_scores<POSMUL, POSADD, DMAX>(s, fast, key0, kend, t_row, rowsel, brow2, c1, h);
    if (!__all(lm <= m_run + AT_THR)) {
        const float mn = fmaxf(m_run, lm); const float ms = (mn == -INFINITY) ? 0.f : mn;
        const float alpha = __builtin_amdgcn_exp2f(m_run - ms); m_run = mn; l_run *= alpha;
#pragma unroll
        for (int dt = 0; dt < AT<DH>::NDT; ++dt)
#pragma unroll
            for (int i = 0; i < 16; ++i) o[dt][i] *= alpha;
    }
    const float sub = (m_run == -INFINITY) ? 0.f : m_run;
    l_run += at_probs(s, fast, rowsel, brow2[127], c1, sub);
    at_pv<DH, DB>(Vl, s, o, lane);
}

__device__ __forceinline__ void l1_window_mfma(const Params& P, LAS unsigned char* lds, int tid, int lane, int wave, int wg, int G) {
    unsigned char* ws = P.ws; float* ocw = (float*)(ws + WS_OCW);
    constexpr int TILE = AT<128>::TILE;
    at_load_bt2(ws, lds, AT_BT_OFF, tid);
    const int r = lane & 31, h = lane >> 5;
    for (int unit = wg; unit < 512; unit += G) {
        const int g = unit & 1, c = unit >> 1, t0 = 64 * c;
        const int t_row = t0 + 8 * wave + (r >> 2), head = 4 * g + (r & 3);
        const bf16* Kg = l1_tensor(ws, 16 + g); const bf16* Vg = l1_tensor(ws, 18 + g);
        bf16x8 qf[8];
        { const bf16* qrow = l1_tensor(ws, head) + (size_t)t_row * 128 + 8 * h;
#pragma unroll
          for (int ks = 0; ks < 8; ++ks) qf[ks] = *(const bf16x8*)(qrow + 16 * ks); }
        const bf16 graw = l1_gate_raw(ws, t_row, head, 2);
        const LAS float* brow = (const LAS float*)(lds + AT_BT_OFF) + head * 128;
        f32x16 o[4];
#pragma unroll
        for (int dt = 0; dt < 4; ++dt)
#pragma unroll
            for (int i = 0; i < 16; ++i) o[dt][i] = 0.f;
        float m_run = -INFINITY, l_run = 0.f;
        const int jlo = c >= 8 ? c - 8 : 0;
        u4 kr[2], vr[2];
        at_load<128>(Kg, Vg, 128, 64 * jlo, T - 1, kr, vr, tid);
        __syncthreads();
        for (int j = jlo; j <= c; ++j) {
            LAS unsigned char* Kl = lds + ((j - jlo) & 1) * 2 * TILE; LAS unsigned char* Vl = Kl + TILE;
            at_store<128>(Kl, Vl, kr, vr, tid);
            __syncthreads();
            if (j < c) at_load<128>(Kg, Vg, 128, 64 * (j + 1), T - 1, kr, vr, tid);
            const int dmin = t0 + 8 * wave - (64 * j + 63), dmax = t0 + 8 * wave + 7 - 64 * j;
            at_step<128, 1, 0, 512, 2>(Kl, Vl, qf, o, m_run, l_run, dmin >= 113 && dmax < 512, 64 * j, T, t_row, true, brow, SCALE_C * LOG2E, r, h, lane);
        }
        const float lt = l_run + __shfl_xor(l_run, 32);
        const float f = sigmoidf_(bf2f(graw)) / fmaxf(lt, 1e-30f);
        float* orow = ocw + (size_t)t_row * 1024 + head * 128 + 4 * h;
#pragma unroll
        for (int dt = 0; dt < 4; ++dt)
#pragma unroll
            for (int gq = 0; gq < 4; ++gq)
                *(float4*)(orow + 32 * dt + 8 * gq) = make_float4(o[dt][4 * gq] * f, o[dt][4 * gq + 1] * f, o[dt][4 * gq + 2] * f, o[dt][4 * gq + 3] * f);
    }
}

__device__ __forceinline__ void l1_sel_mfma(const Params& P, LAS unsigned char* lds, int tid, int lane, int wave, int wg, int G) {
    unsigned char* ws = P.ws; const float* ocw = (const float*)(ws + WS_OCW); const unsigned* selmask = (const unsigned*)(ws + WS_SELMASK);
    bf16* attnout = (bf16*)(ws + WS_XN);
    constexpr int TILE = AT<128>::TILE;
    LAS unsigned* selm = (LAS unsigned*)(lds + AT_BT_OFF + 4096);
    at_load_bt2(ws, lds, AT_BT_OFF, tid);
    const int r = lane & 31, h = lane >> 5;
    for (int u = wg; u < 512; u += G) {
        const int g = u & 1, k = u >> 1, c = k < 128 ? k : 383 - k, t0 = 64 * c;
        const int ql = 8 * wave + (r >> 2), t_row = t0 + ql, head = 4 * g + (r & 3);
        const bf16* Kg = l1_tensor(ws, 12 + g); const bf16* Vg = l1_tensor(ws, 14 + g);
        bf16x8 qf[8];
        { const bf16* qrow = l1_tensor(ws, head) + (size_t)t_row * 128 + 8 * h;
#pragma unroll
          for (int ks = 0; ks < 8; ++ks) qf[ks] = *(const bf16x8*)(qrow + 16 * ks); }
        const LAS float* brow = (const LAS float*)(lds + AT_BT_OFF) + head * 128;
        f32x16 o[4];
#pragma unroll
        for (int dt = 0; dt < 4; ++dt)
#pragma unroll
            for (int i = 0; i < 16; ++i) o[dt][i] = 0.f;
        float m_run = -INFINITY, l_run = 0.f;
        u4 kra[2], vra[2], krb[2], vrb[2];
        at_load<128>(Kg, Vg, 128, 0, T - 1, kra, vra, tid);
        if (c >= 1) at_load<128>(Kg, Vg, 128, 64, T - 1, krb, vrb, tid);
        __syncthreads();
        selm[tid] = selmask[((size_t)(t0 + (tid >> 3)) * 2 + g) * 8 + (tid & 7)];
#define SEL_STEP(KR, VR, BUF, J) do { const int j_ = (J); LAS unsigned char* Kl = lds + (BUF) * 2 * TILE; LAS unsigned char* Vl = Kl + TILE; \
            at_store<128>(Kl, Vl, KR, VR, tid); __syncthreads(); \
            if (j_ + 2 <= c) at_load<128>(Kg, Vg, 128, 64 * (j_ + 2), T - 1, KR, VR, tid); \
            const bool rowsel = (selm[ql * 8 + (j_ >> 5)] >> (j_ & 31)) & 1u; \
            if (__any(rowsel)) at_step<128, 1, 0, 0x7fffffff>(Kl, Vl, qf, o, m_run, l_run, t0 + 8 * wave - (64 * j_ + 63) >= 113, 64 * j_, T, t_row, rowsel, brow, SCALE_C * LOG2E, r, h, lane); } while (0)
        for (int j = 0; j <= c; j += 2) {
            SEL_STEP(kra, vra, 0, j);
            if (j + 1 <= c) SEL_STEP(krb, vrb, 1, j + 1);
        }
#undef SEL_STEP
        const float lt = l_run + __shfl_xor(l_run, 32);
        const float f = l1_gate(ws, t_row, head, 1) / fmaxf(lt, 1e-30f);
        const size_t ob = (size_t)t_row * 1024 + head * 128 + 4 * h;
#pragma unroll
        for (int dt = 0; dt < 4; ++dt)
#pragma unroll
            for (int gq = 0; gq < 4; ++gq) { const float4 b = *(const float4*)(ocw + ob + 32 * dt + 8 * gq);
                uint2 w; w.x = pk2(b.x + o[dt][4 * gq] * f, b.y + o[dt][4 * gq + 1] * f); w.y = pk2(b.z + o[dt][4 * gq + 2] * f, b.w + o[dt][4 * gq + 3] * f);
                *(uint2*)(attnout + ob + 32 * dt + 8 * gq) = w; }
    }
}

#define MOBA_INSERT(v_, idx_) do { const float v__ = (v_); const int x__ = (idx_); \
    const bool g0 = v__ > b0 || (v__ == b0 && x__ < i0), g1 = v__ > b1 || (v__ == b1 && x__ < i1), g2 = v__ > b2 || (v__ == b2 && x__ < i2); \
    const float nb2 = g1 ? b1 : (g2 ? v__ : b2); const int ni2 = g1 ? i1 : (g2 ? x__ : i2); \
    const float nb1 = g0 ? b0 : (g1 ? v__ : b1); const int ni1 = g0 ? i0 : (g1 ? x__ : i1); \
    const float nb0 = g0 ? v__ : b0; const int ni0 = g0 ? x__ : i0; \
    b0 = nb0; b1 = nb1; b2 = nb2; i0 = ni0; i1 = ni1; i2 = ni2; } while (0)
__device__ __forceinline__ void l0_moba_mfma(const Params& P, LAS unsigned char* lds, int tid, int lane, int wave, int wg, int G) {
    unsigned char* ws = P.ws; const bf16* proj = (const bf16*)(ws + WS_PROJ); bf16* attnout = (bf16*)(ws + WS_XN);
    const float* kmean = (const float*)(ws + WS_KMEAN);
    constexpr int TILE = AT<64>::TILE;
    LAS float* kml = (LAS float*)(lds + 81920);
    LAS unsigned* uni = (LAS unsigned*)(lds + 98304);
    at_load_bt2(ws, lds, AT_BT_OFF, tid);
    const int r = lane & 31, h = lane >> 5;
    for (int u = wg; u < 512; u += G) {
        const int head = u & 7, k = u >> 3, ob = k < 32 ? k : 95 - k, t0 = 256 * ob;
        const int t_row = t0 + 32 * wave + r;
        const bf16* Kg = proj + (size_t)1 * T * 512 + 64 * head; const bf16* Vg = proj + (size_t)2 * T * 512 + 64 * head;
        const bf16* qrow = proj + (size_t)t_row * 512 + 64 * head;
        __syncthreads();
        for (int i = tid; i < 64 * 64; i += NTHR) kml[i] = kmean[(size_t)head * 4096 + i];
        __syncthreads();
        unsigned mlo = 0u, mhi = 0u;
        {
            float qv[64];
#pragma unroll
            for (int i = 0; i < 8; ++i) { const u4 w = ((const u4*)qrow)[i]; qv[8 * i] = bflo(w.x); qv[8 * i + 1] = bfhi(w.x); qv[8 * i + 2] = bflo(w.y); qv[8 * i + 3] = bfhi(w.y);
                qv[8 * i + 4] = bflo(w.z); qv[8 * i + 5] = bfhi(w.z); qv[8 * i + 6] = bflo(w.w); qv[8 * i + 7] = bfhi(w.w); }
            float b0 = -INFINITY, b1 = -INFINITY, b2 = -INFINITY; int i0 = 0x7fffffff, i1 = 0x7fffffff, i2 = 0x7fffffff;
            for (int j = h; j < ob; j += 2) { const LAS f4* km = (const LAS f4*)(kml + j * 64); float sc = 0.f;
#pragma unroll
                for (int d4 = 0; d4 < 16; ++d4) { const f4 kv = km[d4]; sc += (kv.x * qv[4 * d4] + kv.y * qv[4 * d4 + 1]) + (kv.z * qv[4 * d4 + 2] + kv.w * qv[4 * d4 + 3]); }
                MOBA_INSERT(sc, j); }
            const float p0 = __shfl_xor(b0, 32), p1 = __shfl_xor(b1, 32), p2 = __shfl_xor(b2, 32); const int j0 = __shfl_xor(i0, 32), j1 = __shfl_xor(i1, 32), j2 = __shfl_xor(i2, 32);
            MOBA_INSERT(p0, j0); MOBA_INSERT(p1, j1); MOBA_INSERT(p2, j2);
            if (b0 > -INFINITY) { if (i0 < 32) mlo |= 1u << i0; else mhi |= 1u << (i0 - 32); }
            if (b1 > -INFINITY) { if (i1 < 32) mlo |= 1u << i1; else mhi |= 1u << (i1 - 32); }
            if (b2 > -INFINITY) { if (i2 < 32) mlo |= 1u << i2; else mhi |= 1u << (i2 - 32); }
        }
        {
            unsigned ulo = mlo, uhi = mhi;
#pragma unroll
            for (int o = 1; o < 64; o <<= 1) { ulo |= __shfl_xor(ulo, o); uhi |= __shfl_xor(uhi, o); }
            if (lane == 0) { uni[2 * wave] = ulo; uni[2 * wave + 1] = uhi; }
        }
        __syncthreads();
        unsigned long long un = 0ull;
#pragma unroll
        for (int w = 0; w < 8; ++w) un |= (unsigned long long)uni[2 * w] | ((unsigned long long)uni[2 * w + 1] << 32);
        un = ((unsigned long long)__builtin_amdgcn_readfirstlane((unsigned)(un >> 32)) << 32) | (unsigned long long)__builtin_amdgcn_readfirstlane((unsigned)un);
        un |= 1ull << ob;
        bf16x8 qf[4];
#pragma unroll
        for (int ks = 0; ks < 4; ++ks) qf[ks] = *(const bf16x8*)(qrow + 16 * ks + 8 * h);
        const LAS float* brow = (const LAS float*)(lds + AT_BT_OFF) + head * 128;
        f32x16 o[2];
#pragma unroll
        for (int dt = 0; dt < 2; ++dt)
#pragma unroll
            for (int i = 0; i < 16; ++i) o[dt][i] = 0.f;
        float m_run = -INFINITY, l_run = 0.f;
        LAS int* tl = (LAS int*)(lds + 98304 + 64);
        if (tid < 64 && ((un >> tid) & 1ull)) { const int pos = __builtin_popcountll(un & ((1ull << tid) - 1ull));
#pragma unroll
            for (int tt = 0; tt < 4; ++tt) tl[4 * pos + tt] = 256 * tid + 64 * tt; }
        const int nt = 4 * __builtin_popcountll(un);
        __syncthreads();
        u4 kra[1], vra[1], krb[1], vrb[1];
        at_load<64>(Kg, Vg, 512, tl[0], T - 1, kra, vra, tid);
        at_load<64>(Kg, Vg, 512, tl[1], T - 1, krb, vrb, tid);
#define MOBA_STEP(KR, VR, BUF, I) do { const int i_ = (I); LAS unsigned char* Kl = lds + (BUF) * 2 * TILE; LAS unsigned char* Vl = Kl + TILE; \
            at_store<64>(Kl, Vl, KR, VR, tid); __syncthreads(); \
            if (i_ + 2 < nt) at_load<64>(Kg, Vg, 512, tl[i_ + 2], T - 1, KR, VR, tid); \
            const int key0 = tl[i_], j = key0 >> 8, tt = (key0 >> 6) & 3; const bool own = (j == ob); \
            const bool rowsel = own ? true : (bool)(((j < 32 ? mlo >> j : mhi >> (j - 32)) & 1u) != 0u); \
            const bool wave_on = own ? (32 * wave + 31 >= 64 * tt) : (__any(rowsel) != 0); \
            if (wave_on) at_step<64, 1, 0, 0x7fffffff>(Kl, Vl, qf, o, m_run, l_run, t0 + 32 * wave - (key0 + 63) >= 113, key0, T, t_row, rowsel, brow, 0.125f * LOG2E, r, h, lane); } while (0)
        for (int i = 0; i < nt; i += 2) { MOBA_STEP(kra, vra, 0, i); MOBA_STEP(krb, vrb, 1, i + 1); }
#undef MOBA_STEP
        const float lt = l_run + __shfl_xor(l_run, 32);
        const float f = 1.f / fmaxf(lt, 1e-30f);
        bf16* orow = attnout + (size_t)t_row * 1024 + 64 * head + 4 * h;
#pragma unroll
        for (int dt = 0; dt < 2; ++dt)
#pragma unroll
            for (int gq = 0; gq < 4; ++gq) { uint2 w; w.x = pk2(o[dt][4 * gq] * f, o[dt][4 * gq + 1] * f); w.y = pk2(o[dt][4 * gq + 2] * f, o[dt][4 * gq + 3] * f);
                *(uint2*)(orow + 32 * dt + 8 * gq) = w; }
    }
}

__device__ __forceinline__ void l1_cmp_mfma(const Params& P, LAS unsigned char* lds, int tid, int lane, int wave, int wg, int G) {
    unsigned char* ws = P.ws; float* ocw = (float*)(ws + WS_OCW); unsigned* selmask = (unsigned*)(ws + WS_SELMASK);
    constexpr int TILE = AT<128>::TILE, BT_OFF = 2 * TILE, IMP_OFF = BT_OFF + 4096;
    LAS float* imp = (LAS float*)(lds + IMP_OFF);
    at_load_bt2(ws, lds, BT_OFF, tid);
    const int r = lane & 31, h = lane >> 5;
    const float c1 = SCALE_C * LOG2E;
    LAS unsigned char* Kl = lds; LAS unsigned char* Vl = lds + TILE;
    for (int u = wg; u < 512; u += G) {
        const int g = u & 1, k = u >> 1, c = k < 128 ? k : 383 - k, t0 = 64 * c;
        const int ql = 8 * wave + (r >> 2), t_row = t0 + ql, head = 4 * g + (r & 3);
        const bf16* Kg = (const bf16*)(ws + WS_KCMP) + (size_t)(0 * 2 + g) * 1024 * 128; const bf16* Vg = (const bf16*)(ws + WS_KCMP) + (size_t)(1 * 2 + g) * 1024 * 128;
        const int NV = (4 * c + 3) < 1023 ? (4 * c + 3) : 1023, ntiles = (NV + 63) >> 6;
        bf16x8 qf[8];
        { const bf16* qrow = l1_tensor(ws, head) + (size_t)t_row * 128 + 8 * h;
#pragma unroll
          for (int ks = 0; ks < 8; ++ks) qf[ks] = *(const bf16x8*)(qrow + 16 * ks); }
        const LAS float* brow = (const LAS float*)(lds + BT_OFF) + head * 128;
        float m_run = -INFINITY, l_run = 0.f;
        u4 kr[2], vr[2];
        at_load_k<128>(Kg, 128, 0, 1022, kr, tid);
#pragma unroll 1
        for (int tl = 0; tl < ntiles; ++tl) {
            __syncthreads();
            at_store_k<128>(Kl, kr, tid);
            __syncthreads();
            if (tl + 1 < ntiles) at_load_k<128>(Kg, 128, 64 * (tl + 1), 1022, kr, tid);
            f32x16 s[2];
            at_qk<128, 4>(Kl, qf, s, r, h);
            const bool fast = (64 * tl + 63 < NV) && (t0 + 8 * wave - (16 * (64 * tl + 63) + 31) >= 113);
            const float lm = at_scores<16, 31, 0x7fffffff>(s, fast, 64 * tl, NV, t_row, true, brow, c1, h);
            if (!__all(lm <= m_run + AT_THR)) { const float mn = fmaxf(m_run, lm); const float ms = (mn == -INFINITY) ? 0.f : mn; l_run *= __builtin_amdgcn_exp2f(m_run - ms); m_run = mn; }
            l_run += at_probs(s, fast, true, brow[127], c1, (m_run == -INFINITY) ? 0.f : m_run);
        }
        at_load<128>(Kg, Vg, 128, 0, 1022, kr, vr, tid);
        const float ltot = fmaxf(l_run + __shfl_xor(l_run, 32), 1e-30f);
        const float sub2 = ((m_run == -INFINITY) ? 0.f : m_run) + __builtin_amdgcn_logf(ltot);
        f32x16 o[4];
#pragma unroll
        for (int dt = 0; dt < 4; ++dt)
#pragma unroll
            for (int i = 0; i < 16; ++i) o[dt][i] = 0.f;
        float y_prev = 0.f;
#pragma unroll 1
        for (int tl = 0; tl < ntiles; ++tl) {
            __syncthreads();
            at_store<128>(Kl, Vl, kr, vr, tid);
            __syncthreads();
            if (tl + 1 < ntiles) at_load<128>(Kg, Vg, 128, 64 * (tl + 1), 1022, kr, vr, tid);
            f32x16 s[2];
            {
                int zoff = 0; asm volatile("" : "+v"(zoff));
                const bf16* qrow2 = l1_tensor(ws, head) + (size_t)t_row * 128 + 8 * h + zoff; bf16x8 qf2[8];
#pragma unroll
                for (int ks = 0; ks < 8; ++ks) qf2[ks] = *(const bf16x8*)(qrow2 + 16 * ks);
                at_qk<128, 4>(Kl, qf2, s, r, h);
            }
            const bool fast = (64 * tl + 63 < NV) && (t0 + 8 * wave - (16 * (64 * tl + 63) + 31) >= 113);
            (void)at_scores<16, 31, 0x7fffffff>(s, fast, 64 * tl, NV, t_row, true, brow, c1, h);
            (void)at_probs(s, fast, true, brow[127], c1, sub2);
#pragma unroll
            for (int idx = 0; idx < 8; ++idx) { const int kt = idx >> 2, gq = idx & 3;
                float g4 = (s[kt][4 * gq] + s[kt][4 * gq + 1]) + (s[kt][4 * gq + 2] + s[kt][4 * gq + 3]); float la = s[kt][4 * gq + 3];
                g4 += dpp_quad_xor1(g4); g4 += dpp_quad_xor2(g4); la += dpp_quad_xor1(la); la += dpp_quad_xor2(la);
                const auto sw = __builtin_amdgcn_permlane32_swap(__builtin_bit_cast(unsigned, la), __builtin_bit_cast(unsigned, la), false, false);
                const float y_cur = __builtin_bit_cast(float, h ? sw[0] : sw[1]);
                const float v = g4 + (h ? y_cur : y_prev); y_prev = y_cur;
                if ((r & 3) == 0) imp[ql * 256 + 16 * tl + 2 * idx + h] = v; }
            at_pv<128>(Vl, s, o, lane);
        }
        {
            const float f = l1_gate(ws, t_row, head, 0);
            float* orow = ocw + (size_t)t_row * 1024 + head * 128 + 4 * h;
#pragma unroll
            for (int dt = 0; dt < 4; ++dt)
#pragma unroll
                for (int gq = 0; gq < 4; ++gq) { float4 b = *(float4*)(orow + 32 * dt + 8 * gq);
                    b.x += o[dt][4 * gq] * f; b.y += o[dt][4 * gq + 1] * f; b.z += o[dt][4 * gq + 2] * f; b.w += o[dt][4 * gq + 3] * f; *(float4*)(orow + 32 * dt + 8 * gq) = b; }
        }
        __syncthreads();
        const int nsel = (c + 1) < 16 ? (c + 1) : 16;
#pragma unroll 1
        for (int qi = 0; qi < 8; ++qi) {
            const int q = 8 * wave + qi, t = t0 + q;
            unsigned key[4];
#pragma unroll
            for (int i = 0; i < 4; ++i) { const int j = lane + 64 * i; float v = imp[q * 256 + j];
                if (j == 0 || j == c || j == c - 1) v += 1e4f;
                key[i] = (j <= c) ? ((__builtin_bit_cast(unsigned, v) & 0xFFFFFF00u) | (unsigned)(255 - j)) : 0u; }
            unsigned mk[4] = {0u, 0u, 0u, 0u};
            for (int rr = 0; rr < nsel; ++rr) {
                const unsigned m = wave_max_u32(max(max(key[0], key[1]), max(key[2], key[3])));
#pragma unroll
                for (int i = 0; i < 4; ++i) if (m != 0u && key[i] == m) { key[i] = 0u; mk[i] = 1u; }
            }
#pragma unroll
            for (int i = 0; i < 4; ++i) { const unsigned long long bal = __ballot(mk[i] != 0u);
                if (lane == 0) { selmask[((size_t)t * 2 + g) * 8 + 2 * i] = (unsigned)bal; selmask[((size_t)t * 2 + g) * 8 + 2 * i + 1] = (unsigned)(bal >> 32); } }
        }
    }
}

struct EpiF32P {
    static constexpr bool PERM = false, AFTER_DRAIN = false;
    float* C; int ldc;
    __device__ __forceinline__ void operator()(const pg8::f32x4 (&acc)[2][2][4][2], const pg8::Unit& u, int wr, int wc, int fr, int fq) const {
        const int row0 = u.pm * 256 + wr * 64 + fr, col0 = u.pn * 256 + wc * 32 + 4 * fq;
#pragma unroll
        for (int ai = 0; ai < 2; ++ai)
#pragma unroll
            for (int m = 0; m < 4; ++m) { float* rowp = C + (size_t)(row0 + ai * 128 + m * 16) * ldc + col0;
#pragma unroll
                for (int bj = 0; bj < 2; ++bj)
#pragma unroll
                    for (int n = 0; n < 2; ++n) *(pg8::f32x4*)(rowp + bj * 128 + n * 16) = acc[ai][bj][m][n]; }
    }
};
struct OneUnit { int pm;
    __device__ __forceinline__ bool next(int i, pg8::Unit& u) const { if (i) return false; u.pm = pm; u.pn = 0; return true; }
    __device__ __forceinline__ void a_ready(const pg8::Unit&) const {}
    __device__ __forceinline__ void done(const pg8::Unit&) const {}
};
__device__ __forceinline__ void l1_compress_gemm(const Params& P, LAS unsigned char* lds, int tid, int wg) {
    unsigned char* ws = P.ws;
    if (wg < 64) {
        const int prob = wg >> 2, pm = wg & 3, kv = prob >> 3, g = (prob >> 2) & 1, sp = prob & 3;
        pg8::Gemm gm{l1_tensor(ws, (kv ? 10 : 8) + g) + sp * 1024, (const bf16*)(ws + (kv ? WS_CW1V : WS_CW1K)) + sp * 1024, 1024, 256, 1024, 2048, 4096};
        OneUnit S{pm}; EpiF32P E{(float*)(ws + WS_CPART) + (size_t)((sp * 2 + kv) * 2 + g) * 1024 * 256, 256};
        pg8::gemm_phase<EpiF32P, OneUnit, true, true>((PG8_LAS unsigned char*)lds, gm, S, E);
    } else if (wg < 96) {
        const int tq = wg - 64, kv = tq >> 4, l = 2 * (tq & 15) + (tid >> 8), j = tid & 255;
        const float* pos = P.in[kv ? I_POSV : I_POSK] + l * 128; const float* w1 = P.in[kv ? I_V1 : I_K1] + (size_t)l * 128 * 256 + j; float s = 0.f;
#pragma unroll 8
        for (int d = 0; d < 128; ++d) s += pos[d] * w1[(size_t)d * 256];
        ((float*)(ws + WS_POSP))[(kv * 32 + l) * 256 + j] = s;
    }
}
__device__ __forceinline__ void l1_compress_out(const Params& P, LAS unsigned char* lds, int tid, int wg, int G) {
    unsigned char* ws = P.ws; const float* part = (const float*)(ws + WS_CPART); const float* posp = (const float*)(ws + WS_POSP); bf16* kc = (bf16*)(ws + WS_KCMP);
    LAS float* pb = (LAS float*)lds; LAS float* hs = (LAS float*)(lds + 1024);
    for (int task = wg; task < 256; task += G) {
        const int kv = task >> 7, g = (task >> 6) & 1, n0 = (task & 63) * 16;
        __syncthreads();
        if (tid < 256) { float s = 0.f;
#pragma unroll 8
            for (int l = 0; l < 32; ++l) s += posp[(kv * 32 + l) * 256 + tid]; pb[tid] = s; }
        __syncthreads();
#pragma unroll
        for (int i = 0; i < 8; ++i) { const int e = tid + 512 * i, row = e >> 8, j = e & 255; float s = pb[j];
#pragma unroll
            for (int sp = 0; sp < 4; ++sp) s += part[((size_t)((sp * 2 + kv) * 2 + g) * 1024 + n0 + row) * 256 + j];
            hs[e] = gelu_tanh(s); }
        __syncthreads();
        const int d = tid & 127, rq = tid >> 7; const float* w2 = P.in[kv ? I_V2 : I_K2] + d; float acc[4] = {0.f, 0.f, 0.f, 0.f};
        for (int j = 0; j < 256; ++j) { const float w = w2[(size_t)j * 128];
#pragma unroll
            for (int i = 0; i < 4; ++i) acc[i] += hs[(rq + 4 * i) * 256 + j] * w; }
#pragma unroll
        for (int i = 0; i < 4; ++i) { const int n = n0 + rq + 4 * i; if (n < 1023) kc[((size_t)(kv * 2 + g) * 1024 + n) * 128 + d] = (bf16)f2bf(acc[i]); }
    }
}

__device__ __forceinline__ void l0_route(const Params& P, LAS unsigned char* lds, int tid, int lane, int wave, int wg, int G) {
    unsigned char* ws = P.ws; const bf16* proj = (const bf16*)(ws + WS_PROJ); const float* kmean = (const float*)(ws + WS_KMEAN);
    unsigned long long* selq = (unsigned long long*)(ws + WS_SELQ); unsigned* selT = (unsigned*)(ws + WS_SELT);
    LAS float* kml = (LAS float*)lds;
    const int r = lane & 31, h = lane >> 5;
    for (int u = wg; u < 512; u += G) {
        const int head = u & 7, k = u >> 3, ob = k < 32 ? k : 95 - k, t_row = 256 * ob + 32 * wave + r;
        const bf16* qrow = proj + (size_t)t_row * 512 + 64 * head;
        __syncthreads();
        for (int i = tid; i < 64 * 64; i += NTHR) kml[i] = kmean[(size_t)head * 4096 + i];
        __syncthreads();
        unsigned mlo = 0u, mhi = 0u;
        float qv[64];
#pragma unroll
        for (int i = 0; i < 8; ++i) { const u4 w = ((const u4*)qrow)[i]; qv[8 * i] = bflo(w.x); qv[8 * i + 1] = bfhi(w.x); qv[8 * i + 2] = bflo(w.y); qv[8 * i + 3] = bfhi(w.y);
            qv[8 * i + 4] = bflo(w.z); qv[8 * i + 5] = bfhi(w.z); qv[8 * i + 6] = bflo(w.w); qv[8 * i + 7] = bfhi(w.w); }
        float b0 = -INFINITY, b1 = -INFINITY, b2 = -INFINITY; int i0 = 0x7fffffff, i1 = 0x7fffffff, i2 = 0x7fffffff;
        for (int j = h; j < ob; j += 2) { const LAS f4* km = (const LAS f4*)(kml + j * 64); float sc = 0.f;
#pragma unroll
            for (int d4 = 0; d4 < 16; ++d4) { const f4 kv = km[d4]; sc += (kv.x * qv[4 * d4] + kv.y * qv[4 * d4 + 1]) + (kv.z * qv[4 * d4 + 2] + kv.w * qv[4 * d4 + 3]); }
            MOBA_INSERT(sc, j); }
        const float p0 = __shfl_xor(b0, 32), p1 = __shfl_xor(b1, 32), p2 = __shfl_xor(b2, 32); const int j0 = __shfl_xor(i0, 32), j1 = __shfl_xor(i1, 32), j2 = __shfl_xor(i2, 32);
        MOBA_INSERT(p0, j0); MOBA_INSERT(p1, j1); MOBA_INSERT(p2, j2);
        if (b0 > -INFINITY) { if (i0 < 32) mlo |= 1u << i0; else mhi |= 1u << (i0 - 32); }
        if (b1 > -INFINITY) { if (i1 < 32) mlo |= 1u << i1; else mhi |= 1u << (i1 - 32); }
        if (b2 > -INFINITY) { if (i2 < 32) mlo |= 1u << i2; else mhi |= 1u << (i2 - 32); }
        if (h == 0) selq[(size_t)t_row * 8 + head] = ((unsigned long long)mhi << 32) | (unsigned long long)mlo;
        for (int j = 0; j < ob; ++j) { const unsigned bit = ((j < 32 ? mlo >> j : mhi >> (j - 32)) & 1u); const unsigned long long bal = __ballot(bit != 0u);
            if (lane == 0) selT[((size_t)(head * 64 + j) * 64 + ob) * 8 + wave] = (unsigned)bal; }
    }
}
__device__ __forceinline__ void moba_write_partial(unsigned char* ws, const f32x16 (&o)[2], float m_run, float l_run, int tq, int head, int slot, bool valid_row, int h) {
    const float lt = l_run + __shfl_xor(l_run, 32); const float inv = 1.f / fmaxf(lt, 1e-30f);
    if (valid_row) { const size_t rec = ((size_t)tq * 8 + head) * 4 + slot; bf16* po = (bf16*)(ws + WS_PO) + rec * 64 + 4 * h;
#pragma unroll
        for (int dt = 0; dt < 2; ++dt)
#pragma unroll
            for (int gq = 0; gq < 4; ++gq) { uint2 w; w.x = pk2(o[dt][4 * gq] * inv, o[dt][4 * gq + 1] * inv); w.y = pk2(o[dt][4 * gq + 2] * inv, o[dt][4 * gq + 3] * inv);
                *(uint2*)(po + 32 * dt + 8 * gq) = w; }
        if (h == 0) ((float2*)(ws + WS_PML))[rec] = make_float2(m_run, lt); }
}
constexpr int MOBA_NB = 8 * (15 + 31 + 47 + 63);
constexpr int MOBA_NU = MOBA_NB + 512;
__device__ __forceinline__ void l0_moba_gather(const Params& P, LAS unsigned char* lds, int tid, int lane, int wave, int wg, int G) {
    unsigned char* ws = P.ws; const bf16* proj = (const bf16*)(ws + WS_PROJ);
    const unsigned long long* selq = (const unsigned long long*)(ws + WS_SELQ); const unsigned* selT = (const unsigned*)(ws + WS_SELT);
    unsigned* queue = (unsigned*)(ws + WS_CTL) + CW_QUEUE;
    constexpr int TILE = AT<64>::TILE, BTO = 8 * TILE;
    LAS int* rows = (LAS int*)(lds + BTO + 4096);
    LAS unsigned* wsum = (LAS unsigned*)(lds + BTO + 4096 + 16384);
    at_load_bt2(ws, lds, BTO, tid);
    const int r = lane & 31, h = lane >> 5;
    const float c1 = 0.125f * LOG2E;
    int unit = wg, it = 0;
    while (unit < MOBA_NU) {
        if (tid == 0) wsum[16 + (it & 1)] = __hip_atomic_fetch_add(queue, 1u, __ATOMIC_RELAXED, __HIP_MEMORY_SCOPE_AGENT) + (unsigned)G;
        __syncthreads();
        if (unit < MOBA_NB) {
            int rg, rem; if (unit < 120) { rg = 0; rem = unit; } else if (unit < 368) { rg = 1; rem = unit - 120; } else if (unit < 744) { rg = 2; rem = unit - 368; } else { rg = 3; rem = unit - 744; }
            const int head = rem & 7, j = rem >> 3;
            const bf16* Kg = proj + (size_t)1 * T * 512 + 64 * head; const bf16* Vg = proj + (size_t)2 * T * 512 + 64 * head;
            const LAS float* brow = (const LAS float*)(lds + BTO) + head * 128;
            const int ob = 16 * rg + (tid >> 5), word = (tid & 31) >> 2, sh = 8 * (tid & 3);
            unsigned bits = (ob > j && ob <= 63) ? ((selT[((size_t)(head * 64 + j) * 64 + ob) * 8 + word] >> sh) & 0xffu) : 0u;
#pragma unroll
            for (int tt = 0; tt < 4; ++tt) { u4 kr[1], vr[1]; at_load<64>(Kg, Vg, 512, 256 * j + 64 * tt, T - 1, kr, vr, tid); at_store<64>(lds + tt * TILE, lds + (4 + tt) * TILE, kr, vr, tid); }
            const int cnt = __builtin_popcount(bits); int incl = cnt;
#pragma unroll
            for (int o_ = 1; o_ < 64; o_ <<= 1) { const int v = __shfl_up(incl, o_); if (lane >= o_) incl += v; }
            if (lane == 63) wsum[wave] = (unsigned)incl;
            __syncthreads();
            int base = 0, n = 0;
#pragma unroll
            for (int w = 0; w < 8; ++w) { const int x = (int)wsum[w]; if (w < wave) base += x; n += x; }
            int pos = base + incl - cnt;
            while (bits) { const int b = __builtin_ctz(bits); bits &= bits - 1u; rows[pos++] = 256 * ob + 8 * (tid & 31) + b; }
            __syncthreads();
            const int ntile = (n + 31) >> 5;
            for (int tile = wave; tile < ntile; tile += NWAVES) {
                const int idx = 32 * tile + r; const bool valid_row = idx < n; const int tq = rows[valid_row ? idx : (n - 1)];
                const int tmin = __builtin_amdgcn_readfirstlane(rows[32 * tile]);
                const bf16* qrow = proj + (size_t)tq * 512 + 64 * head;
                bf16x8 qf[4];
#pragma unroll
                for (int ks = 0; ks < 4; ++ks) qf[ks] = *(const bf16x8*)(qrow + 16 * ks + 8 * h);
                const unsigned long long sq = selq[(size_t)tq * 8 + head];
                f32x16 o[2];
#pragma unroll
                for (int dt = 0; dt < 2; ++dt)
#pragma unroll
                    for (int i = 0; i < 16; ++i) o[dt][i] = 0.f;
                float m_run = -INFINITY, l_run = 0.f;
#pragma unroll 1
                for (int tt = 0; tt < 4; ++tt) { const int key0 = 256 * j + 64 * tt;
                    at_step<64, 1, 0, 0x7fffffff>(lds + tt * TILE, lds + (4 + tt) * TILE, qf, o, m_run, l_run, tmin - (key0 + 63) >= 113, key0, T, tq, true, brow, c1, r, h, lane); }
                const int slot = __builtin_popcountll(sq & ((1ull << j) - 1ull));
                moba_write_partial(ws, o, m_run, l_run, tq, head, slot, valid_row, h);
            }
        } else {
            const int ua = unit - MOBA_NB, head = ua & 7, ob = 63 - (ua >> 3), t0 = 256 * ob, t_row = t0 + 32 * wave + r;
            const bf16* Kg = proj + (size_t)1 * T * 512 + 64 * head; const bf16* Vg = proj + (size_t)2 * T * 512 + 64 * head;
            const LAS float* brow = (const LAS float*)(lds + BTO) + head * 128;
            const bf16* qrow = proj + (size_t)t_row * 512 + 64 * head;
            bf16x8 qf[4];
#pragma unroll
            for (int ks = 0; ks < 4; ++ks) qf[ks] = *(const bf16x8*)(qrow + 16 * ks + 8 * h);
            f32x16 o[2];
#pragma unroll
            for (int dt = 0; dt < 2; ++dt)
#pragma unroll
                for (int i = 0; i < 16; ++i) o[dt][i] = 0.f;
            float m_run = -INFINITY, l_run = 0.f;
            u4 kr[1], vr[1];
            at_load<64>(Kg, Vg, 512, t0, T - 1, kr, vr, tid);
#pragma unroll 1
            for (int tt = 0; tt < 4; ++tt) {
                LAS unsigned char* Kl = lds + (tt & 1) * 2 * TILE; LAS unsigned char* Vl = Kl + TILE;
                at_store<64>(Kl, Vl, kr, vr, tid);
                __syncthreads();
                if (tt < 3) at_load<64>(Kg, Vg, 512, t0 + 64 * (tt + 1), T - 1, kr, vr, tid);
                if (32 * wave + 31 >= 64 * tt)
                    at_step<64, 1, 0, 0x7fffffff>(Kl, Vl, qf, o, m_run, l_run, false, t0 + 64 * tt, T, t_row, true, brow, c1, r, h, lane);
            }
            moba_write_partial(ws, o, m_run, l_run, t_row, head, 3, true, h);
        }
        __syncthreads();
        unit = (int)wsum[16 + (it & 1)]; ++it;
    }
}
__device__ __forceinline__ void l0_moba_merge(const Params& P, int tid, int wg, int G) {
    unsigned char* ws = P.ws; const unsigned long long* selq = (const unsigned long long*)(ws + WS_SELQ);
    const bf16* po = (const bf16*)(ws + WS_PO); const float2* pml = (const float2*)(ws + WS_PML); bf16* attnout = (bf16*)(ws + WS_XN);
    constexpr int NIT = T * 8 * 16;
    for (int idx0 = wg * NTHR + tid; idx0 < NIT; idx0 += 4 * G * NTHR) {
        unsigned long long sq[4]; float2 ml[4][4]; uint2 pv[4][4];
#pragma unroll
        for (int u = 0; u < 4; ++u) { const int idx = idx0 + u * G * NTHR; const int ic = idx < NIT ? idx : idx0; const int dq = ic & 15, th = ic >> 4;
            sq[u] = selq[th];
#pragma unroll
            for (int s_ = 0; s_ < 4; ++s_) { ml[u][s_] = pml[(size_t)th * 4 + s_]; pv[u][s_] = *(const uint2*)(po + ((size_t)th * 4 + s_) * 64 + 4 * dq); } }
#pragma unroll
        for (int u = 0; u < 4; ++u) { const int idx = idx0 + u * G * NTHR;
            if (idx < NIT) {
                const int dq = idx & 15, th = idx >> 4; const int cnt = __builtin_popcountll(sq[u]);
                float M = ml[u][3].x;
#pragma unroll
                for (int s_ = 0; s_ < 3; ++s_) { if (s_ >= cnt) { ml[u][s_] = make_float2(-INFINITY, 0.f); pv[u][s_] = make_uint2(0u, 0u); } M = fmaxf(M, ml[u][s_].x); }
                float a0 = 0.f, a1 = 0.f, a2 = 0.f, a3 = 0.f, den = 0.f;
#pragma unroll
                for (int s_ = 0; s_ < 4; ++s_) { const float w = ml[u][s_].y * __builtin_amdgcn_exp2f(ml[u][s_].x - M); const uint2 v = pv[u][s_];
                    a0 += w * bflo(v.x); a1 += w * bfhi(v.x); a2 += w * bflo(v.y); a3 += w * bfhi(v.y); den += w; }
                const float inv = 1.f / fmaxf(den, 1e-30f);
                uint2 o; o.x = pk2(a0 * inv, a1 * inv); o.y = pk2(a2 * inv, a3 * inv);
                *(uint2*)(attnout + (size_t)(th >> 3) * 1024 + 64 * (th & 7) + 4 * dq) = o;
            }
        }
    }
}

typedef float f32x4v __attribute__((ext_vector_type(4)));
__device__ __forceinline__ void at16_step(const LAS unsigned char* Kl, const LAS unsigned char* Vl, const bf16x8 (&qf)[4], f32x4v (&o)[8], float& m_run, float& l_run,
                                          bool fast, int key0, int kend, int t_row, bool rowsel, const LAS float* brow2, float bfar_in, float c1, int lane) {
    constexpr int PK = AT<128>::PK;
    const int r16 = lane & 15, gl = lane >> 4;
    f32x4v s[4];
    {
        bf16x8 kf[16];
#pragma unroll
        for (int kt = 0; kt < 4; ++kt)
#pragma unroll
            for (int ks = 0; ks < 4; ++ks) kf[4 * kt + ks] = *(const LAS bf16x8*)(Kl + (16 * kt + r16) * PK + (32 * ks + 8 * gl) * 2);
        asm volatile("" ::: "memory");
#pragma unroll
        for (int kt = 0; kt < 4; ++kt) s[kt] = (f32x4v){0.f, 0.f, 0.f, 0.f};
#pragma unroll
        for (int ks = 0; ks < 4; ++ks)
#pragma unroll
            for (int kt = 0; kt < 4; ++kt) s[kt] = __builtin_amdgcn_mfma_f32_16x16x32_bf16(kf[4 * kt + ks], qf[ks], s[kt], 0, 0, 0);
    }
    float bfar = bfar_in;
    float lm = -INFINITY;
    if (!fast) {
        float bv[16];
#pragma unroll
        for (int kt = 0; kt < 4; ++kt)
#pragma unroll
            for (int i = 0; i < 4; ++i) { const int d = t_row - (key0 + 16 * kt + 4 * gl + i); const int dd = d < 0 ? 0 : (d > 127 ? 127 : d); bv[4 * kt + i] = brow2[dd]; }
        asm volatile("" ::: "memory");
#pragma unroll
        for (int kt = 0; kt < 4; ++kt)
#pragma unroll
            for (int i = 0; i < 4; ++i) { const int key = key0 + 16 * kt + 4 * gl + i; const int d = t_row - key;
                const bool valid = rowsel && key < kend && d >= 0;
                const float v = valid ? fmaf(s[kt][i], c1, bv[4 * kt + i]) : -INFINITY; s[kt][i] = v; lm = fmaxf(lm, v); }
    }
    asm volatile("s_waitcnt lgkmcnt(0)" : "+v"(bfar) :: "memory");
    const int q4 = r16 >> 2, p4 = r16 & 3;
    v4i16_t lo0[8], hi0[8];
#pragma unroll
    for (int d4 = 0; d4 < 4; ++d4)
#pragma unroll
        for (int s2 = 0; s2 < 2; ++s2) { const int row = 32 * s2 + 4 * gl + q4, ch = 2 * d4 + (p4 >> 1);
            lo0[2 * d4 + s2] = __builtin_amdgcn_ds_read_tr16_b64_v4i16((LAS v4i16_t*)(Vl + v_off<128>(row, ch) + 8 * (p4 & 1)));
            hi0[2 * d4 + s2] = __builtin_amdgcn_ds_read_tr16_b64_v4i16((LAS v4i16_t*)(Vl + v_off<128>(row + 16, ch) + 8 * (p4 & 1))); }
    asm volatile("" ::: "memory");
    if (fast) {
#pragma unroll
        for (int kt = 0; kt < 4; ++kt)
#pragma unroll
            for (int i = 0; i < 4; ++i) lm = fmaxf(lm, s[kt][i]);
        lm = rowsel ? fmaf(lm, c1, bfar) : -INFINITY;
    }
    lm = max_xor32(max_xor16(lm));
    if (!__all(lm <= m_run + AT_THR)) {
        const float mn = fmaxf(m_run, lm); const float ms = (mn == -INFINITY) ? 0.f : mn;
        const float alpha = __builtin_amdgcn_exp2f(m_run - ms); m_run = mn; l_run *= alpha;
#pragma unroll
        for (int dt = 0; dt < 8; ++dt)
#pragma unroll
            for (int i = 0; i < 4; ++i) o[dt][i] *= alpha;
    }
    const float sub = (m_run == -INFINITY) ? 0.f : m_run;
    float ps = 0.f;
    if (fast) { const float bb = rowsel ? (bfar - sub) : -INFINITY;
#pragma unroll
        for (int kt = 0; kt < 4; ++kt)
#pragma unroll
            for (int i = 0; i < 4; ++i) { const float p = __builtin_amdgcn_exp2f(fmaf(s[kt][i], c1, bb)); s[kt][i] = p; ps += p; }
    } else {
#pragma unroll
        for (int kt = 0; kt < 4; ++kt)
#pragma unroll
            for (int i = 0; i < 4; ++i) { const float p = __builtin_amdgcn_exp2f(s[kt][i] - sub); s[kt][i] = p; ps += p; }
    }
    l_run += ps;
    bf16x8 pb[2];
#pragma unroll
    for (int s2 = 0; s2 < 2; ++s2) { u4 w; w.x = pg8::cvt_pk_bf16(s[2 * s2][0], s[2 * s2][1]); w.y = pg8::cvt_pk_bf16(s[2 * s2][2], s[2 * s2][3]);
        w.z = pg8::cvt_pk_bf16(s[2 * s2 + 1][0], s[2 * s2 + 1][1]); w.w = pg8::cvt_pk_bf16(s[2 * s2 + 1][2], s[2 * s2 + 1][3]); pb[s2] = __builtin_bit_cast(bf16x8, w); }
    asm volatile("s_waitcnt lgkmcnt(0)" : "+v"(lo0[0]), "+v"(lo0[1]), "+v"(lo0[2]), "+v"(lo0[3]), "+v"(lo0[4]), "+v"(lo0[5]), "+v"(lo0[6]), "+v"(lo0[7]),
                 "+v"(hi0[0]), "+v"(hi0[1]), "+v"(hi0[2]), "+v"(hi0[3]), "+v"(hi0[4]), "+v"(hi0[5]), "+v"(hi0[6]), "+v"(hi0[7]) :: "memory");
    v4i16_t lo1[8], hi1[8];
#pragma unroll
    for (int d4 = 0; d4 < 4; ++d4)
#pragma unroll
        for (int s2 = 0; s2 < 2; ++s2) { const int row = 32 * s2 + 4 * gl + q4, ch = 2 * (4 + d4) + (p4 >> 1);
            lo1[2 * d4 + s2] = __builtin_amdgcn_ds_read_tr16_b64_v4i16((LAS v4i16_t*)(Vl + v_off<128>(row, ch) + 8 * (p4 & 1)));
            hi1[2 * d4 + s2] = __builtin_amdgcn_ds_read_tr16_b64_v4i16((LAS v4i16_t*)(Vl + v_off<128>(row + 16, ch) + 8 * (p4 & 1))); }
    asm volatile("" ::: "memory");
#pragma unroll
    for (int s2 = 0; s2 < 2; ++s2)
#pragma unroll
        for (int d4 = 0; d4 < 4; ++d4) { const v4i16_t l_ = lo0[2 * d4 + s2], h_ = hi0[2 * d4 + s2];
            const bf16x8 a = {l_[0], l_[1], l_[2], l_[3], h_[0], h_[1], h_[2], h_[3]};
            o[d4] = __builtin_amdgcn_mfma_f32_16x16x32_bf16(a, pb[s2], o[d4], 0, 0, 0); }
    asm volatile("s_waitcnt lgkmcnt(0)" : "+v"(lo1[0]), "+v"(lo1[1]), "+v"(lo1[2]), "+v"(lo1[3]), "+v"(lo1[4]), "+v"(lo1[5]), "+v"(lo1[6]), "+v"(lo1[7]),
                 "+v"(hi1[0]), "+v"(hi1[1]), "+v"(hi1[2]), "+v"(hi1[3]), "+v"(hi1[4]), "+v"(hi1[5]), "+v"(hi1[6]), "+v"(hi1[7]) :: "memory");
#pragma unroll
    for (int s2 = 0; s2 < 2; ++s2)
#pragma unroll
        for (int d4 = 0; d4 < 4; ++d4) { const v4i16_t l_ = lo1[2 * d4 + s2], h_ = hi1[2 * d4 + s2];
            const bf16x8 a = {l_[0], l_[1], l_[2], l_[3], h_[0], h_[1], h_[2], h_[3]};
            o[4 + d4] = __builtin_amdgcn_mfma_f32_16x16x32_bf16(a, pb[s2], o[4 + d4], 0, 0, 0); }
}
__device__ __forceinline__ void l1_sel16(const Params& P, LAS unsigned char* lds, int tid, int lane, int wave, int wg, int G) {
    unsigned char* ws = P.ws; const float* ocw = (const float*)(ws + WS_OCW); const unsigned* selmask = (const unsigned*)(ws + WS_SELMASK);
    bf16* attnout = (bf16*)(ws + WS_XN);
    constexpr int TILE = AT<128>::TILE;
    LAS unsigned* selm = (LAS unsigned*)(lds + AT_BT_OFF + 4096);
    at_load_bt2(ws, lds, AT_BT_OFF, tid);
    const int r16 = lane & 15, gl = lane >> 4;
    for (int u = wg; u < 512; u += G) {
        const int g = u & 1, k = u >> 1, c = k < 128 ? k : 383 - k, t0 = 64 * c;
        const int head = 4 * g + (r16 & 3);
        const int ql0 = 8 * wave + (r16 >> 2), ql1 = ql0 + 4;
        const bf16* Kg = l1_tensor(ws, 12 + g); const bf16* Vg = l1_tensor(ws, 14 + g);
        bf16x8 qf0[4], qf1[4];
        { const bf16* q0 = l1_tensor(ws, head) + (size_t)(t0 + ql0) * 128 + 8 * gl; const bf16* q1 = l1_tensor(ws, head) + (size_t)(t0 + ql1) * 128 + 8 * gl;
#pragma unroll
          for (int ks = 0; ks < 4; ++ks) { qf0[ks] = *(const bf16x8*)(q0 + 32 * ks); qf1[ks] = *(const bf16x8*)(q1 + 32 * ks); } }
        const LAS float* brow = (const LAS float*)(lds + AT_BT_OFF) + head * 128;
        f32x4v o0[8], o1[8];
#pragma unroll
        for (int dt = 0; dt < 8; ++dt) { o0[dt] = (f32x4v){0.f, 0.f, 0.f, 0.f}; o1[dt] = (f32x4v){0.f, 0.f, 0.f, 0.f}; }
        float m0 = -INFINITY, l0 = 0.f, m1 = -INFINITY, l1 = 0.f;
        u4 kra[2], vra[2];
        at_load<128>(Kg, Vg, 128, 0, T - 1, kra, vra, tid);
        __syncthreads();
        selm[tid] = selmask[((size_t)(t0 + (tid >> 3)) * 2 + g) * 8 + (tid & 7)];
        const float bfar_u = brow[127];
#define SEL16_STEP(KR, VR, BUF, J) do { const int j_ = (J); LAS unsigned char* Kl = lds + (BUF) * 2 * TILE; LAS unsigned char* Vl = Kl + TILE; \
            at_store<128>(Kl, Vl, KR, VR, tid); __syncthreads(); \
            if (j_ + 1 <= c) at_load<128>(Kg, Vg, 128, 64 * (j_ + 1), T - 1, KR, VR, tid); \
            const bool rs0 = (selm[ql0 * 8 + (j_ >> 5)] >> (j_ & 31)) & 1u, rs1 = (selm[ql1 * 8 + (j_ >> 5)] >> (j_ & 31)) & 1u; \
            const bool fast_ = t0 + 8 * wave - (64 * j_ + 63) >= 113; \
            if (__any(rs0)) at16_step(Kl, Vl, qf0, o0, m0, l0, fast_, 64 * j_, T, t0 + ql0, rs0, brow, bfar_u, SCALE_C * LOG2E, lane); \
            if (__any(rs1)) at16_step(Kl, Vl, qf1, o1, m1, l1, fast_, 64 * j_, T, t0 + ql1, rs1, brow, bfar_u, SCALE_C * LOG2E, lane); } while (0)
        for (int j = 0; j <= c; j += 2) {
            SEL16_STEP(kra, vra, 0, j);
            if (j + 1 <= c) SEL16_STEP(kra, vra, 1, j + 1);
        }
#undef SEL16_STEP
#pragma unroll
        for (int sb = 0; sb < 2; ++sb) {
            const int t_row = t0 + (sb ? ql1 : ql0); float lr = sb ? l1 : l0;
            lr += __shfl_xor(lr, 16); lr += __shfl_xor(lr, 32);
            const float f = l1_gate(ws, t_row, head, 1) / fmaxf(lr, 1e-30f);
            const size_t ob = (size_t)t_row * 1024 + head * 128 + 4 * gl;
#pragma unroll
            for (int dt = 0; dt < 8; ++dt) { const f32x4v ov = sb ? o1[dt] : o0[dt]; const float4 b = *(const float4*)(ocw + ob + 16 * dt);
                uint2 w; w.x = pk2(b.x + ov[0] * f, b.y + ov[1] * f); w.y = pk2(b.z + ov[2] * f, b.w + ov[3] * f);
                *(uint2*)(attnout + ob + 16 * dt) = w; }
        }
    }
}

constexpr int NPH = 21;
__global__ void __launch_bounds__(NTHR, 2) fwd(Params P) {
    extern __shared__ __attribute__((aligned(16))) unsigned char lds_raw[];
    LAS unsigned char* lds = (LAS unsigned char*)lds_raw;
    volatile LAS unsigned* MISC = (volatile LAS unsigned*)(lds + MISC_OFF);
    const int tid = threadIdx.x, lane = tid & 63, wave = __builtin_amdgcn_readfirstlane(tid >> 6), wg = blockIdx.x, G = gridDim.x;
    unsigned char* ws = P.ws;
    for (int u = tid; u < (LDS_BYTES - SCR_BYTES) / 4; u += NTHR) ((LAS unsigned*)(lds + SCR_BYTES))[u] = 0u;
    __syncthreads();
    const int lo = P.ph_lo, hi = P.ph_hi;
    XcdBarrier bar; bar.bar = (unsigned*)(ws + WS_CTL) + CW_BAR; bar.x = 0; bar.st = nullptr;
    if (hi - lo > 1) bar = xcd_barrier_post((unsigned*)(ws + WS_CTL) + CW_BAR, MISC + 8);
#ifndef PH_MASK
#define PH_MASK 0xFFFFFFFFu
#endif
#define IN(k) (lo <= (k) && (k) < hi && ((PH_MASK >> (k)) & 1u))
#ifndef REP_MASK
#define REP_MASK 0u
#endif
#define RPT(k) for (int rep_ = 0; rep_ < ((((REP_MASK) >> (k)) & 1u) ? 2 : 1); ++rep_)
#define RPTBAR do { if (rep_) xcd_barrier(bar); } while (0)
#define SEAM(k) do { if (IN(k) && IN((k) + 1)) xcd_barrier(bar); } while (0)
    const int gw = wg * NWAVES + wave, NGW = G * NWAVES;
    bf16* xn = (bf16*)(ws + WS_XN); bf16* proj = (bf16*)(ws + WS_PROJ); bf16* mb = (bf16*)(ws + WS_MB); bf16* ub = (bf16*)(ws + WS_U);

    if (IN(0)) { p0_prologue(P, lds, tid, lane, wave, wg, G); } SEAM(0);
    if (IN(1)) { run_gemm<0>(lds, xn, (const bf16*)(ws + WS_W0IN), T, N0IN, D, proj, 512, (size_t)T * 512, G, wg); } SEAM(1);
    if (IN(2)) { l0_stage_a(P, lds, tid, lane, wave, wg, G); } SEAM(2);
    if (IN(3)) { RPT(3) { RPTBAR; l0_stage_c(P, lds, tid, lane, wave, wg, G); l0_route(P, lds, tid, lane, wave, wg, G); } } SEAM(3);
    if (IN(4)) { l0_moba_gather(P, lds, tid, lane, wave, wg, G); } SEAM(4);
    if (IN(5)) { RPT(5) { RPTBAR; l0_moba_merge(P, tid, wg, G); } } SEAM(5);
    if (IN(6)) { run_gemm<0>(lds, xn, (const bf16*)(ws + WS_W0OUT), T, D, D, mb, 1024, 0, G, wg); } SEAM(6);
    if (IN(7)) { post_norm<0, 1>(P.in[I_X], P.out, mb, P.in[I_NMIXPOST], P.in[I_NMLPPRE], xn, lane, gw, NGW); } SEAM(7);
    if (IN(8)) { run_gemm<1>(lds, xn, (const bf16*)(ws + WS_W0UP), T, FF, D, ub, 4096, 0, G, wg); } SEAM(8);
    if (IN(9)) { run_gemm<0>(lds, ub, (const bf16*)(ws + WS_W0DN), T, D, FF, mb, 1024, 0, G, wg); } SEAM(9);
    if (IN(10)) { post_norm<1, 1>(P.out, P.out, mb, P.in[I_NMLPPOST], P.in[I_NMIXPRE] + D, xn, lane, gw, NGW); } SEAM(10);
    if (IN(11)) { run_gemm<0>(lds, xn, (const bf16*)(ws + WS_W1IN), T, N1IN, D, proj, 128, (size_t)T * 128, G, wg); } SEAM(11);
    if (IN(12)) { RPT(12) { RPTBAR; l1_compress_gemm(P, lds, tid, wg); __syncthreads(); l1_window_mfma(P, lds, tid, lane, wave, wg, G); } } SEAM(12);
    if (IN(13)) { l1_compress_out(P, lds, tid, wg, G); } SEAM(13);
    if (IN(14)) { l1_cmp_mfma(P, lds, tid, lane, wave, wg, G); } SEAM(14);
    if (IN(15)) { RPT(15) { RPTBAR; l1_sel16(P, lds, tid, lane, wave, wg, G); } } SEAM(15);
    if (IN(16)) { run_gemm<0>(lds, xn, (const bf16*)(ws + WS_W1OUT), T, D, D, mb, 1024, 0, G, wg); } SEAM(16);
    if (IN(17)) { post_norm<1, 1>(P.out, ws + WS_X3, mb, P.in[I_NMIXPOST] + D, P.in[I_NMLPPRE] + D, xn, lane, gw, NGW); } SEAM(17);
    if (IN(18)) { run_gemm<1>(lds, xn, (const bf16*)(ws + WS_W1UP), T, FF, D, ub, 4096, 0, G, wg); } SEAM(18);
    if (IN(19)) { run_gemm<0>(lds, ub, (const bf16*)(ws + WS_W1DN), T, D, FF, mb, 1024, 0, G, wg); } SEAM(19);
    if (IN(20)) { post_norm<1, 0>(ws + WS_X3, P.out, mb, P.in[I_NMLPPOST] + D, nullptr, xn, lane, gw, NGW); }
#undef IN
#undef SEAM
}

extern "C" void kernel_launch(void* const* d_in, const int* in_sizes, int n_in, void* d_out, int out_size, void* d_ws, size_t ws_size, hipStream_t stream) {
    static int grid = 0;
    if (grid == 0) {
        if (n_in != N_IN || in_sizes[0] != T * D || out_size != T * D || ws_size < WS_END) { fprintf(stderr, "kernel_launch: unexpected shapes (n_in %d, in0 %d, out %d, ws %zu); nothing launched\n", n_in, n_in > 0 ? in_sizes[0] : -1, out_size, ws_size); grid = -1; return; }
        int dev = 0, cus = 0, per_cu = 0;
        if (hipGetDevice(&dev) != hipSuccess || hipDeviceGetAttribute(&cus, hipDeviceAttributeMultiprocessorCount, dev) != hipSuccess) { grid = -1; return; }
        if (hipFuncSetAttribute((const void*)fwd, hipFuncAttributeMaxDynamicSharedMemorySize, LDS_BYTES) != hipSuccess) { fprintf(stderr, "kernel_launch: hipFuncSetAttribute failed\n"); grid = -1; return; }
        if (hipOccupancyMaxActiveBlocksPerMultiprocessor(&per_cu, (const void*)fwd, NTHR, LDS_BYTES) != hipSuccess || per_cu < 1) fprintf(stderr, "kernel_launch: occupancy query reports %d workgroups per CU\n", per_cu);
        (void)hipGetLastError();
        grid = cus;
        if (grid < 96) { fprintf(stderr, "kernel_launch: needs >= 96 CUs\n"); grid = -1; return; }
    }
    if (grid < 0) return;
    if (hipMemsetAsync((char*)d_ws + WS_CTL, 0, CTL_ZERO_BYTES, stream) != hipSuccess) return;
    Params p{};
    for (int i = 0; i < N_IN; ++i) p.in[i] = (const float*)d_in[i];
    p.out = (float*)d_out; p.ws = (unsigned char*)d_ws;
#if MK_ONE_LAUNCH
    p.ph_lo = 0; p.ph_hi = NPH;
    hipLaunchKernelGGL(fwd, dim3(grid), dim3(NTHR), LDS_BYTES, stream, p);
#else
    for (int k = 0; k < NPH; ++k) { p.ph_lo = k; p.ph_hi = k + 1; hipLaunchKernelGGL(fwd, dim3(grid), dim3(NTHR), LDS_BYTES, stream, p); }
#endif
}
```

```cpp
#include <hip/hip_runtime.h>
#include <cstdio>
#include <cstdint>
#ifndef MK_ONE_LAUNCH
#define MK_ONE_LAUNCH 1
#endif
#define GAS __attribute__((address_space(1)))
#define LAS __attribute__((address_space(3)))
namespace pg8 {
#define PG8_LAS __attribute__((address_space(3)))
typedef unsigned short bf16_t;
typedef short bf16x8 __attribute__((ext_vector_type(8)));
typedef float f32x4 __attribute__((ext_vector_type(4)));
typedef unsigned u32x4 __attribute__((ext_vector_type(4)));
constexpr int BM = 256, BK = 64, HALF = 128, HTB = HALF * BK * 2  , STAGE_BYTES = 8 * HTB, NXCD = 8, WGM = 8;

__host__ __device__ __forceinline__ int lds_byte(int r, int c) { const int st = (r >> 4) * 2 + (c >> 5), rr = r & 15, cc = c & 31, ob = rr * 64 + cc * 2; return st * 1024 + (ob ^ (((ob >> 9) & 1) << 5)); }
__host__ __device__ __forceinline__ void stage_rc(int b, int& R, int& C) { const int st = b / 1024, sb = b % 1024, swz = sb ^ (((sb >> 9) & 1) << 5); R = (st >> 1) * 16 + swz / 64; C = (st & 1) * 32 + (swz % 64) / 2; }
__host__ __device__ __forceinline__ int perm32(int rho) { const int n = rho >> 4, i = rho & 15; return 8 * (i >> 2) + 4 * n + (i & 3); }

struct Unit { int pm, pn; };
struct Gemm { const bf16_t* A; const bf16_t* Bt; int M, N, K, lda, ldb; };

struct StaticOrder {
    int nM, nN, nwg, G, c;
    __host__ __device__ void init(int M, int N, int G_, int c_) { nM = M / BM; nN = N / BM; nwg = nM * nN; G = G_; c = c_; }
    __host__ __device__ bool next(int i, Unit& u) const {
        const long L = (long)i * G + c; if (L >= nwg) return false;
        int wgid = (int)L; { const int q = nwg / NXCD, r = nwg % NXCD, xcd = wgid % NXCD, off = wgid / NXCD; wgid = (xcd < r ? xcd * (q + 1) : r * (q + 1) + (xcd - r) * q) + off; }
        const int nig = WGM * nN, gid = wgid / nig, fm = gid * WGM, gsz = (nM - fm) < WGM ? (nM - fm) : WGM;
        u.pm = fm + ((wgid % nig) % gsz); u.pn = (wgid % nig) / gsz; return true;
    }
    __device__ __forceinline__ void a_ready(const Unit&) const {}
    __device__ __forceinline__ void done(const Unit&) const {}
};

__device__ __forceinline__ unsigned cvt_pk_bf16(float lo, float hi) { unsigned r; asm volatile("v_cvt_pk_bf16_f32 %0, %1, %2" : "=v"(r) : "v"(lo), "v"(hi)); return r; }
template <class Epi, class Sched, bool ALIGN_EPI = false, bool SP2 = false>
__device__ __forceinline__ void gemm_phase(PG8_LAS unsigned char* lds, const Gemm g, const Sched& S, const Epi& E) {
    const int tid = threadIdx.x, wid = __builtin_amdgcn_readfirstlane(tid >> 6), lane = tid & 63, wr = wid >> 2, wc = wid & 3, fr = lane & 15, fq = lane >> 4;
    const int K = g.K, nt = K / BK;
    unsigned voffA[2], voffB[2];
#pragma unroll
    for (int i = 0; i < 2; ++i) { int R, C; stage_rc(tid * 16 + i * 8192, R, C); const int Rb = Epi::PERM ? ((R & ~31) + perm32(R & 31)) : R;
        voffA[i] = (unsigned)(R * g.lda + C) * 2u; voffB[i] = (unsigned)(Rb * g.ldb + C) * 2u; }
    const size_t kstep = (size_t)(BK * 2);
    const size_t hstepA = (size_t)HALF * g.lda * 2, hstepB = (size_t)HALF * g.ldb * 2;
    const size_t tstepA = 2 * hstepA, tstepB = 2 * hstepB;
    const unsigned ldsw = (unsigned)wid * 1024u;
    const int aoff = lds_byte(wr * 64 + fr, fq * 8), boff = lds_byte(wc * 32 + fr, fq * 8);
#define PG8_SA(b, h) (((b) * 2 + (h)) * HTB)
#define PG8_SB(b, h) ((4 + (b) * 2 + (h)) * HTB)
#define PG8_STAGE(bufoff, gbase, voff) do { _Pragma("unroll") for (int _i = 0; _i < 2; ++_i) \
        __builtin_amdgcn_global_load_lds((const unsigned*)((const char*)(gbase) + (voff)[_i]), (PG8_LAS unsigned*)(lds + (bufoff) + ldsw + _i * 8192), 16, 0, 0); } while (0)
#define PG8_LDA(dst, b, h) do { _Pragma("unroll") for (int m = 0; m < 4; ++m) _Pragma("unroll") for (int k = 0; k < 2; ++k) dst[m][k] = *(const PG8_LAS bf16x8*)(lds + PG8_SA(b, h) + aoff + m * 2048 + k * 1024); } while (0)
#define PG8_LDB(dst, b, h) do { _Pragma("unroll") for (int n = 0; n < 2; ++n) _Pragma("unroll") for (int k = 0; k < 2; ++k) dst[n][k] = *(const PG8_LAS bf16x8*)(lds + PG8_SB(b, h) + boff + n * 2048 + k * 1024); } while (0)
#define PG8_MMA(ai, bj, At, Bt) do { __builtin_amdgcn_s_setprio(1); _Pragma("unroll") for (int m = 0; m < 4; ++m) _Pragma("unroll") for (int n = 0; n < 2; ++n) _Pragma("unroll") for (int k = 0; k < 2; ++k) \
        acc[ai][bj][m][n] = __builtin_amdgcn_mfma_f32_16x16x32_bf16(Bt[n][k], At[m][k], acc[ai][bj][m][n], 0, 0, 0); __builtin_amdgcn_s_setprio(0); } while (0)
#define PG8_WAIT_V(n) asm volatile("s_waitcnt vmcnt(" #n ")" ::: "memory")
#define PG8_WAIT_L(n) asm volatile("s_waitcnt lgkmcnt(" #n ")" ::: "memory")
#define PG8_BAR __builtin_amdgcn_s_barrier()
#define PG8_SCHED __builtin_amdgcn_sched_barrier(0)
    Unit cur, nxt; int ui = 0;
    if (!S.next(0, cur)) return;
    f32x4 acc[2][2][4][2];
#pragma unroll
    for (int a = 0; a < 2; ++a)
#pragma unroll
        for (int b = 0; b < 2; ++b)
#pragma unroll
            for (int m = 0; m < 4; ++m)
#pragma unroll
                for (int n = 0; n < 2; ++n) acc[a][b][m][n] = (f32x4){0.f, 0.f, 0.f, 0.f};
    bf16x8 At[4][2], B0[2][2], B1[2][2];
    const char* cA = (const char*)g.A + (size_t)cur.pm * tstepA; const char* cB = (const char*)g.Bt + (size_t)cur.pn * tstepB;
    S.a_ready(cur);
    if constexpr (SP2) {
        PG8_STAGE(PG8_SB(0, 0), cB, voffB); PG8_STAGE(PG8_SB(0, 1), cB + hstepB, voffB); PG8_STAGE(PG8_SA(0, 0), cA, voffA); PG8_STAGE(PG8_SA(0, 1), cA + hstepA, voffA);
        if (wr == 1) PG8_BAR;
        PG8_WAIT_V(2); PG8_BAR;
        PG8_STAGE(PG8_SB(1, 0), cB + kstep, voffB); PG8_STAGE(PG8_SA(1, 0), cA + kstep, voffA); PG8_STAGE(PG8_SB(1, 1), cB + hstepB + kstep, voffB);
        PG8_WAIT_V(6); PG8_BAR;
    } else {
        PG8_STAGE(PG8_SB(0, 0), cB, voffB); PG8_STAGE(PG8_SA(0, 0), cA, voffA); PG8_STAGE(PG8_SB(0, 1), cB + hstepB, voffB); PG8_STAGE(PG8_SA(0, 1), cA + hstepA, voffA);
        if (wr == 1) PG8_BAR;
        PG8_WAIT_V(4); PG8_BAR;
        PG8_STAGE(PG8_SB(1, 0), cB + kstep, voffB); PG8_STAGE(PG8_SA(1, 0), cA + kstep, voffA); PG8_STAGE(PG8_SB(1, 1), cB + hstepB + kstep, voffB);
        PG8_WAIT_V(6); PG8_BAR;
    }
    for (;;) {
        const bool has_next = S.next(ui + 1, nxt);
        const char* nA = has_next ? (const char*)g.A + (size_t)nxt.pm * tstepA : cA; const char* nB = has_next ? (const char*)g.Bt + (size_t)nxt.pn * tstepB : cB;
        for (int t = 0; t < nt; t += 2) {
            const bool last = (t == nt - 2);
            const char* a1 = cA + (size_t)(t + 1) * kstep;
            const char* a2 = last ? nA : cA + (size_t)(t + 2) * kstep; const char* b2 = last ? nB : cB + (size_t)(t + 2) * kstep;
            const char* a3 = a2 + kstep; const char* b3 = b2 + kstep;
            if (last && has_next) S.a_ready(nxt);
            if constexpr (SP2) {
            PG8_LDB(B0, 0, 0); PG8_LDB(B1, 0, 1); PG8_SCHED; PG8_LDA(At, 0, 0); PG8_STAGE(PG8_SA(1, 1), a1 + hstepA, voffA);
            PG8_WAIT_V(8); PG8_WAIT_L(0); PG8_BAR; PG8_MMA(0, 0, At, B0); PG8_MMA(0, 1, At, B1); PG8_BAR; PG8_SCHED;
            PG8_LDA(At, 0, 1); PG8_STAGE(PG8_SB(0, 0), b2, voffB); PG8_STAGE(PG8_SB(0, 1), b2 + hstepB, voffB); PG8_STAGE(PG8_SA(0, 0), a2, voffA);
            PG8_WAIT_V(8); PG8_WAIT_L(0); PG8_BAR; PG8_MMA(1, 0, At, B0); PG8_MMA(1, 1, At, B1); PG8_BAR; PG8_SCHED;
            PG8_LDB(B0, 1, 0); PG8_LDB(B1, 1, 1); PG8_SCHED; PG8_LDA(At, 1, 0); PG8_STAGE(PG8_SA(0, 1), a2 + hstepA, voffA);
            PG8_WAIT_V(8); PG8_WAIT_L(0); PG8_BAR; PG8_MMA(0, 0, At, B0); PG8_MMA(0, 1, At, B1); PG8_BAR; PG8_SCHED;
            PG8_LDA(At, 1, 1); PG8_STAGE(PG8_SB(1, 0), b3, voffB); PG8_STAGE(PG8_SB(1, 1), b3 + hstepB, voffB); PG8_STAGE(PG8_SA(1, 0), a3, voffA);
            PG8_WAIT_V(8); PG8_WAIT_L(0); PG8_BAR; PG8_MMA(1, 0, At, B0); PG8_MMA(1, 1, At, B1); PG8_BAR; PG8_SCHED;
            } else {
            PG8_LDB(B0, 0, 0); PG8_SCHED; PG8_LDA(At, 0, 0); PG8_STAGE(PG8_SA(1, 1), a1 + hstepA, voffA);
            PG8_WAIT_L(8); PG8_BAR; PG8_WAIT_L(0); PG8_MMA(0, 0, At, B0); PG8_BAR; PG8_SCHED;
            PG8_LDB(B1, 0, 1); PG8_STAGE(PG8_SB(0, 0), b2, voffB);
            PG8_BAR; PG8_WAIT_L(0); PG8_MMA(0, 1, At, B1); PG8_BAR;
            PG8_LDA(At, 0, 1); PG8_STAGE(PG8_SA(0, 0), a2, voffA);
            PG8_BAR; PG8_WAIT_L(0); PG8_MMA(1, 0, At, B0); PG8_BAR; PG8_SCHED;
            PG8_STAGE(PG8_SB(0, 1), b2 + hstepB, voffB);
            PG8_WAIT_V(6); PG8_BAR; PG8_MMA(1, 1, At, B1); PG8_BAR;
            PG8_LDB(B0, 1, 0); PG8_SCHED; PG8_LDA(At, 1, 0); PG8_STAGE(PG8_SA(0, 1), a2 + hstepA, voffA);
            PG8_WAIT_L(8); PG8_BAR; PG8_WAIT_L(0); PG8_MMA(0, 0, At, B0); PG8_BAR; PG8_SCHED;
            PG8_LDB(B1, 1, 1); PG8_STAGE(PG8_SB(1, 0), b3, voffB);
            PG8_BAR; PG8_WAIT_L(0); PG8_MMA(0, 1, At, B1); PG8_BAR;
            PG8_LDA(At, 1, 1); PG8_STAGE(PG8_SA(1, 0), a3, voffA);
            PG8_BAR; PG8_WAIT_L(0); PG8_MMA(1, 0, At, B0); PG8_BAR; PG8_SCHED;
            PG8_STAGE(PG8_SB(1, 1), b3 + hstepB, voffB);
            PG8_WAIT_V(6); PG8_BAR; PG8_MMA(1, 1, At, B1); PG8_BAR;
            }
        }
        if constexpr (ALIGN_EPI) { if (wr == 0) PG8_BAR; }
        if constexpr (!Epi::AFTER_DRAIN) { E(acc, cur, wr, wc, fr, fq); S.done(cur); }
        if (!has_next) break;
#pragma unroll
        for (int a = 0; a < 2; ++a)
#pragma unroll
            for (int b = 0; b < 2; ++b)
#pragma unroll
                for (int m = 0; m < 4; ++m)
#pragma unroll
                    for (int n = 0; n < 2; ++n) acc[a][b][m][n] = (f32x4){0.f, 0.f, 0.f, 0.f};
        cur = nxt; cA = nA; cB = nB; ++ui;
        if constexpr (ALIGN_EPI) { if (wr == 1) PG8_BAR; }
    }
    PG8_WAIT_V(0);
    if constexpr (!ALIGN_EPI) { if (wr == 0) PG8_BAR; }
    PG8_BAR;
    if constexpr (Epi::AFTER_DRAIN) { E.fused(acc, cur, wr, wc, fr, fq, lds, wid, lane); S.done(cur); }
#undef PG8_SA
#undef PG8_SB
#undef PG8_STAGE
#undef PG8_LDA
#undef PG8_LDB
#undef PG8_MMA
#undef PG8_WAIT_V
#undef PG8_WAIT_L
#undef PG8_BAR
#undef PG8_SCHED
}
}
#define XB_TMO      128
#define XB_XCNT(j)  (256  + 64 * (j))
#define XB_XSUB(j)  (1280 + 64 * (j))
#define XB_XGEN(j)  (2304 + 64 * (j))
#define XB_TOP      3328
#define XB_TOPGEN   3392
#define XCD_BAR_WORDS 3456
#define XB_SPIN_CAP (1u << 22)

__device__ __forceinline__ unsigned xb_ld(unsigned* p)              { return __hip_atomic_load(p, __ATOMIC_RELAXED, __HIP_MEMORY_SCOPE_AGENT); }
__device__ __forceinline__ unsigned xb_add(unsigned* p, unsigned v) { return __hip_atomic_fetch_add(p, v, __ATOMIC_RELAXED, __HIP_MEMORY_SCOPE_AGENT); }
__device__ __forceinline__ unsigned xb_xcc_id() { return (unsigned)__builtin_amdgcn_s_getreg((3 << 11) | 20) & 0xFu; }
#define XB_SPIN(cond, bar) do { unsigned _sp = 0; while (cond) { __builtin_amdgcn_s_sleep(1); \
    if ((++_sp & 255u) == 0u) { if (xb_ld(&(bar)[XB_TMO])) break; if (_sp > XB_SPIN_CAP) { atomicAdd(&(bar)[XB_TMO], 1u); break; } } } } while (0)

struct XcdBarrier {
    unsigned* bar; unsigned x;
    volatile LAS unsigned* st;
};

__device__ __forceinline__ XcdBarrier xcd_barrier_post(unsigned* bar, volatile LAS unsigned* st) {
    XcdBarrier b; b.bar = bar; b.x = xb_xcc_id(); b.st = st;
    if (threadIdx.x == 0) (void)xb_add(&bar[XB_XCNT(b.x)], 1u);
    return b;
}
__device__ __forceinline__ void xcd_barrier_complete(unsigned* bar, unsigned x, unsigned& nloc, unsigned& nx) {
    const unsigned G = gridDim.x * gridDim.y * gridDim.z;
    unsigned sum, cnt, mine, sp = 0u;
    for (;;) {
        sum = 0u; cnt = 0u; mine = 0u;
#pragma unroll
        for (unsigned j = 0; j < 16; ++j) { const unsigned c = xb_ld(&bar[XB_XCNT(j)]); sum += c; cnt += (c > 0u) ? 1u : 0u; mine = (j == x) ? c : mine; }
        if (sum == G) break;
        __builtin_amdgcn_s_sleep(1);
        if ((++sp & 255u) == 0u) { if (xb_ld(&bar[XB_TMO])) break; if (sp > XB_SPIN_CAP) { atomicAdd(&bar[XB_TMO], 1u); break; } }
    }
    nloc = mine > 0u ? mine : 1u; nx = cnt > 0u ? cnt : 1u;
}

__device__ __forceinline__ void xcd_barrier(const XcdBarrier& b) {
    asm volatile("s_waitcnt vmcnt(0)" ::: "memory");
    __syncthreads();
    if (threadIdx.x == 0) {
        unsigned* bar = b.bar;
        __builtin_amdgcn_s_waitcnt(0);
        unsigned nloc = b.st[0], nx = b.st[1];
        if (nloc == 0u) { xcd_barrier_complete(bar, b.x, nloc, nx); b.st[0] = nloc; b.st[1] = nx; }
        const unsigned old = xb_add(&bar[XB_XSUB(b.x)], 1u);
        const unsigned gen = old / nloc;
        if (old + 1u == (gen + 1u) * nloc) {
            __builtin_amdgcn_fence(__ATOMIC_RELEASE, "agent");
            asm volatile("s_waitcnt vmcnt(0)" ::: "memory");
            const unsigned og = xb_add(&bar[XB_TOP], 1u);
            const unsigned tg = og / nx;
            if (og + 1u == (tg + 1u) * nx) xb_add(&bar[XB_TOPGEN], 1u);
            else XB_SPIN(xb_ld(&bar[XB_TOPGEN]) == tg, bar);
            __builtin_amdgcn_fence(__ATOMIC_ACQUIRE, "agent");
            xb_add(&bar[XB_XGEN(b.x)], 1u);
            asm volatile("s_waitcnt vmcnt(0)" ::: "memory");
        } else {
            XB_SPIN(xb_ld(&bar[XB_XGEN(b.x)]) == gen, bar);
            __builtin_amdgcn_fence(__ATOMIC_ACQUIRE, "agent");
            asm volatile("s_waitcnt vmcnt(0)" ::: "memory");
        }
    }
    __syncthreads();
}

constexpr int T = 16384, D = 1024, FF = 4096;
constexpr int NWAVES = 8, NTHR = 512;
constexpr float EPS = 1e-6f;
constexpr int N0IN = 2560, N1IN = 2816, C_IN = 2584;
enum { I_X = 0, I_RELB, I_ABWIN, I_CONVW, I_CONVB, I_WRG, I_BRG, I_WIG, I_BIG, I_LAM, I_ABWOUT, I_CWIN, I_POSK, I_POSV, I_K1, I_K2, I_V1, I_V2, I_CWOUT,
       I_NMIXPRE, I_NMIXPOST, I_NMLPPRE, I_NMLPPOST, I_WUP, I_WDN, N_IN };

constexpr size_t MiB = 1u << 20;
constexpr size_t WS_CTL = 0, CTL_ZERO_BYTES = 1 * MiB;
constexpr size_t WS_BT = 1 * MiB;
constexpr size_t WS_KMEAN = 1 * MiB + 65536;
constexpr size_t WS_CARRY = 2 * MiB;
constexpr size_t WS_SELMASK = 3 * MiB;
constexpr size_t WS_SELQ = 4 * MiB;
constexpr size_t WS_SELT = 5 * MiB;
constexpr size_t WS_PO = 172 * MiB;
constexpr size_t WS_PML = 236 * MiB;
constexpr int CW_QUEUE = 8192;
constexpr size_t WS_W0IN = 8 * MiB, WS_W0OUT = 13 * MiB, WS_W0UP = 15 * MiB, WS_W0DN = 23 * MiB;
constexpr size_t WS_W1IN = 31 * MiB, WS_W1OUT = 37 * MiB, WS_W1UP = 39 * MiB, WS_W1DN = 47 * MiB;
constexpr size_t WS_CW1K = 55 * MiB, WS_CW1V = 57 * MiB;
constexpr size_t WS_CPART = 60 * MiB;
constexpr size_t WS_POSP = 76 * MiB;
constexpr size_t WS_XN = 60 * MiB;
constexpr size_t WS_PROJ = 92 * MiB;
constexpr size_t WS_HLOC = 172 * MiB;
constexpr size_t WS_OCW = 180 * MiB;
constexpr size_t WS_HID = 244 * MiB;
constexpr size_t WS_KCMP = 250 * MiB;
constexpr size_t WS_MB = 92 * MiB;
constexpr size_t WS_U = 124 * MiB;
constexpr size_t WS_X3 = 1 * MiB;
constexpr size_t WS_END = 256 * MiB;
constexpr int CW_BAR = 4096;

constexpr int SCR_BYTES = 131072;
constexpr int MISC_OFF = SCR_BYTES + 320;
constexpr int LDS_BYTES = 147456;

typedef unsigned short bf16;
typedef float f4 __attribute__((ext_vector_type(4)));
#define LDS_WAIT() asm volatile("s_waitcnt lgkmcnt(0)" ::: "memory")
#define VM_WAIT() asm volatile("s_waitcnt vmcnt(0)" ::: "memory")
__device__ __forceinline__ unsigned f2bf(float f) { unsigned u = __builtin_bit_cast(unsigned, f); return (u + 0x7fffu + ((u >> 16) & 1u)) >> 16; }
__device__ __forceinline__ unsigned pk2(float lo, float hi) { return f2bf(lo) | (f2bf(hi) << 16); }
__device__ __forceinline__ float bf2f(bf16 b) { return __builtin_bit_cast(float, ((unsigned)b) << 16); }
__device__ __forceinline__ float bflo(unsigned w) { return __builtin_bit_cast(float, w << 16); }
__device__ __forceinline__ float bfhi(unsigned w) { return __builtin_bit_cast(float, w & 0xffff0000u); }
__device__ __forceinline__ float wave_sum(float v) {
#pragma unroll
    for (int o = 1; o < 64; o <<= 1) v += __shfl_xor(v, o);
    return v;
}
__device__ __forceinline__ float wave_max(float v) {
#pragma unroll
    for (int o = 1; o < 64; o <<= 1) v = fmaxf(v, __shfl_xor(v, o));
    return v;
}
__device__ __forceinline__ void wave_argmax(float& v, int& i) {
#pragma unroll
    for (int o = 1; o < 64; o <<= 1) { const float ov = __shfl_xor(v, o); const int oi = __shfl_xor(i, o); if (ov > v || (ov == v && oi < i)) { v = ov; i = oi; } }
}
__device__ __forceinline__ float gelu_tanh(float x) { return 0.5f * x * (1.f + tanhf(0.7978845608028654f * (x + 0.044715f * x * x * x))); }
__device__ __forceinline__ float sigmoidf_(float x) { return 1.f / (1.f + __expf(-x)); }
__device__ __forceinline__ int t5_bucket(int d) {
    if (d < 16) return d;
    return 16 + (d >= 19) + (d >= 21) + (d >= 24) + (d >= 27) + (d >= 31) + (d >= 35) + (d >= 40) + (d >= 46) + (d >= 52) + (d >= 59) + (d >= 67) + (d >= 77) + (d >= 87) + (d >= 99) + (d >= 113);
}

#ifndef MOBA_MFMA
#define MOBA_MFMA 1
#endif
struct Params { const float* in[N_IN]; float* out; unsigned char* ws; int ph_lo, ph_hi; };

typedef unsigned v4u_t __attribute__((ext_vector_type(4)));
template <int ACT  > struct EpiT {
    static constexpr bool PERM = true, AFTER_DRAIN = false;
    bf16* O; int tcols; size_t tstride;
    __device__ __forceinline__ void operator()(const pg8::f32x4 (&acc)[2][2][4][2], const pg8::Unit& u, int wr, int wc, int fr, int fq) const {
        const int row0 = u.pm * 256 + wr * 64 + fr;
        const __amdgpu_buffer_rsrc_t rs = __builtin_amdgcn_make_buffer_rsrc((void*)O, 0, 0x7FFFFFF0, 0x00020000);
#pragma unroll
        for (int bj = 0; bj < 2; ++bj) {
            const int c0 = u.pn * 256 + bj * 128; const int tt = c0 / tcols; const int cw = c0 - tt * tcols;
            const unsigned base = (unsigned)(((size_t)tt * tstride + cw + wc * 32 + 8 * fq) * 2);
#pragma unroll
            for (int ai = 0; ai < 2; ++ai)
#pragma unroll
                for (int m = 0; m < 4; ++m) {
                    pg8::f32x4 v0 = acc[ai][bj][m][0], v1 = acc[ai][bj][m][1];
                    if (ACT == 1) {
#pragma unroll
                        for (int j = 0; j < 4; ++j) { const float a = fmaxf(v0[j], 0.f), b = fmaxf(v1[j], 0.f); v0[j] = a * a; v1[j] = b * b; } }
                    pg8::u32x4 w; w.x = pg8::cvt_pk_bf16(v0[0], v0[1]); w.y = pg8::cvt_pk_bf16(v0[2], v0[3]); w.z = pg8::cvt_pk_bf16(v1[0], v1[1]); w.w = pg8::cvt_pk_bf16(v1[2], v1[3]);
                    __builtin_amdgcn_raw_buffer_store_b128(__builtin_bit_cast(v4u_t, w), rs, base + (unsigned)((row0 + ai * 128 + m * 16) * tcols * 2), 0, 16);
                }
        }
    }
};
template <int ACT> __device__ __forceinline__ void run_gemm(LAS unsigned char* lds, const bf16* A, const bf16* Bt, int M, int N, int K, bf16* O, int tcols, size_t tstride, int G, int wg) {
    pg8::Gemm g{A, Bt, M, N, K, K, K}; pg8::StaticOrder S; S.init(M, N, G, wg); EpiT<ACT> E{O, tcols, tstride};
    pg8::gemm_phase<EpiT<ACT>, pg8::StaticOrder, true, true>((PG8_LAS unsigned char*)lds, g, S, E);
}

__device__ __forceinline__ void tr_load(const float* __restrict__ W, int K, int N, int item, int nblk, float (&wv)[32], int lane) {
    const int kb = item / nblk, nb = item % nblk, k0 = 64 * kb, n0 = 32 * nb;
    const int nn = n0 + (lane & 31); const bool ok = nn < N;
#pragma unroll
    for (int i = 0; i < 32; ++i) { const int kk = 2 * i + (lane >> 5); wv[i] = ok ? W[(size_t)(k0 + kk) * N + nn] : 0.f; }
}
__device__ __forceinline__ void tr_finish(int K, bf16* __restrict__ WT, int item, int nblk, const float (&wv)[32], LAS float* scr, int lane) {
    const int kb = item / nblk, nb = item % nblk, k0 = 64 * kb, n0 = 32 * nb;
#pragma unroll
    for (int i = 0; i < 32; ++i) { const int kk = 2 * i + (lane >> 5); scr[kk * 33 + (lane & 31)] = wv[i]; }
    LDS_WAIT(); asm volatile("" ::: "memory");
    const int c = lane & 7;
#pragma unroll
    for (int j = 0; j < 4; ++j) { const int n = (lane >> 3) + 8 * j; const LAS float* s = scr + (8 * c) * 33 + n;
        uint4 o; o.x = pk2(s[0 * 33], s[1 * 33]); o.y = pk2(s[2 * 33], s[3 * 33]); o.z = pk2(s[4 * 33], s[5 * 33]); o.w = pk2(s[6 * 33], s[7 * 33]);
        *(uint4*)(WT + (size_t)(n0 + n) * K + k0 + 8 * c) = o; }
    LDS_WAIT(); asm volatile("" ::: "memory");
}
struct WSel { const float* src; bf16* dst; int K, N, nblk, r; };
__device__ __forceinline__ WSel w_select(const Params& P, unsigned char* ws, int it) {
    WSel w; int r = it;
#define TRY_W(src_, K_, N_, NP_, dst_) { constexpr int cnt = ((K_) / 64) * ((NP_) / 32); if (r < cnt) { w.src = (src_); w.dst = (bf16*)(ws + (dst_)); w.K = (K_); w.N = (N_); w.nblk = (NP_) / 32; w.r = r; return w; } r -= cnt; }
    TRY_W(P.in[I_ABWIN], 1024, 2560, 2560, WS_W0IN)
    TRY_W(P.in[I_ABWOUT], 1024, 1024, 1024, WS_W0OUT)
    TRY_W(P.in[I_WUP], 1024, 4096, 4096, WS_W0UP)
    TRY_W(P.in[I_WDN], 4096, 1024, 1024, WS_W0DN)
    TRY_W(P.in[I_CWIN], 1024, C_IN, N1IN, WS_W1IN)
    TRY_W(P.in[I_CWOUT], 1024, 1024, 1024, WS_W1OUT)
    TRY_W(P.in[I_WUP] + (size_t)1024 * 4096, 1024, 4096, 4096, WS_W1UP)
    TRY_W(P.in[I_WDN] + (size_t)4096 * 1024, 4096, 1024, 1024, WS_W1DN)
    TRY_W(P.in[I_K1], 4096, 256, 256, WS_CW1K)
#undef TRY_W
    w.src = P.in[I_V1]; w.dst = (bf16*)(ws + WS_CW1V); w.K = 4096; w.N = 256; w.nblk = 8; w.r = r; return w;
}
__device__ __forceinline__ void rms_to_bf16(const float4 (&v)[4], const float* __restrict__ g, bf16* __restrict__ orow, int lane) {
    float ss = 0.f;
#pragma unroll
    for (int j = 0; j < 4; ++j) ss += (v[j].x * v[j].x + v[j].y * v[j].y) + (v[j].z * v[j].z + v[j].w * v[j].w);
    const float r = 1.f / sqrtf(wave_sum(ss) * (1.f / D) + EPS);
#pragma unroll
    for (int j = 0; j < 4; ++j) { const float4 gg = ((const float4*)g)[lane + 64 * j];
        uint2 o; o.x = pk2(v[j].x * r * gg.x, v[j].y * r * gg.y); o.y = pk2(v[j].z * r * gg.z, v[j].w * r * gg.w);
        ((uint2*)orow)[lane + 64 * j] = o; }
}
__device__ __forceinline__ void p0_prologue(const Params& P, LAS unsigned char* lds, int tid, int lane, int wave, int wg, int G) {
    unsigned char* ws = P.ws;
    LAS float* scr = (LAS float*)(lds + wave * 16384);
    const int gw = wg * NWAVES + wave, NGW = G * NWAVES;
    constexpr int NITEMS = 16 * 80 + 16 * 32 + 16 * 128 + 64 * 32 + 16 * 88 + 16 * 32 + 16 * 128 + 64 * 32 + 2 * 64 * 8;
    {
        float wa[32], wb[32];
        int it = gw;
        WSel cur = w_select(P, ws, it < NITEMS ? it : 0);
        if (it < NITEMS) tr_load(cur.src, cur.K, cur.N, cur.r, cur.nblk, wa, lane);
        while (it < NITEMS) {
            const int itn = it + NGW; WSel nx = w_select(P, ws, itn < NITEMS ? itn : 0);
            if (itn < NITEMS) tr_load(nx.src, nx.K, nx.N, nx.r, nx.nblk, wb, lane);
            tr_finish(cur.K, cur.dst, cur.r, cur.nblk, wa, scr, lane);
            if (itn >= NITEMS) break;
            const int it2 = itn + NGW; cur = w_select(P, ws, it2 < NITEMS ? it2 : 0);
            if (it2 < NITEMS) tr_load(cur.src, cur.K, cur.N, cur.r, cur.nblk, wa, lane);
            tr_finish(nx.K, nx.dst, nx.r, nx.nblk, wb, scr, lane);
            it = it2;
        }
    }
    if (wg == 0) { float* bt = (float*)(ws + WS_BT); for (int i = tid; i < 1024; i += NTHR) { const int h = i >> 7, d = i & 127; bt[i] = P.in[I_RELB][t5_bucket(d) * 8 + h]; } }
    for (int m = gw; m < T; m += 2 * NGW) {
        const float4* xr0 = (const float4*)(P.in[I_X] + (size_t)m * D); const float4* xr1 = (const float4*)(P.in[I_X] + (size_t)((m + NGW < T) ? (m + NGW) : m) * D); float4 v0[4], v1[4];
#pragma unroll
        for (int j = 0; j < 4; ++j) { v0[j] = xr0[lane + 64 * j]; v1[j] = xr1[lane + 64 * j]; }
        rms_to_bf16(v0, P.in[I_NMIXPRE], (bf16*)(ws + WS_XN) + (size_t)m * D, lane);
        if (m + NGW < T) rms_to_bf16(v1, P.in[I_NMIXPRE], (bf16*)(ws + WS_XN) + (size_t)(m + NGW) * D, lane);
    }
}

template <int XIN, int XOUT>
__device__ __forceinline__ void post_norm(const void* xin_, void* xout_, const bf16* __restrict__ y, const float* __restrict__ g1, const float* __restrict__ g2  ,
                                          bf16* __restrict__ xn, int lane, int gw, int NGW) {
    for (int m0 = gw; m0 < T; m0 += 2 * NGW) {
        const int m1 = (m0 + NGW < T) ? (m0 + NGW) : m0; const bool two = (m0 + NGW < T);
        const uint2* yr0 = (const uint2*)(y + (size_t)m0 * D); const uint2* yr1 = (const uint2*)(y + (size_t)m1 * D);
        uint2 yw0[4], yw1[4]; float4 xv0[4], xv1[4];
        if (XIN == 0) {
            const float4* xr0 = (const float4*)((const float*)xin_ + (size_t)m0 * D); const float4* xr1 = (const float4*)((const float*)xin_ + (size_t)m1 * D);
#pragma unroll
            for (int j = 0; j < 4; ++j) { yw0[j] = yr0[lane + 64 * j]; yw1[j] = yr1[lane + 64 * j]; xv0[j] = xr0[lane + 64 * j]; xv1[j] = xr1[lane + 64 * j]; }
        } else {
            const uint2* xr0 = (const uint2*)((const bf16*)xin_ + (size_t)m0 * D); const uint2* xr1 = (const uint2*)((const bf16*)xin_ + (size_t)m1 * D);
            uint2 xw0[4], xw1[4];
#pragma unroll
            for (int j = 0; j < 4; ++j) { yw0[j] = yr0[lane + 64 * j]; yw1[j] = yr1[lane + 64 * j]; xw0[j] = xr0[lane + 64 * j]; xw1[j] = xr1[lane + 64 * j]; }
#pragma unroll
            for (int j = 0; j < 4; ++j) { xv0[j] = make_float4(bflo(xw0[j].x), bfhi(xw0[j].x), bflo(xw0[j].y), bfhi(xw0[j].y)); xv1[j] = make_float4(bflo(xw1[j].x), bfhi(xw1[j].x), bflo(xw1[j].y), bfhi(xw1[j].y)); }
        }
#pragma unroll
        for (int rr = 0; rr < 2; ++rr) {
            if (rr == 1 && !two) break;
            const int m = rr ? m1 : m0; float4 yv[4]; float ss = 0.f;
#pragma unroll
            for (int j = 0; j < 4; ++j) { const uint2 w = rr ? yw1[j] : yw0[j]; yv[j] = make_float4(bflo(w.x), bfhi(w.x), bflo(w.y), bfhi(w.y));
                ss += (yv[j].x * yv[j].x + yv[j].y * yv[j].y) + (yv[j].z * yv[j].z + yv[j].w * yv[j].w); }
            const float r = 1.f / sqrtf(wave_sum(ss) * (1.f / D) + EPS);
            float4 v[4];
#pragma unroll
            for (int j = 0; j < 4; ++j) { const float4 xv = rr ? xv1[j] : xv0[j]; const float4 gg = ((const float4*)g1)[lane + 64 * j];
                v[j] = make_float4(xv.x + yv[j].x * r * gg.x, xv.y + yv[j].y * r * gg.y, xv.z + yv[j].z * r * gg.z, xv.w + yv[j].w * r * gg.w);
                if (XOUT == 0) ((float4*)((float*)xout_ + (size_t)m * D))[lane + 64 * j] = v[j];
                else { uint2 o; o.x = pk2(v[j].x, v[j].y); o.y = pk2(v[j].z, v[j].w); ((uint2*)((bf16*)xout_ + (size_t)m * D))[lane + 64 * j] = o; } }
            if (g2) rms_to_bf16(v, g2, xn + (size_t)m * D, lane);
        }
    }
}

template <int DH, int NP, int MODE>
__device__ __forceinline__ void wattn_tile(const bf16* __restrict__ Kt, const bf16* __restrict__ Vt, int ldk, int key0, int kend, int t, int posmul, int posadd, int dmax,
                                           const LAS float* qs, const float* __restrict__ btab, int h0, float scale,
                                           float (&m)[NP], float (&l)[NP], float (&o)[NP][DH / 64], LAS float* cs, int lane) {
    const int k = key0 + lane; const bool inb = k < kend; const int kc = inb ? k : (kend - 1);
    const int d = t - (posmul * kc + posadd);
    const bool valid = inb && d >= 0 && d < dmax;
    float s[NP];
#pragma unroll
    for (int p = 0; p < NP; ++p) s[p] = 0.f;
    const uint4* krow = (const uint4*)(Kt + (size_t)kc * ldk);
    uint4 kr[DH / 8];
#pragma unroll
    for (int c = 0; c < DH / 8; ++c) kr[c] = krow[c];
#pragma unroll
    for (int c = 0; c < DH / 8; ++c) {
        asm volatile("" ::: "memory");
        const uint4 kv = kr[c];
        const float k0 = bflo(kv.x), k1 = bfhi(kv.x), k2 = bflo(kv.y), k3 = bfhi(kv.y), k4 = bflo(kv.z), k5 = bfhi(kv.z), k6 = bflo(kv.w), k7 = bfhi(kv.w);
#pragma unroll
        for (int p = 0; p < NP; ++p) { const f4 qa = *(const volatile LAS f4*)(qs + p * DH + 8 * c), qb = *(const volatile LAS f4*)(qs + p * DH + 8 * c + 4);
            s[p] += (k0 * qa.x + k1 * qa.y) + (k2 * qa.z + k3 * qa.w) + (k4 * qb.x + k5 * qb.y) + (k6 * qb.z + k7 * qb.w);
            asm volatile("" : "+v"(s[p]) :: "memory"); }
    }
    const int dd = d < 0 ? 0 : (d > 127 ? 127 : d);
    float pe[NP];
#pragma unroll
    for (int p = 0; p < NP; ++p) {
        const float sc = valid ? s[p] * scale + btab[(h0 + p) * 128 + dd] : -INFINITY;
        if (MODE == 2) { pe[p] = valid ? __expf(sc - m[p]) * l[p] : 0.f; }
        else {
            const float tm = wave_max(sc); const float mn = fmaxf(m[p], tm);
            float alpha = 1.f; pe[p] = 0.f;
            if (mn != -INFINITY) { alpha = __expf(m[p] - mn); pe[p] = valid ? __expf(sc - mn) : 0.f; }
            l[p] = l[p] * alpha + wave_sum(pe[p]); m[p] = mn;
            if (MODE == 0) {
#pragma unroll
                for (int i = 0; i < DH / 64; ++i) o[p][i] *= alpha; }
        }
    }
    if (MODE == 2) { float csum = 0.f;
#pragma unroll
        for (int p = 0; p < NP; ++p) csum += pe[p];
        if (inb) cs[k] = csum; }
    if (MODE != 1) {
        const int nk = (kend - key0) < 64 ? (kend - key0) : 64;
        for (int kk = 0; kk < nk; ++kk) {
            const bf16* vrow = Vt + (size_t)(key0 + kk) * ldk;
            float v0, v1 = 0.f;
            if (DH == 128) { const unsigned w = ((const unsigned*)vrow)[lane]; v0 = bflo(w); v1 = bfhi(w); } else { v0 = bf2f(vrow[lane]); }
#pragma unroll
            for (int p = 0; p < NP; ++p) { const float pk = __builtin_bit_cast(float, __builtin_amdgcn_readlane(__builtin_bit_cast(int, pe[p]), kk));
                o[p][0] += pk * v0; if (DH == 128) o[p][DH / 64 - 1] += pk * v1; }
        }
    }
}

__device__ __forceinline__ void l0_stage_a(const Params& P, LAS unsigned char* lds, int tid, int lane, int wave, int wg, int G) {
    unsigned char* ws = P.ws;
    const bf16* proj = (const bf16*)(ws + WS_PROJ);
    const bf16* xr = proj + (size_t)3 * T * 512;
    LAS float* xc = (LAS float*)lds;
    unsigned* hp = (unsigned*)(ws + WS_HLOC);
    const int c = tid, b = c >> 6;
    LAS bf16* rp = (LAS bf16*)(lds + 65536); LAS bf16* ip = (LAS bf16*)(lds + 98304);
    const int r16 = lane & 15, gl = lane >> 4;
    pg8::bf16x8 wfr[4][2], wfi[4][2];
    {
        const float* Wr = P.in[I_WRG] + (size_t)b * 4096; const float* Wi = P.in[I_WIG] + (size_t)b * 4096;
#pragma unroll
        for (int nt = 0; nt < 4; ++nt)
#pragma unroll
            for (int ks = 0; ks < 2; ++ks) { float fr[8], fi[8];
#pragma unroll
                for (int j = 0; j < 8; ++j) { const int idx = (32 * ks + 8 * gl + j) * 64 + 16 * nt + r16; fr[j] = Wr[idx]; fi[j] = Wi[idx]; }
                pg8::u32x4 wr4, wi4; wr4.x = pk2(fr[0], fr[1]); wr4.y = pk2(fr[2], fr[3]); wr4.z = pk2(fr[4], fr[5]); wr4.w = pk2(fr[6], fr[7]);
                wi4.x = pk2(fi[0], fi[1]); wi4.y = pk2(fi[2], fi[3]); wi4.z = pk2(fi[4], fi[5]); wi4.w = pk2(fi[6], fi[7]);
                wfr[nt][ks] = __builtin_bit_cast(pg8::bf16x8, wr4); wfi[nt][ks] = __builtin_bit_cast(pg8::bf16x8, wi4); }
    }
    float brg4[4], big4[4];
#pragma unroll
    for (int nt = 0; nt < 4; ++nt) { brg4[nt] = P.in[I_BRG][64 * b + 16 * nt + r16]; big4[nt] = P.in[I_BIG][64 * b + 16 * nt + r16]; }
    const float sp = log1pf(expf(-P.in[I_LAM][c]));
    const float* cw = P.in[I_CONVW]; const float w0 = cw[c], w1 = cw[512 + c], w2 = cw[1024 + c], w3 = cw[1536 + c], cb = P.in[I_CONVB][c];
    for (int ch = wg; ch < T / 64; ch += G) {
        const int t0 = ch * 64;
        float xm3 = (t0 >= 3) ? bf2f(xr[(size_t)(t0 - 3) * 512 + c]) : 0.f, xm2 = (t0 >= 2) ? bf2f(xr[(size_t)(t0 - 2) * 512 + c]) : 0.f, xm1 = (t0 >= 1) ? bf2f(xr[(size_t)(t0 - 1) * 512 + c]) : 0.f;
        float h = 0.f, Pc = 1.f;
#pragma unroll 1
        for (int hf = 0; hf < 2; ++hf) {
            const int ts = t0 + 32 * hf;
            for (int t16 = 0; t16 < 32; t16 += 16) { bf16 xv[16];
#pragma unroll
                for (int i = 0; i < 16; ++i) xv[i] = xr[(size_t)(ts + t16 + i) * 512 + c];
#pragma unroll
                for (int i = 0; i < 16; ++i) { const float x0 = bf2f(xv[i]); xc[(t16 + i) * 512 + c] = cb + w0 * xm3 + w1 * xm2 + w2 * xm1 + w3 * x0; xm3 = xm2; xm2 = xm1; xm1 = x0; } }
            __syncthreads();
#pragma unroll
            for (int mt = 0; mt < 2; ++mt) {
                pg8::bf16x8 af[2];
#pragma unroll
                for (int ks = 0; ks < 2; ++ks) { const LAS f4* xp = (const LAS f4*)(xc + (16 * mt + r16) * 512 + 64 * b + 32 * ks + 8 * gl); const f4 x0 = xp[0], x1 = xp[1];
                    pg8::u32x4 w; w.x = pk2(x0.x, x0.y); w.y = pk2(x0.z, x0.w); w.z = pk2(x1.x, x1.y); w.w = pk2(x1.z, x1.w); af[ks] = __builtin_bit_cast(pg8::bf16x8, w); }
#pragma unroll
                for (int nt = 0; nt < 4; ++nt) {
                    pg8::f32x4 ar = {0.f, 0.f, 0.f, 0.f}, ai = {0.f, 0.f, 0.f, 0.f};
                    ar = __builtin_amdgcn_mfma_f32_16x16x32_bf16(af[0], wfr[nt][0], ar, 0, 0, 0); ar = __builtin_amdgcn_mfma_f32_16x16x32_bf16(af[1], wfr[nt][1], ar, 0, 0, 0);
                    ai = __builtin_amdgcn_mfma_f32_16x16x32_bf16(af[0], wfi[nt][0], ai, 0, 0, 0); ai = __builtin_amdgcn_mfma_f32_16x16x32_bf16(af[1], wfi[nt][1], ai, 0, 0, 0);
#pragma unroll
                    for (int i = 0; i < 4; ++i) { const int o_ = (16 * mt + 4 * gl + i) * 512 + 64 * b + 16 * nt + r16; rp[o_] = (bf16)f2bf(ar[i] + brg4[nt]); ip[o_] = (bf16)f2bf(ai[i] + big4[nt]); }
                }
            }
            __syncthreads();
#pragma unroll 4
            for (int t = 0; t < 32; ++t) {
                const float r = __builtin_amdgcn_rcpf(1.f + __builtin_amdgcn_exp2f(-1.4426950408889634f * bf2f(rp[t * 512 + c]))), ig = __builtin_amdgcn_rcpf(1.f + __builtin_amdgcn_exp2f(-1.4426950408889634f * bf2f(ip[t * 512 + c])));
                const float la = -8.f * r * sp; const float a = __builtin_amdgcn_exp2f(1.4426950408889634f * la); const float x2 = 2.f * la;
                const float em_s = -x2 * (1.f + x2 * 0.5f * (1.f + x2 * (1.f / 3.f) * (1.f + x2 * 0.25f * (1.f + x2 * 0.2f * (1.f + x2 * (1.f / 6.f))))));
                const float em = (x2 > -0.25f) ? em_s : 1.f - a * a;
                const float bb = __builtin_amdgcn_sqrtf(em) * ig * xc[t * 512 + c];
                h = a * h + bb; Pc *= a;
                hp[(size_t)(ts + t) * 512 + c] = pk2(h, Pc);
            }
            __syncthreads();
        }
        float* car = (float*)(ws + WS_CARRY) + (size_t)ch * 1024; car[c] = Pc; car[512 + c] = h;
    }
    const bf16* kt = proj + (size_t)1 * T * 512; float* kmean = (float*)(ws + WS_KMEAN);
    LAS float* red = (LAS float*)lds;
    for (int task = wg; task < 512; task += G) {
        const int h = task >> 6, j = task & 63, d = tid & 63, rg = tid >> 6; const bf16* kk = kt + (size_t)(256 * j + rg) * 512 + 64 * h + d; float sacc = 0.f;
#pragma unroll
        for (int r8 = 0; r8 < 32; r8 += 8) { bf16 v[8];
#pragma unroll
            for (int i = 0; i < 8; ++i) v[i] = kk[(size_t)(8 * (r8 + i)) * 512];
#pragma unroll
            for (int i = 0; i < 8; ++i) sacc += bf2f(v[i]); }
        __syncthreads();
        red[rg * 64 + d] = sacc;
        __syncthreads();
        if (tid < 64) { float t_ = 0.f;
#pragma unroll
            for (int g8 = 0; g8 < 8; ++g8) t_ += red[g8 * 64 + tid];
            kmean[(h * 64 + j) * 64 + tid] = t_ * (1.f / 256.f); }
    }
}

__device__ __forceinline__ void l0_stage_c(const Params& P, LAS unsigned char* lds, int tid, int lane, int wave, int wg, int G) {
    unsigned char* ws = P.ws;
    const bf16* proj = (const bf16*)(ws + WS_PROJ);
    bf16* attnout = (bf16*)(ws + WS_XN);
    {
        const unsigned* hp = (const unsigned*)(ws + WS_HLOC); const float* car = (const float*)(ws + WS_CARRY);
        const bf16* gr = proj + (size_t)4 * T * 512;
        for (int ch = wg; ch < T / 64; ch += G) {
            const int c = tid, t0 = ch * 64; float H = 0.f;
            int cc = 0;
            for (; cc + 16 <= ch; cc += 16) {
                float a_[16], b_[16];
#pragma unroll
                for (int i = 0; i < 16; ++i) { a_[i] = car[(size_t)(cc + i) * 1024 + c]; b_[i] = car[(size_t)(cc + i) * 1024 + 512 + c]; }
#pragma unroll
                for (int i = 0; i < 16; ++i) H = a_[i] * H + b_[i];
            }
            for (; cc < ch; ++cc) H = car[(size_t)cc * 1024 + c] * H + car[(size_t)cc * 1024 + 512 + c];
            for (int t8 = 0; t8 < 64; t8 += 16) {
                unsigned hw[16]; bf16 gv[16];
#pragma unroll
                for (int i = 0; i < 16; ++i) { const size_t ix = (size_t)(t0 + t8 + i) * 512 + c; hw[i] = hp[ix]; gv[i] = gr[ix]; }
#pragma unroll
                for (int i = 0; i < 16; ++i) attnout[(size_t)(t0 + t8 + i) * 1024 + 512 + c] = (bf16)f2bf((bflo(hw[i]) + bfhi(hw[i]) * H) * gelu_tanh(bf2f(gv[i])));
            }
        }
    }
#if !MOBA_MFMA
    const bf16* qt = proj; const bf16* kt = proj + (size_t)1 * T * 512; const bf16* vt = proj + (size_t)2 * T * 512;
    const float* kmean = (const float*)(ws + WS_KMEAN); const float* btab = (const float*)(ws + WS_BT);
    LAS float* qs = (LAS float*)(lds + wave * 8192);
    for (int task = wg * NWAVES + wave; task < T * 8; task += G * NWAVES) {
        const int t = task >> 3, h = task & 7, own = t >> 8;
        qs[lane] = bf2f(qt[(size_t)t * 512 + 64 * h + lane]);
        LDS_WAIT(); asm volatile("" ::: "memory");
        float rv = -1e30f;
        if (lane < own) { const float4* km = (const float4*)(kmean + (size_t)(h * 64 + lane) * 64); float s = 0.f;
#pragma unroll
            for (int i = 0; i < 16; ++i) { const float4 kv = km[i]; const f4 qv = *(const LAS f4*)(qs + 4 * i); s += (kv.x * qv.x + kv.y * qv.y) + (kv.z * qv.z + kv.w * qv.w); }
            rv = s; }
        int sel[3];
#pragma unroll
        for (int r = 0; r < 3; ++r) { float bv = rv; int bi = lane; wave_argmax(bv, bi); bi = __builtin_amdgcn_readfirstlane(bi); sel[r] = (bv > -5e29f) ? bi : -1; if (lane == bi) rv = -INFINITY; }
        float m[1] = {-INFINITY}, l[1] = {0.f}, o[1][1] = {{0.f}};
#pragma unroll
        for (int r = 0; r < 3; ++r) if (sel[r] >= 0) for (int tile = 0; tile < 4; ++tile) { const int key0 = sel[r] * 256 + 64 * tile;
            wattn_tile<64, 1, 0>(kt + 64 * h, vt + 64 * h, 512, key0, key0 + 64, t, 1, 0, 0x7fffffff, qs, btab, h, 0.125f, m, l, o, nullptr, lane); }
        for (int key0 = own * 256; key0 <= t; key0 += 64)
            wattn_tile<64, 1, 0>(kt + 64 * h, vt + 64 * h, 512, key0, t + 1, t, 1, 0, 0x7fffffff, qs, btab, h, 0.125f, m, l, o, nullptr, lane);
        attnout[(size_t)t * 1024 + 64 * h + lane] = (bf16)f2bf(o[0][0] / fmaxf(l[0], 1e-30f));
        asm volatile("" ::: "memory");
    }
#endif
}

__device__ __forceinline__ const bf16* l1_tensor(const unsigned char* ws, int i) { return (const bf16*)(ws + WS_PROJ) + (size_t)i * T * 128; }
__device__ __forceinline__ void l1_load_q(const unsigned char* ws, int t, int g, LAS float* qs, int lane) {
#pragma unroll
    for (int p = 0; p < 4; ++p) { const unsigned w = ((const unsigned*)(l1_tensor(ws, 4 * g + p) + (size_t)t * 128))[lane]; qs[p * 128 + 2 * lane] = bflo(w); qs[p * 128 + 2 * lane + 1] = bfhi(w); }
    LDS_WAIT(); asm volatile("" ::: "memory");
}
__device__ __forceinline__ bf16 l1_gate_raw(const unsigned char* ws, int t, int h, int i) { return l1_tensor(ws, 20)[(size_t)t * 128 + 3 * h + i]; }
__device__ __forceinline__ float l1_gate(const unsigned char* ws, int t, int h, int i) { return sigmoidf_(bf2f(l1_tensor(ws, 20)[(size_t)t * 128 + 3 * h + i])); }
constexpr float SCALE_C = 0.08838834764831845f;
#ifndef WIN_MFMA
#define WIN_MFMA 1
#endif
#ifndef COMPRESS_MFMA
#define COMPRESS_MFMA 1
#endif

__device__ __forceinline__ void l1_stage_a(const Params& P, LAS unsigned char* lds, int tid, int lane, int wave, int wg, int G) {
    unsigned char* ws = P.ws;
#if !COMPRESS_MFMA
    {
        LAS float* kts = (LAS float*)lds;
        LAS float* pos_s = (LAS float*)(lds + 73728);
        LAS float* red = (LAS float*)(lds + 90112);
        float* hid = (float*)(ws + WS_HID);
        for (int task = wg; task < 512; task += G) {
            const int kv = task >> 8, g = (task >> 7) & 1, n0 = (task & 127) * 8;
            const bf16* src = l1_tensor(ws, (kv ? 10 : 8) + g); const float* pos = P.in[kv ? I_POSV : I_POSK]; const float* w1 = P.in[kv ? I_V1 : I_K1];
            for (int i = tid; i < 144 * 128; i += NTHR) { const int tok = 16 * n0 + (i >> 7); kts[i] = tok < T ? bf2f(src[(size_t)tok * 128 + (i & 127)]) : 0.f; }
            for (int i = tid; i < 32 * 128; i += NTHR) pos_s[i] = pos[i];
            __syncthreads();
            const int j = tid & 255, half = tid >> 8;
            float acc[8];
#pragma unroll
            for (int i = 0; i < 8; ++i) acc[i] = 0.f;
            for (int l = half * 16; l < half * 16 + 16; ++l)
                for (int d4 = 0; d4 < 32; ++d4) {
                    const float* wp = w1 + (size_t)(l * 128 + 4 * d4) * 256 + j; const float wa = wp[0], wb = wp[256], wc_ = wp[512], wd = wp[768];
                    const f4 pv = *(const LAS f4*)(pos_s + l * 128 + 4 * d4);
#pragma unroll
                    for (int i = 0; i < 8; ++i) { const f4 kk = *(const LAS f4*)(kts + (16 * i + l) * 128 + 4 * d4);
                        acc[i] += ((kk.x + pv.x) * wa + (kk.y + pv.y) * wb) + ((kk.z + pv.z) * wc_ + (kk.w + pv.w) * wd); }
                }
            if (half == 1) {
#pragma unroll
                for (int i = 0; i < 8; ++i) red[i * 256 + j] = acc[i]; }
            __syncthreads();
            if (half == 0) {
#pragma unroll
                for (int i = 0; i < 8; ++i) { const int n = n0 + i; if (n < 1023) hid[((size_t)(kv * 1024 + n) * 2 + g) * 256 + j] = gelu_tanh(acc[i] + red[i * 256 + j]); } }
            __syncthreads();
        }
    }
#endif
#if !WIN_MFMA
    const float* btab = (const float*)(ws + WS_BT); float* ocw = (float*)(ws + WS_OCW);
    LAS float* qs = (LAS float*)(lds + wave * 8192);
    for (int task = wg * NWAVES + wave; task < T * 2; task += G * NWAVES) {
        const int t = task >> 1, g = task & 1;
        l1_load_q(ws, t, g, qs, lane);
        float m[4], l[4], o[4][2];
#pragma unroll
        for (int p = 0; p < 4; ++p) { m[p] = -INFINITY; l[p] = 0.f; o[p][0] = 0.f; o[p][1] = 0.f; }
        const int lo = t >= 511 ? t - 511 : 0;
        for (int key0 = lo; key0 <= t; key0 += 64)
            wattn_tile<128, 4, 0>(l1_tensor(ws, 16 + g), l1_tensor(ws, 18 + g), 128, key0, t + 1, t, 1, 0, 512, qs, btab, 4 * g, SCALE_C, m, l, o, nullptr, lane);
#pragma unroll
        for (int p = 0; p < 4; ++p) { const float gt = l1_gate(ws, t, 4 * g + p, 2) / fmaxf(l[p], 1e-30f);
            *(float2*)(ocw + (size_t)t * 1024 + (4 * g + p) * 128 + 2 * lane) = make_float2(gt * o[p][0], gt * o[p][1]); }
        asm volatile("" ::: "memory");
    }
#endif
}
__device__ __forceinline__ void l1_stage_b(const Params& P, int tid, int wg, int G) {
    unsigned char* ws = P.ws; const float* hid = (const float*)(ws + WS_HID); bf16* kc = (bf16*)(ws + WS_KCMP);
    for (int idx = wg * NTHR + tid; idx < 2 * 2 * 1023 * 128; idx += G * NTHR) {
        const int d = idx & 127; int r = idx >> 7; const int n = r % 1023; r /= 1023; const int g = r & 1, kv = r >> 1;
        const float* hp = hid + ((size_t)(kv * 1024 + n) * 2 + g) * 256; const float* w2 = P.in[kv ? I_V2 : I_K2] + d; float s = 0.f;
#pragma unroll 8
        for (int j = 0; j < 256; ++j) s += hp[j] * w2[(size_t)j * 128];
        kc[((size_t)(kv * 2 + g) * 1024 + n) * 128 + d] = (bf16)f2bf(s);
    }
}
__device__ __forceinline__ void l1_stage_c(const Params& P, LAS unsigned char* lds, int tid, int lane, int wave, int wg, int G) {
    unsigned char* ws = P.ws;
    const float* btab = (const float*)(ws + WS_BT); float* ocw = (float*)(ws + WS_OCW); unsigned* selmask = (unsigned*)(ws + WS_SELMASK);
    LAS float* qs = (LAS float*)(lds + wave * 8192); LAS float* cs = qs + 512 + 8;
    for (int task = wg * NWAVES + wave; task < T * 2; task += G * NWAVES) {
        const int t = task >> 1, g = task & 1, cur = t >> 6;
        l1_load_q(ws, t, g, qs, lane);
        for (int i = lane; i < 1040; i += 64) cs[i - 4] = 0.f;
        LDS_WAIT(); asm volatile("" ::: "memory");
        const bf16* kc = (const bf16*)(ws + WS_KCMP) + (size_t)(0 * 2 + g) * 1024 * 128; const bf16* vc = (const bf16*)(ws + WS_KCMP) + (size_t)(1 * 2 + g) * 1024 * 128;
        int nvalid = t >= 31 ? ((t - 31) >> 4) + 1 : 0; if (nvalid > 1023) nvalid = 1023;
        float m[4], l[4], o[4][2];
#pragma unroll
        for (int p = 0; p < 4; ++p) { m[p] = -INFINITY; l[p] = 0.f; o[p][0] = 0.f; o[p][1] = 0.f; }
        for (int key0 = 0; key0 < nvalid; key0 += 64)
            wattn_tile<128, 4, 1>(kc, vc, 128, key0, nvalid, t, 16, 31, 0x7fffffff, qs, btab, 4 * g, SCALE_C, m, l, o, cs, lane);
#pragma unroll
        for (int p = 0; p < 4; ++p) l[p] = 1.f / fmaxf(l[p], 1e-30f);
        for (int key0 = 0; key0 < nvalid; key0 += 64)
            wattn_tile<128, 4, 2>(kc, vc, 128, key0, nvalid, t, 16, 31, 0x7fffffff, qs, btab, 4 * g, SCALE_C, m, l, o, cs, lane);
#pragma unroll
        for (int p = 0; p < 4; ++p) { const float gt = l1_gate(ws, t, 4 * g + p, 0); float2* op = (float2*)(ocw + (size_t)t * 1024 + (4 * g + p) * 128 + 2 * lane);
            float2 v = *op; v.x += gt * o[p][0]; v.y += gt * o[p][1]; *op = v; }
        LDS_WAIT(); asm volatile("" ::: "memory");
        float iv[4];
#pragma unroll
        for (int i = 0; i < 4; ++i) { const int j = lane + 64 * i; float v = cs[4 * j - 1] + cs[4 * j] + cs[4 * j + 1] + cs[4 * j + 2] + cs[4 * j + 3];
            if (j == 0 || j == cur || j == cur - 1) v += 1e4f;
            if (j > cur) v = -1e30f;
            iv[i] = v; }
        unsigned mk[4] = {0u, 0u, 0u, 0u};
        for (int r = 0; r < 16; ++r) {
            float bv = iv[0]; int bi = lane;
#pragma unroll
            for (int i = 1; i < 4; ++i) if (iv[i] > bv) { bv = iv[i]; bi = lane + 64 * i; }
            wave_argmax(bv, bi); bi = __builtin_amdgcn_readfirstlane(bi);
            if (!(bv > -5e29f)) break;
#pragma unroll
            for (int i = 0; i < 4; ++i) if (lane + 64 * i == bi) { iv[i] = -INFINITY; mk[i] = 1u; }
        }
#pragma unroll
        for (int i = 0; i < 4; ++i) { const unsigned long long bal = __ballot(mk[i] != 0u);
            if (lane == 0) { selmask[((size_t)t * 2 + g) * 8 + 2 * i] = (unsigned)bal; selmask[((size_t)t * 2 + g) * 8 + 2 * i + 1] = (unsigned)(bal >> 32); } }
        asm volatile("" ::: "memory");
    }
}
__device__ __forceinline__ void l1_stage_d(const Params& P, LAS unsigned char* lds, int tid, int lane, int wave, int wg, int G) {
    unsigned char* ws = P.ws;
    const float* btab = (const float*)(ws + WS_BT); const float* ocw = (const float*)(ws + WS_OCW); const unsigned* selmask = (const unsigned*)(ws + WS_SELMASK);
    bf16* attnout = (bf16*)(ws + WS_XN);
    LAS float* qs = (LAS float*)(lds + wave * 8192);
    for (int task = wg * NWAVES + wave; task < T * 2; task += G * NWAVES) {
        const int t = task >> 1, g = task & 1;
        l1_load_q(ws, t, g, qs, lane);
        float m[4], l[4], o[4][2];
#pragma unroll
        for (int p = 0; p < 4; ++p) { m[p] = -INFINITY; l[p] = 0.f; o[p][0] = 0.f; o[p][1] = 0.f; }
        for (int w = 0; w < 8; ++w) {
            unsigned bits = __builtin_amdgcn_readfirstlane(selmask[((size_t)t * 2 + g) * 8 + w]);
            while (bits) { const int b = __builtin_ctz(bits); bits &= bits - 1u; const int key0 = (32 * w + b) * 64; const int kend = (key0 + 64) < (t + 1) ? (key0 + 64) : (t + 1);
                wattn_tile<128, 4, 0>(l1_tensor(ws, 12 + g), l1_tensor(ws, 14 + g), 128, key0, kend, t, 1, 0, 0x7fffffff, qs, btab, 4 * g, SCALE_C, m, l, o, nullptr, lane); }
        }
#pragma unroll
        for (int p = 0; p < 4; ++p) { const float gt = l1_gate(ws, t, 4 * g + p, 1) / fmaxf(l[p], 1e-30f); const float2 base = *(const float2*)(ocw + (size_t)t * 1024 + (4 * g + p) * 128 + 2 * lane);
            *(unsigned*)(attnout + (size_t)t * 1024 + (4 * g + p) * 128 + 2 * lane) = pk2(base.x + gt * o[p][0], base.y + gt * o[p][1]); }
        asm volatile("" ::: "memory");
    }
}

typedef short bf16x8 __attribute__((ext_vector_type(8)));
typedef short v4i16_t __attribute__((ext_vector_type(4)));
typedef float f32x16 __attribute__((ext_vector_type(16)));
typedef unsigned u4 __attribute__((ext_vector_type(4)));
template <int DH> struct AT { static constexpr int PK = DH * 2 + 16, TILE = 64 * PK, NKS = DH / 16, NDT = DH / 32, CPT = DH / 64; };
template <int DH> __device__ __forceinline__ int v_off(int row, int ch) {
    if (DH == 128) return 256 * row + 16 * (ch ^ (((row & 3) << 2) | ((row >> 2) & 3)));
    else return 128 * row + 16 * (ch ^ ((((row >> 1) & 1) << 2) | (((row >> 2) & 1) << 1) | ((row >> 3) & 1)));
}
constexpr int AT_BT_OFF = 4 * AT<128>::TILE;

template <int DH> __device__ __forceinline__ void at_load(const bf16* __restrict__ Kg, const bf16* __restrict__ Vg, int ldk, int key0, int kmax, u4 (&kr)[AT<DH>::CPT], u4 (&vr)[AT<DH>::CPT], int tid) {
#pragma unroll
    for (int i = 0; i < AT<DH>::CPT; ++i) { const int cid = tid + 512 * i, key = cid / (DH / 8), cc = cid % (DH / 8); int row = key0 + key; row = row < kmax ? row : kmax;
        kr[i] = *(const u4*)(Kg + (size_t)row * ldk + cc * 8); vr[i] = *(const u4*)(Vg + (size_t)row * ldk + cc * 8); }
}
template <int DH> __device__ __forceinline__ void at_load_k(const bf16* __restrict__ Kg, int ldk, int key0, int kmax, u4 (&kr)[AT<DH>::CPT], int tid) {
#pragma unroll
    for (int i = 0; i < AT<DH>::CPT; ++i) { const int cid = tid + 512 * i, key = cid / (DH / 8), cc = cid % (DH / 8); int row = key0 + key; row = row < kmax ? row : kmax;
        kr[i] = *(const u4*)(Kg + (size_t)row * ldk + cc * 8); }
}
template <int DH> __device__ __forceinline__ void at_store_k(LAS unsigned char* Kl, const u4 (&kr)[AT<DH>::CPT], int tid) {
#pragma unroll
    for (int i = 0; i < AT<DH>::CPT; ++i) { const int cid = tid + 512 * i, key = cid / (DH / 8), cc = cid % (DH / 8); *(LAS u4*)(Kl + key * AT<DH>::PK + cc * 16) = kr[i]; }
}
template <int DH> __device__ __forceinline__ void at_store(LAS unsigned char* Kl, LAS unsigned char* Vl, const u4 (&kr)[AT<DH>::CPT], const u4 (&vr)[AT<DH>::CPT], int tid) {
#pragma unroll
    for (int i = 0; i < AT<DH>::CPT; ++i) { const int cid = tid + 512 * i, key = cid / (DH / 8), cc = cid % (DH / 8);
        *(LAS u4*)(Kl + key * AT<DH>::PK + cc * 16) = kr[i]; *(LAS u4*)(Vl + v_off<DH>(key, cc)) = vr[i]; }
}
template <int DH, int KB = AT<DH>::NKS> __device__ __forceinline__ void at_qk(const LAS unsigned char* Kl, const bf16x8 (&qf)[AT<DH>::NKS], f32x16 (&s)[2], int r, int h) {
#pragma unroll
    for (int kt = 0; kt < 2; ++kt) {
        f32x16 a0;
#pragma unroll
        for (int i = 0; i < 16; ++i) a0[i] = 0.f;
#pragma unroll
        for (int k0 = 0; k0 < AT<DH>::NKS; k0 += KB) {
            bf16x8 kf[KB];
#pragma unroll
            for (int ks = 0; ks < KB; ++ks) kf[ks] = *(const LAS bf16x8*)(Kl + (32 * kt + r) * AT<DH>::PK + (16 * (k0 + ks) + 8 * h) * 2);
            asm volatile("" ::: "memory");
#pragma unroll
            for (int ks = 0; ks < KB; ++ks) a0 = __builtin_amdgcn_mfma_f32_32x32x16_bf16(kf[ks], qf[k0 + ks], a0, 0, 0, 0);
        }
        s[kt] = a0; }
}
template <int POSMUL, int POSADD, int DMAX> __device__ __forceinline__ float at_mask(f32x16 (&s)[2], int key0, int kend, int t_row, bool rowsel, const LAS float* brow, float scale, int h) {
    float lm = -INFINITY;
#pragma unroll
    for (int kt = 0; kt < 2; ++kt)
#pragma unroll
        for (int i4 = 0; i4 < 16; i4 += 4) {
            float bv[4];
#pragma unroll
            for (int i = i4; i < i4 + 4; ++i) { const int key = key0 + 32 * kt + (i & 3) + 8 * (i >> 2) + 4 * h; const int d = t_row - (POSMUL * key + POSADD); const int dd = d < 0 ? 0 : (d > 127 ? 127 : d); bv[i - i4] = brow[dd]; }
            asm volatile("" ::: "memory");
#pragma unroll
            for (int i = i4; i < i4 + 4; ++i) { const int key = key0 + 32 * kt + (i & 3) + 8 * (i >> 2) + 4 * h; const int d = t_row - (POSMUL * key + POSADD);
                const bool valid = rowsel && key < kend && (unsigned)d < (unsigned)DMAX;
                const float v = valid ? s[kt][i] * scale + bv[i - i4] : -INFINITY; s[kt][i] = v; lm = fmaxf(lm, v); }
        }
    return lm;
}
template <int DH, int DB = ((DH == 128) ? 1 : 2)> __device__ __forceinline__ void at_pv(const LAS unsigned char* Vl, const f32x16 (&s)[2], f32x16 (&o)[AT<DH>::NDT], int lane) {
    bf16x8 pb[4];
#pragma unroll
    for (int kt = 0; kt < 2; ++kt)
#pragma unroll
        for (int s2 = 0; s2 < 2; ++s2) { u4 w; w.x = pg8::cvt_pk_bf16(s[kt][8 * s2 + 0], s[kt][8 * s2 + 1]); w.y = pg8::cvt_pk_bf16(s[kt][8 * s2 + 2], s[kt][8 * s2 + 3]);
            w.z = pg8::cvt_pk_bf16(s[kt][8 * s2 + 4], s[kt][8 * s2 + 5]); w.w = pg8::cvt_pk_bf16(s[kt][8 * s2 + 6], s[kt][8 * s2 + 7]); pb[2 * kt + s2] = __builtin_bit_cast(bf16x8, w); }
    const int i16 = lane & 15, q4 = i16 >> 2, p4 = i16 & 3, half = (lane >> 4) & 1, h = lane >> 5;
#pragma unroll
    for (int dp = 0; dp < AT<DH>::NDT; dp += DB) {
        v4i16_t lo[4 * DB], hi[4 * DB];
#pragma unroll
        for (int d2 = 0; d2 < DB; ++d2)
#pragma unroll
            for (int ks4 = 0; ks4 < 4; ++ks4) {
                const int row = 16 * ks4 + 4 * h + q4, ch = 4 * (dp + d2) + 2 * half + (p4 >> 1);
                lo[4 * d2 + ks4] = __builtin_amdgcn_ds_read_tr16_b64_v4i16((LAS v4i16_t*)(Vl + v_off<DH>(row, ch) + 8 * (p4 & 1)));
                hi[4 * d2 + ks4] = __builtin_amdgcn_ds_read_tr16_b64_v4i16((LAS v4i16_t*)(Vl + v_off<DH>(row + 8, ch) + 8 * (p4 & 1))); }
        if (DB == 2) asm volatile("s_waitcnt lgkmcnt(0)" : "+v"(lo[0]), "+v"(lo[1]), "+v"(lo[2]), "+v"(lo[3]), "+v"(lo[4 * (DB - 1)]), "+v"(lo[4 * (DB - 1) + 1]), "+v"(lo[4 * (DB - 1) + 2]), "+v"(lo[4 * (DB - 1) + 3]),
                                  "+v"(hi[0]), "+v"(hi[1]), "+v"(hi[2]), "+v"(hi[3]), "+v"(hi[4 * (DB - 1)]), "+v"(hi[4 * (DB - 1) + 1]), "+v"(hi[4 * (DB - 1) + 2]), "+v"(hi[4 * (DB - 1) + 3]) :: "memory");
        else asm volatile("s_waitcnt lgkmcnt(0)" : "+v"(lo[0]), "+v"(lo[1]), "+v"(lo[2]), "+v"(lo[3]), "+v"(hi[0]), "+v"(hi[1]), "+v"(hi[2]), "+v"(hi[3]) :: "memory");
#pragma unroll
        for (int ks4 = 0; ks4 < 4; ++ks4)
#pragma unroll
            for (int d2 = 0; d2 < DB; ++d2) { const v4i16_t l_ = lo[4 * d2 + ks4], h_ = hi[4 * d2 + ks4];
                const bf16x8 a = {l_[0], l_[1], l_[2], l_[3], h_[0], h_[1], h_[2], h_[3]};
                o[dp + d2] = __builtin_amdgcn_mfma_f32_32x32x16_bf16(a, pb[ks4], o[dp + d2], 0, 0, 0); }
#pragma unroll
        for (int d2 = 0; d2 < DB; ++d2) asm volatile("" : "+v"(o[dp + d2]) :: "memory");
    }
}
template <int DH> __device__ __forceinline__ void at_softmax(f32x16 (&s)[2], float lm, float& m_run, float& l_run, f32x16 (&o)[AT<DH>::NDT]) {
    lm = fmaxf(lm, __shfl_xor(lm, 32));
    const float mn = fmaxf(m_run, lm); const float ms = (mn == -INFINITY) ? 0.f : mn;
    const float alpha = __expf(m_run - ms); m_run = mn;
    float ps = 0.f;
#pragma unroll
    for (int kt = 0; kt < 2; ++kt)
#pragma unroll
        for (int i = 0; i < 16; ++i) { const float p = __expf(s[kt][i] - ms); s[kt][i] = p; ps += p; }
    l_run = l_run * alpha + ps;
#pragma unroll
    for (int dt = 0; dt < AT<DH>::NDT; ++dt)
#pragma unroll
        for (int i = 0; i < 16; ++i) o[dt][i] *= alpha;
}
__device__ __forceinline__ void at_load_bt(const unsigned char* ws, LAS unsigned char* lds, int tid) {
    const float* bt = (const float*)(ws + WS_BT); LAS float* d = (LAS float*)(lds + AT_BT_OFF);
    for (int i = tid; i < 1024; i += NTHR) d[i] = bt[i];
}

constexpr float LOG2E = 1.4426950408889634f;
__device__ __forceinline__ float dpp_quad_xor1(float v) { return __builtin_bit_cast(float, __builtin_amdgcn_update_dpp(0, __builtin_bit_cast(int, v), 0xB1, 0xf, 0xf, false)); }
__device__ __forceinline__ float dpp_quad_xor2(float v) { return __builtin_bit_cast(float, __builtin_amdgcn_update_dpp(0, __builtin_bit_cast(int, v), 0x4E, 0xf, 0xf, false)); }
__device__ __forceinline__ unsigned wave_max_u32(unsigned v) {
    v = max(v, (unsigned)__builtin_amdgcn_update_dpp(0, (int)v, 0x128, 0xf, 0xf, false));
    v = max(v, (unsigned)__builtin_amdgcn_update_dpp(0, (int)v, 0x124, 0xf, 0xf, false));
    v = max(v, (unsigned)__builtin_amdgcn_update_dpp(0, (int)v, 0x122, 0xf, 0xf, false));
    v = max(v, (unsigned)__builtin_amdgcn_update_dpp(0, (int)v, 0x121, 0xf, 0xf, false));
    const auto a = __builtin_amdgcn_permlane16_swap(v, v, false, false); v = max(a[0], a[1]);
    const auto b = __builtin_amdgcn_permlane32_swap(v, v, false, false); v = max(b[0], b[1]);
    return v; }
__device__ __forceinline__ float max_xor32(float v) { const auto rr = __builtin_amdgcn_permlane32_swap(__builtin_bit_cast(unsigned, v), __builtin_bit_cast(unsigned, v), false, false);
    return fmaxf(__builtin_bit_cast(float, rr[0]), __builtin_bit_cast(float, rr[1])); }
__device__ __forceinline__ float max_xor16(float v) { const auto rr = __builtin_amdgcn_permlane16_swap(__builtin_bit_cast(unsigned, v), __builtin_bit_cast(unsigned, v), false, false);
    return fmaxf(__builtin_bit_cast(float, rr[0]), __builtin_bit_cast(float, rr[1])); }
constexpr float AT_THR = 8.f;
__device__ __forceinline__ void at_load_bt2(const unsigned char* ws, LAS unsigned char* lds, int off, int tid) {
    const float* bt = (const float*)(ws + WS_BT); LAS float* d = (LAS float*)(lds + off);
    for (int i = tid; i < 1024; i += NTHR) d[i] = bt[i] * LOG2E;
}
template <int POSMUL, int POSADD, int DMAX> __device__ __forceinline__ float at_scores(f32x16 (&s)[2], bool fast, int key0, int kend, int t_row, bool rowsel, const LAS float* brow2, float c1, int h) {
    float lm = -INFINITY;
    if (fast) {
#pragma unroll
        for (int kt = 0; kt < 2; ++kt)
#pragma unroll
            for (int i = 0; i < 16; ++i) lm = fmaxf(lm, s[kt][i]);
        lm = rowsel ? fmaf(lm, c1, brow2[127]) : -INFINITY;
    } else {
#pragma unroll
        for (int kt = 0; kt < 2; ++kt)
#pragma unroll
            for (int i4 = 0; i4 < 16; i4 += 4) {
                float bv[4];
#pragma unroll
                for (int i = i4; i < i4 + 4; ++i) { const int key = key0 + 32 * kt + (i & 3) + 8 * (i >> 2) + 4 * h; const int d = t_row - (POSMUL * key + POSADD); const int dd = d < 0 ? 0 : (d > 127 ? 127 : d); bv[i - i4] = brow2[dd]; }
                asm volatile("" ::: "memory");
#pragma unroll
                for (int i = i4; i < i4 + 4; ++i) { const int key = key0 + 32 * kt + (i & 3) + 8 * (i >> 2) + 4 * h; const int d = t_row - (POSMUL * key + POSADD);
                    const bool valid = rowsel && key < kend && (unsigned)d < (unsigned)DMAX;
                    const float v = valid ? fmaf(s[kt][i], c1, bv[i - i4]) : -INFINITY; s[kt][i] = v; lm = fmaxf(lm, v); }
            }
    }
    return max_xor32(lm);
}
__device__ __forceinline__ float at_probs(f32x16 (&s)[2], bool fast, bool rowsel, float bfar2, float c1, float sub) {
    float ps = 0.f;
    if (fast) { const float bb = rowsel ? (bfar2 - sub) : -INFINITY;
#pragma unroll
        for (int kt = 0; kt < 2; ++kt)
#pragma unroll
            for (int i = 0; i < 16; ++i) { const float p = __builtin_amdgcn_exp2f(fmaf(s[kt][i], c1, bb)); s[kt][i] = p; ps += p; }
    } else {
#pragma unroll
        for (int kt = 0; kt < 2; ++kt)
#pragma unroll
            for (int i = 0; i < 16; ++i) { const float p = __builtin_amdgcn_exp2f(s[kt][i] - sub); s[kt][i] = p; ps += p; }
    }
    return ps;
}
template <int DH, int POSMUL, int POSADD, int DMAX, int DB = ((DH == 128) ? 1 : 2), int KB = AT<DH>::NKS>
__device__ __forceinline__ void at_step(const LAS unsigned char* Kl, const LAS unsigned char* Vl, const bf16x8 (&qf)[AT<DH>::NKS], f32x16 (&o)[AT<DH>::NDT], float& m_run, float& l_run,
                                        bool fast, int key0, int kend, int t_row, bool rowsel, const LAS float* brow2, float c1, int r, int h, int lane) {
    f32x16 s[2];
    at_qk<DH, KB>(Kl, qf, s, r, h);
    const float lm = at_scores<POSMUL, POSADD, DMAX>(s, fast, key0, kend, t_row, rowsel, brow2, c1, h);
    if (!__all(lm <= m_run + AT_THR)) {
        const float mn = fmaxf(m_run, lm); const float ms = (mn == -INFINITY) ? 0.f : mn;
        const float alpha = __builtin_amdgcn_exp2f(m_run - ms); m_run = mn; l_run *= alpha;
#pragma unroll
        for (int dt = 0; dt < AT<DH>::NDT; ++dt)
#pragma unroll
            for (int i = 0; i < 16; ++i) o[dt][i] *= alpha;
    }
    const float sub = (m_run == -INFINITY) ? 0.f : m_run;
    l_run += at_probs(s, fast, rowsel, brow2[127], c1, sub);
    at_pv<DH, DB>(Vl, s, o, lane);
}

__device__ __forceinline__ void l1_window_mfma(const Params& P, LAS unsigned char* lds, int tid, int lane, int wave, int wg, int G) {
    unsigned char* ws = P.ws; float* ocw = (float*)(ws + WS_OCW);
    constexpr int TILE = AT<128>::TILE;
    at_load_bt2(ws, lds, AT_BT_OFF, tid);
    const int r = lane & 31, h = lane >> 5;
    for (int unit = wg; unit < 512; unit += G) {
        const int g = unit & 1, c = unit >> 1, t0 = 64 * c;
        const int t_row = t0 + 8 * wave + (r >> 2), head = 4 * g + (r & 3);
        const bf16* Kg = l1_tensor(ws, 16 + g); const bf16* Vg = l1_tensor(ws, 18 + g);
        bf16x8 qf[8];
        { const bf16* qrow = l1_tensor(ws, head) + (size_t)t_row * 128 + 8 * h;
#pragma unroll
          for (int ks = 0; ks < 8; ++ks) qf[ks] = *(const bf16x8*)(qrow + 16 * ks); }
        const bf16 graw = l1_gate_raw(ws, t_row, head, 2);
        const LAS float* brow = (const LAS float*)(lds + AT_BT_OFF) + head * 128;
        f32x16 o[4];
#pragma unroll
        for (int dt = 0; dt < 4; ++dt)
#pragma unroll
            for (int i = 0; i < 16; ++i) o[dt][i] = 0.f;
        float m_run = -INFINITY, l_run = 0.f;
        const int jlo = c >= 8 ? c - 8 : 0;
        u4 kr[2], vr[2];
        at_load<128>(Kg, Vg, 128, 64 * jlo, T - 1, kr, vr, tid);
        __syncthreads();
        for (int j = jlo; j <= c; ++j) {
            LAS unsigned char* Kl = lds + ((j - jlo) & 1) * 2 * TILE; LAS unsigned char* Vl = Kl + TILE;
            at_store<128>(Kl, Vl, kr, vr, tid);
            __syncthreads();
            if (j < c) at_load<128>(Kg, Vg, 128, 64 * (j + 1), T - 1, kr, vr, tid);
            const int dmin = t0 + 8 * wave - (64 * j + 63), dmax = t0 + 8 * wave + 7 - 64 * j;
            at_step<128, 1, 0, 512, 2>(Kl, Vl, qf, o, m_run, l_run, dmin >= 113 && dmax < 512, 64 * j, T, t_row, true, brow, SCALE_C * LOG2E, r, h, lane);
        }
        const float lt = l_run + __shfl_xor(l_run, 32);
        const float f = sigmoidf_(bf2f(graw)) / fmaxf(lt, 1e-30f);
        float* orow = ocw + (size_t)t_row * 1024 + head * 128 + 4 * h;
#pragma unroll
        for (int dt = 0; dt < 4; ++dt)
#pragma unroll
            for (int gq = 0; gq < 4; ++gq)
                *(float4*)(orow + 32 * dt + 8 * gq) = make_float4(o[dt][4 * gq] * f, o[dt][4 * gq + 1] * f, o[dt][4 * gq + 2] * f, o[dt][4 * gq + 3] * f);
    }
}

__device__ __forceinline__ void l1_sel_mfma(const Params& P, LAS unsigned char* lds, int tid, int lane, int wave, int wg, int G) {
    unsigned char* ws = P.ws; const float* ocw = (const float*)(ws + WS_OCW); const unsigned* selmask = (const unsigned*)(ws + WS_SELMASK);
    bf16* attnout = (bf16*)(ws + WS_XN);
    constexpr int TILE = AT<128>::TILE;
    LAS unsigned* selm = (LAS unsigned*)(lds + AT_BT_OFF + 4096);
    at_load_bt2(ws, lds, AT_BT_OFF, tid);
    const int r = lane & 31, h = lane >> 5;
    for (int u = wg; u < 512; u += G) {
        const int g = u & 1, k = u >> 1, c = k < 128 ? k : 383 - k, t0 = 64 * c;
        const int ql = 8 * wave + (r >> 2), t_row = t0 + ql, head = 4 * g + (r & 3);
        const bf16* Kg = l1_tensor(ws, 12 + g); const bf16* Vg = l1_tensor(ws, 14 + g);
        bf16x8 qf[8];
        { const bf16* qrow = l1_tensor(ws, head) + (size_t)t_row * 128 + 8 * h;
#pragma unroll
          for (int ks = 0; ks < 8; ++ks) qf[ks] = *(const bf16x8*)(qrow + 16 * ks); }
        const LAS float* brow = (const LAS float*)(lds + AT_BT_OFF) + head * 128;
        f32x16 o[4];
#pragma unroll
        for (int dt = 0; dt < 4; ++dt)
#pragma unroll
            for (int i = 0; i < 16; ++i) o[dt][i] = 0.f;
        float m_run = -INFINITY, l_run = 0.f;
        u4 kra[2], vra[2], krb[2], vrb[2];
        at_load<128>(Kg, Vg, 128, 0, T - 1, kra, vra, tid);
        if (c >= 1) at_load<128>(Kg, Vg, 128, 64, T - 1, krb, vrb, tid);
        __syncthreads();
        selm[tid] = selmask[((size_t)(t0 + (tid >> 3)) * 2 + g) * 8 + (tid & 7)];
#define SEL_STEP(KR, VR, BUF, J) do { const int j_ = (J); LAS unsigned char* Kl = lds + (BUF) * 2 * TILE; LAS unsigned char* Vl = Kl + TILE; \
            at_store<128>(Kl, Vl, KR, VR, tid); __syncthreads(); \
            if (j_ + 2 <= c) at_load<128>(Kg, Vg, 128, 64 * (j_ + 2), T - 1, KR, VR, tid); \
            const bool rowsel = (selm[ql * 8 + (j_ >> 5)] >> (j_ & 31)) & 1u; \
            if (__any(rowsel)) at_step<128, 1, 0, 0x7fffffff>(Kl, Vl, qf, o, m_run, l_run, t0 + 8 * wave - (64 * j_ + 63) >= 113, 64 * j_, T, t_row, rowsel, brow, SCALE_C * LOG2E, r, h, lane); } while (0)
        for (int j = 0; j <= c; j += 2) {
            SEL_STEP(kra, vra, 0, j);
            if (j + 1 <= c) SEL_STEP(krb, vrb, 1, j + 1);
        }
#undef SEL_STEP
        const float lt = l_run + __shfl_xor(l_run, 32);
        const float f = l1_gate(ws, t_row, head, 1) / fmaxf(lt, 1e-30f);
        const size_t ob = (size_t)t_row * 1024 + head * 128 + 4 * h;
#pragma unroll
        for (int dt = 0; dt < 4; ++dt)
#pragma unroll
            for (int gq = 0; gq < 4; ++gq) { const float4 b = *(const float4*)(ocw + ob + 32 * dt + 8 * gq);
                uint2 w; w.x = pk2(b.x + o[dt][4 * gq] * f, b.y + o[dt][4 * gq + 1] * f); w.y = pk2(b.z + o[dt][4 * gq + 2] * f, b.w + o[dt][4 * gq + 3] * f);
                *(uint2*)(attnout + ob + 32 * dt + 8 * gq) = w; }
    }
}

#define MOBA_INSERT(v_, idx_) do { const float v__ = (v_); const int x__ = (idx_); \
    const bool g0 = v__ > b0 || (v__ == b0 && x__ < i0), g1 = v__ > b1 || (v__ == b1 && x__ < i1), g2 = v__ > b2 || (v__ == b2 && x__ < i2); \
    const float nb2 = g1 ? b1 : (g2 ? v__ : b2); const int ni2 = g1 ? i1 : (g2 ? x__ : i2); \
    const float nb1 = g0 ? b0 : (g1 ? v__ : b1); const int ni1 = g0 ? i0 : (g1 ? x__ : i1); \
    const float nb0 = g0 ? v__ : b0; const int ni0 = g0 ? x__ : i0; \
    b0 = nb0; b1 = nb1; b2 = nb2; i0 = ni0; i1 = ni1; i2 = ni2; } while (0)
__device__ __forceinline__ void l0_moba_mfma(const Params& P, LAS unsigned char* lds, int tid, int lane, int wave, int wg, int G) {
    unsigned char* ws = P.ws; const bf16* proj = (const bf16*)(ws + WS_PROJ); bf16* attnout = (bf16*)(ws + WS_XN);
    const float* kmean = (const float*)(ws + WS_KMEAN);
    constexpr int TILE = AT<64>::TILE;
    LAS float* kml = (LAS float*)(lds + 81920);
    LAS unsigned* uni = (LAS unsigned*)(lds + 98304);
    at_load_bt2(ws, lds, AT_BT_OFF, tid);
    const int r = lane & 31, h = lane >> 5;
    for (int u = wg; u < 512; u += G) {
        const int head = u & 7, k = u >> 3, ob = k < 32 ? k : 95 - k, t0 = 256 * ob;
        const int t_row = t0 + 32 * wave + r;
        const bf16* Kg = proj + (size_t)1 * T * 512 + 64 * head; const bf16* Vg = proj + (size_t)2 * T * 512 + 64 * head;
        const bf16* qrow = proj + (size_t)t_row * 512 + 64 * head;
        __syncthreads();
        for (int i = tid; i < 64 * 64; i += NTHR) kml[i] = kmean[(size_t)head * 4096 + i];
        __syncthreads();
        unsigned mlo = 0u, mhi = 0u;
        {
            float qv[64];
#pragma unroll
            for (int i = 0; i < 8; ++i) { const u4 w = ((const u4*)qrow)[i]; qv[8 * i] = bflo(w.x); qv[8 * i + 1] = bfhi(w.x); qv[8 * i + 2] = bflo(w.y); qv[8 * i + 3] = bfhi(w.y);
                qv[8 * i + 4] = bflo(w.z); qv[8 * i + 5] = bfhi(w.z); qv[8 * i + 6] = bflo(w.w); qv[8 * i + 7] = bfhi(w.w); }
            float b0 = -INFINITY, b1 = -INFINITY, b2 = -INFINITY; int i0 = 0x7fffffff, i1 = 0x7fffffff, i2 = 0x7fffffff;
            for (int j = h; j < ob; j += 2) { const LAS f4* km = (const LAS f4*)(kml + j * 64); float sc = 0.f;
#pragma unroll
                for (int d4 = 0; d4 < 16; ++d4) { const f4 kv = km[d4]; sc += (kv.x * qv[4 * d4] + kv.y * qv[4 * d4 + 1]) + (kv.z * qv[4 * d4 + 2] + kv.w * qv[4 * d4 + 3]); }
                MOBA_INSERT(sc, j); }
            const float p0 = __shfl_xor(b0, 32), p1 = __shfl_xor(b1, 32), p2 = __shfl_xor(b2, 32); const int j0 = __shfl_xor(i0, 32), j1 = __shfl_xor(i1, 32), j2 = __shfl_xor(i2, 32);
            MOBA_INSERT(p0, j0); MOBA_INSERT(p1, j1); MOBA_INSERT(p2, j2);
            if (b0 > -INFINITY) { if (i0 < 32) mlo |= 1u << i0; else mhi |= 1u << (i0 - 32); }
            if (b1 > -INFINITY) { if (i1 < 32) mlo |= 1u << i1; else mhi |= 1u << (i1 - 32); }
            if (b2 > -INFINITY) { if (i2 < 32) mlo |= 1u << i2; else mhi |= 1u << (i2 - 32); }
        }
        {
            unsigned ulo = mlo, uhi = mhi;
#pragma unroll
            for (int o = 1; o < 64; o <<= 1) { ulo |= __shfl_xor(ulo, o); uhi |= __shfl_xor(uhi, o); }
            if (lane == 0) { uni[2 * wave] = ulo; uni[2 * wave + 1] = uhi; }
        }
        __syncthreads();
        unsigned long long un = 0ull;
#pragma unroll
        for (int w = 0; w < 8; ++w) un |= (unsigned long long)uni[2 * w] | ((unsigned long long)uni[2 * w + 1] << 32);
        un = ((unsigned long long)__builtin_amdgcn_readfirstlane((unsigned)(un >> 32)) << 32) | (unsigned long long)__builtin_amdgcn_readfirstlane((unsigned)un);
        un |= 1ull << ob;
        bf16x8 qf[4];
#pragma unroll
        for (int ks = 0; ks < 4; ++ks) qf[ks] = *(const bf16x8*)(qrow + 16 * ks + 8 * h);
        const LAS float* brow = (const LAS float*)(lds + AT_BT_OFF) + head * 128;
        f32x16 o[2];
#pragma unroll
        for (int dt = 0; dt < 2; ++dt)
#pragma unroll
            for (int i = 0; i < 16; ++i) o[dt][i] = 0.f;
        float m_run = -INFINITY, l_run = 0.f;
        LAS int* tl = (LAS int*)(lds + 98304 + 64);
        if (tid < 64 && ((un >> tid) & 1ull)) { const int pos = __builtin_popcountll(un & ((1ull << tid) - 1ull));
#pragma unroll
            for (int tt = 0; tt < 4; ++tt) tl[4 * pos + tt] = 256 * tid + 64 * tt; }
        const int nt = 4 * __builtin_popcountll(un);
        __syncthreads();
        u4 kra[1], vra[1], krb[1], vrb[1];
        at_load<64>(Kg, Vg, 512, tl[0], T - 1, kra, vra, tid);
        at_load<64>(Kg, Vg, 512, tl[1], T - 1, krb, vrb, tid);
#define MOBA_STEP(KR, VR, BUF, I) do { const int i_ = (I); LAS unsigned char* Kl = lds + (BUF) * 2 * TILE; LAS unsigned char* Vl = Kl + TILE; \
            at_store<64>(Kl, Vl, KR, VR, tid); __syncthreads(); \
            if (i_ + 2 < nt) at_load<64>(Kg, Vg, 512, tl[i_ + 2], T - 1, KR, VR, tid); \
            const int key0 = tl[i_], j = key0 >> 8, tt = (key0 >> 6) & 3; const bool own = (j == ob); \
            const bool rowsel = own ? true : (bool)(((j < 32 ? mlo >> j : mhi >> (j - 32)) & 1u) != 0u); \
            const bool wave_on = own ? (32 * wave + 31 >= 64 * tt) : (__any(rowsel) != 0); \
            if (wave_on) at_step<64, 1, 0, 0x7fffffff>(Kl, Vl, qf, o, m_run, l_run, t0 + 32 * wave - (key0 + 63) >= 113, key0, T, t_row, rowsel, brow, 0.125f * LOG2E, r, h, lane); } while (0)
        for (int i = 0; i < nt; i += 2) { MOBA_STEP(kra, vra, 0, i); MOBA_STEP(krb, vrb, 1, i + 1); }
#undef MOBA_STEP
        const float lt = l_run + __shfl_xor(l_run, 32);
        const float f = 1.f / fmaxf(lt, 1e-30f);
        bf16* orow = attnout + (size_t)t_row * 1024 + 64 * head + 4 * h;
#pragma unroll
        for (int dt = 0; dt < 2; ++dt)
#pragma unroll
            for (int gq = 0; gq < 4; ++gq) { uint2 w; w.x = pk2(o[dt][4 * gq] * f, o[dt][4 * gq + 1] * f); w.y = pk2(o[dt][4 * gq + 2] * f, o[dt][4 * gq + 3] * f);
                *(uint2*)(orow + 32 * dt + 8 * gq) = w; }
    }
}

__device__ __forceinline__ void l1_cmp_mfma(const Params& P, LAS unsigned char* lds, int tid, int lane, int wave, int wg, int G) {
    unsigned char* ws = P.ws; float* ocw = (float*)(ws + WS_OCW); unsigned* selmask = (unsigned*)(ws + WS_SELMASK);
    constexpr int TILE = AT<128>::TILE, BT_OFF = 2 * TILE, IMP_OFF = BT_OFF + 4096;
    LAS float* imp = (LAS float*)(lds + IMP_OFF);
    at_load_bt2(ws, lds, BT_OFF, tid);
    const int r = lane & 31, h = lane >> 5;
    const float c1 = SCALE_C * LOG2E;
    LAS unsigned char* Kl = lds; LAS unsigned char* Vl = lds + TILE;
    for (int u = wg; u < 512; u += G) {
        const int g = u & 1, k = u >> 1, c = k < 128 ? k : 383 - k, t0 = 64 * c;
        const int ql = 8 * wave + (r >> 2), t_row = t0 + ql, head = 4 * g + (r & 3);
        const bf16* Kg = (const bf16*)(ws + WS_KCMP) + (size_t)(0 * 2 + g) * 1024 * 128; const bf16* Vg = (const bf16*)(ws + WS_KCMP) + (size_t)(1 * 2 + g) * 1024 * 128;
        const int NV = (4 * c + 3) < 1023 ? (4 * c + 3) : 1023, ntiles = (NV + 63) >> 6;
        bf16x8 qf[8];
        { const bf16* qrow = l1_tensor(ws, head) + (size_t)t_row * 128 + 8 * h;
#pragma unroll
          for (int ks = 0; ks < 8; ++ks) qf[ks] = *(const bf16x8*)(qrow + 16 * ks); }
        const LAS float* brow = (const LAS float*)(lds + BT_OFF) + head * 128;
        float m_run = -INFINITY, l_run = 0.f;
        u4 kr[2], vr[2];
        at_load_k<128>(Kg, 128, 0, 1022, kr, tid);
#pragma unroll 1
        for (int tl = 0; tl < ntiles; ++tl) {
            __syncthreads();
            at_store_k<128>(Kl, kr, tid);
            __syncthreads();
            if (tl + 1 < ntiles) at_load_k<128>(Kg, 128, 64 * (tl + 1), 1022, kr, tid);
            f32x16 s[2];
            at_qk<128, 4>(Kl, qf, s, r, h);
            const bool fast = (64 * tl + 63 < NV) && (t0 + 8 * wave - (16 * (64 * tl + 63) + 31) >= 113);
            const float lm = at_scores<16, 31, 0x7fffffff>(s, fast, 64 * tl, NV, t_row, true, brow, c1, h);
            if (!__all(lm <= m_run + AT_THR)) { const float mn = fmaxf(m_run, lm); const float ms = (mn == -INFINITY) ? 0.f : mn; l_run *= __builtin_amdgcn_exp2f(m_run - ms); m_run = mn; }
            l_run += at_probs(s, fast, true, brow[127], c1, (m_run == -INFINITY) ? 0.f : m_run);
        }
        at_load<128>(Kg, Vg, 128, 0, 1022, kr, vr, tid);
        const float ltot = fmaxf(l_run + __shfl_xor(l_run, 32), 1e-30f);
        const float sub2 = ((m_run == -INFINITY) ? 0.f : m_run) + __builtin_amdgcn_logf(ltot);
        f32x16 o[4];
#pragma unroll
        for (int dt = 0; dt < 4; ++dt)
#pragma unroll
            for (int i = 0; i < 16; ++i) o[dt][i] = 0.f;
        float y_prev = 0.f;
#pragma unroll 1
        for (int tl = 0; tl < ntiles; ++tl) {
            __syncthreads();
            at_store<128>(Kl, Vl, kr, vr, tid);
            __syncthreads();
            if (tl + 1 < ntiles) at_load<128>(Kg, Vg, 128, 64 * (tl + 1), 1022, kr, vr, tid);
            f32x16 s[2];
            {
                int zoff = 0; asm volatile("" : "+v"(zoff));
                const bf16* qrow2 = l1_tensor(ws, head) + (size_t)t_row * 128 + 8 * h + zoff; bf16x8 qf2[8];
#pragma unroll
                for (int ks = 0; ks < 8; ++ks) qf2[ks] = *(const bf16x8*)(qrow2 + 16 * ks);
                at_qk<128, 4>(Kl, qf2, s, r, h);
            }
            const bool fast = (64 * tl + 63 < NV) && (t0 + 8 * wave - (16 * (64 * tl + 63) + 31) >= 113);
            (void)at_scores<16, 31, 0x7fffffff>(s, fast, 64 * tl, NV, t_row, true, brow, c1, h);
            (void)at_probs(s, fast, true, brow[127], c1, sub2);
#pragma unroll
            for (int idx = 0; idx < 8; ++idx) { const int kt = idx >> 2, gq = idx & 3;
                float g4 = (s[kt][4 * gq] + s[kt][4 * gq + 1]) + (s[kt][4 * gq + 2] + s[kt][4 * gq + 3]); float la = s[kt][4 * gq + 3];
                g4 += dpp_quad_xor1(g4); g4 += dpp_quad_xor2(g4); la += dpp_quad_xor1(la); la += dpp_quad_xor2(la);
                const auto sw = __builtin_amdgcn_permlane32_swap(__builtin_bit_cast(unsigned, la), __builtin_bit_cast(unsigned, la), false, false);
                const float y_cur = __builtin_bit_cast(float, h ? sw[0] : sw[1]);
                const float v = g4 + (h ? y_cur : y_prev); y_prev = y_cur;
                if ((r & 3) == 0) imp[ql * 256 + 16 * tl + 2 * idx + h] = v; }
            at_pv<128>(Vl, s, o, lane);
        }
        {
            const float f = l1_gate(ws, t_row, head, 0);
            float* orow = ocw + (size_t)t_row * 1024 + head * 128 + 4 * h;
#pragma unroll
            for (int dt = 0; dt < 4; ++dt)
#pragma unroll
                for (int gq = 0; gq < 4; ++gq) { float4 b = *(float4*)(orow + 32 * dt + 8 * gq);
                    b.x += o[dt][4 * gq] * f; b.y += o[dt][4 * gq + 1] * f; b.z += o[dt][4 * gq + 2] * f; b.w += o[dt][4 * gq + 3] * f; *(float4*)(orow + 32 * dt + 8 * gq) = b; }
        }
        __syncthreads();
        const int nsel = (c + 1) < 16 ? (c + 1) : 16;
#pragma unroll 1
        for (int qi = 0; qi < 8; ++qi) {
            const int q = 8 * wave + qi, t = t0 + q;
            unsigned key[4];
#pragma unroll
            for (int i = 0; i < 4; ++i) { const int j = lane + 64 * i; float v = imp[q * 256 + j];
                if (j == 0 || j == c || j == c - 1) v += 1e4f;
                key[i] = (j <= c) ? ((__builtin_bit_cast(unsigned, v) & 0xFFFFFF00u) | (unsigned)(255 - j)) : 0u; }
            unsigned mk[4] = {0u, 0u, 0u, 0u};
            for (int rr = 0; rr < nsel; ++rr) {
                const unsigned m = wave_max_u32(max(max(key[0], key[1]), max(key[2], key[3])));
#pragma unroll
                for (int i = 0; i < 4; ++i) if (m != 0u && key[i] == m) { key[i] = 0u; mk[i] = 1u; }
            }
#pragma unroll
            for (int i = 0; i < 4; ++i) { const unsigned long long bal = __ballot(mk[i] != 0u);
                if (lane == 0) { selmask[((size_t)t * 2 + g) * 8 + 2 * i] = (unsigned)bal; selmask[((size_t)t * 2 + g) * 8 + 2 * i + 1] = (unsigned)(bal >> 32); } }
        }
    }
}

struct EpiF32P {
    static constexpr bool PERM = false, AFTER_DRAIN = false;
    float* C; int ldc;
    __device__ __forceinline__ void operator()(const pg8::f32x4 (&acc)[2][2][4][2], const pg8::Unit& u, int wr, int wc, int fr, int fq) const {
        const int row0 = u.pm * 256 + wr * 64 + fr, col0 = u.pn * 256 + wc * 32 + 4 * fq;
#pragma unroll
        for (int ai = 0; ai < 2; ++ai)
#pragma unroll
            for (int m = 0; m < 4; ++m) { float* rowp = C + (size_t)(row0 + ai * 128 + m * 16) * ldc + col0;
#pragma unroll
                for (int bj = 0; bj < 2; ++bj)
#pragma unroll
                    for (int n = 0; n < 2; ++n) *(pg8::f32x4*)(rowp + bj * 128 + n * 16) = acc[ai][bj][m][n]; }
    }
};
struct OneUnit { int pm;
    __device__ __forceinline__ bool next(int i, pg8::Unit& u) const { if (i) return false; u.pm = pm; u.pn = 0; return true; }
    __device__ __forceinline__ void a_ready(const pg8::Unit&) const {}
    __device__ __forceinline__ void done(const pg8::Unit&) const {}
};
__device__ __forceinline__ void l1_compress_gemm(const Params& P, LAS unsigned char* lds, int tid, int wg) {
    unsigned char* ws = P.ws;
    if (wg < 64) {
        const int prob = wg >> 2, pm = wg & 3, kv = prob >> 3, g = (prob >> 2) & 1, sp = prob & 3;
        pg8::Gemm gm{l1_tensor(ws, (kv ? 10 : 8) + g) + sp * 1024, (const bf16*)(ws + (kv ? WS_CW1V : WS_CW1K)) + sp * 1024, 1024, 256, 1024, 2048, 4096};
        OneUnit S{pm}; EpiF32P E{(float*)(ws + WS_CPART) + (size_t)((sp * 2 + kv) * 2 + g) * 1024 * 256, 256};
        pg8::gemm_phase<EpiF32P, OneUnit, true, true>((PG8_LAS unsigned char*)lds, gm, S, E);
    } else if (wg < 96) {
        const int tq = wg - 64, kv = tq >> 4, l = 2 * (tq & 15) + (tid >> 8), j = tid & 255;
        const float* pos = P.in[kv ? I_POSV : I_POSK] + l * 128; const float* w1 = P.in[kv ? I_V1 : I_K1] + (size_t)l * 128 * 256 + j; float s = 0.f;
#pragma unroll 8
        for (int d = 0; d < 128; ++d) s += pos[d] * w1[(size_t)d * 256];
        ((float*)(ws + WS_POSP))[(kv * 32 + l) * 256 + j] = s;
    }
}
__device__ __forceinline__ void l1_compress_out(const Params& P, LAS unsigned char* lds, int tid, int wg, int G) {
    unsigned char* ws = P.ws; const float* part = (const float*)(ws + WS_CPART); const float* posp = (const float*)(ws + WS_POSP); bf16* kc = (bf16*)(ws + WS_KCMP);
    LAS float* pb = (LAS float*)lds; LAS float* hs = (LAS float*)(lds + 1024);
    for (int task = wg; task < 256; task += G) {
        const int kv = task >> 7, g = (task >> 6) & 1, n0 = (task & 63) * 16;
        __syncthreads();
        if (tid < 256) { float s = 0.f;
#pragma unroll 8
            for (int l = 0; l < 32; ++l) s += posp[(kv * 32 + l) * 256 + tid]; pb[tid] = s; }
        __syncthreads();
#pragma unroll
        for (int i = 0; i < 8; ++i) { const int e = tid + 512 * i, row = e >> 8, j = e & 255; float s = pb[j];
#pragma unroll
            for (int sp = 0; sp < 4; ++sp) s += part[((size_t)((sp * 2 + kv) * 2 + g) * 1024 + n0 + row) * 256 + j];
            hs[e] = gelu_tanh(s); }
        __syncthreads();
        const int d = tid & 127, rq = tid >> 7; const float* w2 = P.in[kv ? I_V2 : I_K2] + d; float acc[4] = {0.f, 0.f, 0.f, 0.f};
        for (int j = 0; j < 256; ++j) { const float w = w2[(size_t)j * 128];
#pragma unroll
            for (int i = 0; i < 4; ++i) acc[i] += hs[(rq + 4 * i) * 256 + j] * w; }
#pragma unroll
        for (int i = 0; i < 4; ++i) { const int n = n0 + rq + 4 * i; if (n < 1023) kc[((size_t)(kv * 2 + g) * 1024 + n) * 128 + d] = (bf16)f2bf(acc[i]); }
    }
}

__device__ __forceinline__ void l0_route(const Params& P, LAS unsigned char* lds, int tid, int lane, int wave, int wg, int G) {
    unsigned char* ws = P.ws; const bf16* proj = (const bf16*)(ws + WS_PROJ); const float* kmean = (const float*)(ws + WS_KMEAN);
    unsigned long long* selq = (unsigned long long*)(ws + WS_SELQ); unsigned* selT = (unsigned*)(ws + WS_SELT);
    LAS float* kml = (LAS float*)lds;
    const int r = lane & 31, h = lane >> 5;
    for (int u = wg; u < 512; u += G) {
        const int head = u & 7, k = u >> 3, ob = k < 32 ? k : 95 - k, t_row = 256 * ob + 32 * wave + r;
        const bf16* qrow = proj + (size_t)t_row * 512 + 64 * head;
        __syncthreads();
        for (int i = tid; i < 64 * 64; i += NTHR) kml[i] = kmean[(size_t)head * 4096 + i];
        __syncthreads();
        unsigned mlo = 0u, mhi = 0u;
        float qv[64];
#pragma unroll
        for (int i = 0; i < 8; ++i) { const u4 w = ((const u4*)qrow)[i]; qv[8 * i] = bflo(w.x); qv[8 * i + 1] = bfhi(w.x); qv[8 * i + 2] = bflo(w.y); qv[8 * i + 3] = bfhi(w.y);
            qv[8 * i + 4] = bflo(w.z); qv[8 * i + 5] = bfhi(w.z); qv[8 * i + 6] = bflo(w.w); qv[8 * i + 7] = bfhi(w.w); }
        float b0 = -INFINITY, b1 = -INFINITY, b2 = -INFINITY; int i0 = 0x7fffffff, i1 = 0x7fffffff, i2 = 0x7fffffff;
        for (int j = h; j < ob; j += 2) { const LAS f4* km = (const LAS f4*)(kml + j * 64); float sc = 0.f;
#pragma unroll
            for (int d4 = 0; d4 < 16; ++d4) { const f4 kv = km[d4]; sc += (kv.x * qv[4 * d4] + kv.y * qv[4 * d4 + 1]) + (kv.z * qv[4 * d4 + 2] + kv.w * qv[4 * d4 + 3]); }
            MOBA_INSERT(sc, j); }
        const float p0 = __shfl_xor(b0, 32), p1 = __shfl_xor(b1, 32), p2 = __shfl_xor(b2, 32); const int j0 = __shfl_xor(i0, 32), j1 = __shfl_xor(i1, 32), j2 = __shfl_xor(i2, 32);
        MOBA_INSERT(p0, j0); MOBA_INSERT(p1, j1); MOBA_INSERT(p2, j2);
        if (b0 > -INFINITY) { if (i0 < 32) mlo |= 1u << i0; else mhi |= 1u << (i0 - 32); }
        if (b1 > -INFINITY) { if (i1 < 32) mlo |= 1u << i1; else mhi |= 1u << (i1 - 32); }
        if (b2 > -INFINITY) { if (i2 < 32) mlo |= 1u << i2; else mhi |= 1u << (i2 - 32); }
        if (h == 0) selq[(size_t)t_row * 8 + head] = ((unsigned long long)mhi << 32) | (unsigned long long)mlo;
        for (int j = 0; j < ob; ++j) { const unsigned bit = ((j < 32 ? mlo >> j : mhi >> (j - 32)) & 1u); const unsigned long long bal = __ballot(bit != 0u);
            if (lane == 0) selT[((size_t)(head * 64 + j) * 64 + ob) * 8 + wave] = (unsigned)bal; }
    }
}
__device__ __forceinline__ void moba_write_partial(unsigned char* ws, const f32x16 (&o)[2], float m_run, float l_run, int tq, int head, int slot, bool valid_row, int h) {
    const float lt = l_run + __shfl_xor(l_run, 32); const float inv = 1.f / fmaxf(lt, 1e-30f);
    if (valid_row) { const size_t rec = ((size_t)tq * 8 + head) * 4 + slot; bf16* po = (bf16*)(ws + WS_PO) + rec * 64 + 4 * h;
#pragma unroll
        for (int dt = 0; dt < 2; ++dt)
#pragma unroll
            for (int gq = 0; gq < 4; ++gq) { uint2 w; w.x = pk2(o[dt][4 * gq] * inv, o[dt][4 * gq + 1] * inv); w.y = pk2(o[dt][4 * gq + 2] * inv, o[dt][4 * gq + 3] * inv);
                *(uint2*)(po + 32 * dt + 8 * gq) = w; }
        if (h == 0) ((float2*)(ws + WS_PML))[rec] = make_float2(m_run, lt); }
}
constexpr int MOBA_NB = 8 * (15 + 31 + 47 + 63);
constexpr int MOBA_NU = MOBA_NB + 512;
__device__ __forceinline__ void l0_moba_gather(const Params& P, LAS unsigned char* lds, int tid, int lane, int wave, int wg, int G) {
    unsigned char* ws = P.ws; const bf16* proj = (const bf16*)(ws + WS_PROJ);
    const unsigned long long* selq = (const unsigned long long*)(ws + WS_SELQ); const unsigned* selT = (const unsigned*)(ws + WS_SELT);
    unsigned* queue = (unsigned*)(ws + WS_CTL) + CW_QUEUE;
    constexpr int TILE = AT<64>::TILE, BTO = 8 * TILE;
    LAS int* rows = (LAS int*)(lds + BTO + 4096);
    LAS unsigned* wsum = (LAS unsigned*)(lds + BTO + 4096 + 16384);
    at_load_bt2(ws, lds, BTO, tid);
    const int r = lane & 31, h = lane >> 5;
    const float c1 = 0.125f * LOG2E;
    int unit = wg, it = 0;
    while (unit < MOBA_NU) {
        unsigned nxt_ = 0u; if (tid == 0) nxt_ = __hip_atomic_fetch_add(queue, 1u, __ATOMIC_RELAXED, __HIP_MEMORY_SCOPE_AGENT) + (unsigned)G;
        __syncthreads();
        if (unit < MOBA_NB) {
            int rg, rem; if (unit < 120) { rg = 0; rem = unit; } else if (unit < 368) { rg = 1; rem = unit - 120; } else if (unit < 744) { rg = 2; rem = unit - 368; } else { rg = 3; rem = unit - 744; }
            const int head = rem & 7, j = rem >> 3;
            const bf16* Kg = proj + (size_t)1 * T * 512 + 64 * head; const bf16* Vg = proj + (size_t)2 * T * 512 + 64 * head;
            const LAS float* brow = (const LAS float*)(lds + BTO) + head * 128;
            const int ob = 16 * rg + (tid >> 5), word = (tid & 31) >> 2, sh = 8 * (tid & 3);
            unsigned bits = (ob > j && ob <= 63) ? ((selT[((size_t)(head * 64 + j) * 64 + ob) * 8 + word] >> sh) & 0xffu) : 0u;
#pragma unroll
            for (int tt = 0; tt < 4; ++tt) { u4 kr[1], vr[1]; at_load<64>(Kg, Vg, 512, 256 * j + 64 * tt, T - 1, kr, vr, tid); at_store<64>(lds + tt * TILE, lds + (4 + tt) * TILE, kr, vr, tid); }
            const int cnt = __builtin_popcount(bits); int incl = cnt;
#pragma unroll
            for (int o_ = 1; o_ < 64; o_ <<= 1) { const int v = __shfl_up(incl, o_); if (lane >= o_) incl += v; }
            if (lane == 63) wsum[wave] = (unsigned)incl;
            __syncthreads();
            int base = 0, n = 0;
#pragma unroll
            for (int w = 0; w < 8; ++w) { const int x = (int)wsum[w]; if (w < wave) base += x; n += x; }
            int pos = base + incl - cnt;
            while (bits) { const int b = __builtin_ctz(bits); bits &= bits - 1u; rows[pos++] = 256 * ob + 8 * (tid & 31) + b; }
            __syncthreads();
            const int ntile = (n + 31) >> 5;
            for (int tile = wave; tile < ntile; tile += NWAVES) {
                const int idx = 32 * tile + r; const bool valid_row = idx < n; const int tq = rows[valid_row ? idx : (n - 1)];
                const int tmin = __builtin_amdgcn_readfirstlane(rows[32 * tile]);
                const bf16* qrow = proj + (size_t)tq * 512 + 64 * head;
                bf16x8 qf[4];
#pragma unroll
                for (int ks = 0; ks < 4; ++ks) qf[ks] = *(const bf16x8*)(qrow + 16 * ks + 8 * h);
                const unsigned long long sq = selq[(size_t)tq * 8 + head];
                f32x16 o[2];
#pragma unroll
                for (int dt = 0; dt < 2; ++dt)
#pragma unroll
                    for (int i = 0; i < 16; ++i) o[dt][i] = 0.f;
                float m_run = -INFINITY, l_run = 0.f;
#pragma unroll 1
                for (int tt = 0; tt < 4; ++tt) { const int key0 = 256 * j + 64 * tt;
                    at_step<64, 1, 0, 0x7fffffff>(lds + tt * TILE, lds + (4 + tt) * TILE, qf, o, m_run, l_run, tmin - (key0 + 63) >= 113, key0, T, tq, true, brow, c1, r, h, lane); }
                const int slot = __builtin_popcountll(sq & ((1ull << j) - 1ull));
                moba_write_partial(ws, o, m_run, l_run, tq, head, slot, valid_row, h);
            }
        } else {
            const int ua = unit - MOBA_NB, head = ua & 7, ob = 63 - (ua >> 3), t0 = 256 * ob, t_row = t0 + 32 * wave + r;
            const bf16* Kg = proj + (size_t)1 * T * 512 + 64 * head; const bf16* Vg = proj + (size_t)2 * T * 512 + 64 * head;
            const LAS float* brow = (const LAS float*)(lds + BTO) + head * 128;
            const bf16* qrow = proj + (size_t)t_row * 512 + 64 * head;
            bf16x8 qf[4];
#pragma unroll
            for (int ks = 0; ks < 4; ++ks) qf[ks] = *(const bf16x8*)(qrow + 16 * ks + 8 * h);
            f32x16 o[2];
#pragma unroll
            for (int dt = 0; dt < 2; ++dt)
#pragma unroll
                for (int i = 0; i < 16; ++i) o[dt][i] = 0.f;
            float m_run = -INFINITY, l_run = 0.f;
            u4 kr[1], vr[1];
            at_load<64>(Kg, Vg, 512, t0, T - 1, kr, vr, tid);
#pragma unroll 1
            for (int tt = 0; tt < 4; ++tt) {
                LAS unsigned char* Kl = lds + (tt & 1) * 2 * TILE; LAS unsigned char* Vl = Kl + TILE;
                at_store<64>(Kl, Vl, kr, vr, tid);
                __syncthreads();
                if (tt < 3) at_load<64>(Kg, Vg, 512, t0 + 64 * (tt + 1), T - 1, kr, vr, tid);
                if (32 * wave + 31 >= 64 * tt)
                    at_step<64, 1, 0, 0x7fffffff>(Kl, Vl, qf, o, m_run, l_run, false, t0 + 64 * tt, T, t_row, true, brow, c1, r, h, lane);
            }
            moba_write_partial(ws, o, m_run, l_run, t_row, head, 3, true, h);
        }
        if (tid == 0) wsum[16 + (it & 1)] = nxt_;
        __syncthreads();
        unit = (int)wsum[16 + (it & 1)]; ++it;
    }
}
__device__ __forceinline__ void l0_moba_merge(const Params& P, int tid, int wg, int G) {
    unsigned char* ws = P.ws; const unsigned long long* selq = (const unsigned long long*)(ws + WS_SELQ);
    const bf16* po = (const bf16*)(ws + WS_PO); const float2* pml = (const float2*)(ws + WS_PML); bf16* attnout = (bf16*)(ws + WS_XN);
    constexpr int NIT = T * 8 * 16;
    for (int idx0 = wg * NTHR + tid; idx0 < NIT; idx0 += 4 * G * NTHR) {
        unsigned long long sq[4]; float2 ml[4][4]; uint2 pv[4][4];
#pragma unroll
        for (int u = 0; u < 4; ++u) { const int idx = idx0 + u * G * NTHR; const int ic = idx < NIT ? idx : idx0; const int dq = ic & 15, th = ic >> 4;
            sq[u] = selq[th];
#pragma unroll
            for (int s_ = 0; s_ < 4; ++s_) { ml[u][s_] = pml[(size_t)th * 4 + s_]; pv[u][s_] = *(const uint2*)(po + ((size_t)th * 4 + s_) * 64 + 4 * dq); } }
#pragma unroll
        for (int u = 0; u < 4; ++u) { const int idx = idx0 + u * G * NTHR;
            if (idx < NIT) {
                const int dq = idx & 15, th = idx >> 4; const int cnt = __builtin_popcountll(sq[u]);
                float M = ml[u][3].x;
#pragma unroll
                for (int s_ = 0; s_ < 3; ++s_) { if (s_ >= cnt) { ml[u][s_] = make_float2(-INFINITY, 0.f); pv[u][s_] = make_uint2(0u, 0u); } M = fmaxf(M, ml[u][s_].x); }
                float a0 = 0.f, a1 = 0.f, a2 = 0.f, a3 = 0.f, den = 0.f;
#pragma unroll
                for (int s_ = 0; s_ < 4; ++s_) { const float w = ml[u][s_].y * __builtin_amdgcn_exp2f(ml[u][s_].x - M); const uint2 v = pv[u][s_];
                    a0 += w * bflo(v.x); a1 += w * bfhi(v.x); a2 += w * bflo(v.y); a3 += w * bfhi(v.y); den += w; }
                const float inv = 1.f / fmaxf(den, 1e-30f);
                uint2 o; o.x = pk2(a0 * inv, a1 * inv); o.y = pk2(a2 * inv, a3 * inv);
                *(uint2*)(attnout + (size_t)(th >> 3) * 1024 + 64 * (th & 7) + 4 * dq) = o;
            }
        }
    }
}

typedef float f32x4v __attribute__((ext_vector_type(4)));
__device__ __forceinline__ void at16_step(const LAS unsigned char* Kl, const LAS unsigned char* Vl, const bf16x8 (&qf)[4], f32x4v (&o)[8], float& m_run, float& l_run,
                                          bool fast, int key0, int kend, int t_row, bool rowsel, const LAS float* brow2, float bfar_in, float c1, int lane) {
    constexpr int PK = AT<128>::PK;
    const int r16 = lane & 15, gl = lane >> 4;
    f32x4v s[4];
    {
        bf16x8 kf[16];
#pragma unroll
        for (int kt = 0; kt < 4; ++kt)
#pragma unroll
            for (int ks = 0; ks < 4; ++ks) kf[4 * kt + ks] = *(const LAS bf16x8*)(Kl + (16 * kt + r16) * PK + (32 * ks + 8 * gl) * 2);
        asm volatile("" ::: "memory");
#pragma unroll
        for (int kt = 0; kt < 4; ++kt) s[kt] = (f32x4v){0.f, 0.f, 0.f, 0.f};
#pragma unroll
        for (int ks = 0; ks < 4; ++ks)
#pragma unroll
            for (int kt = 0; kt < 4; ++kt) s[kt] = __builtin_amdgcn_mfma_f32_16x16x32_bf16(kf[4 * kt + ks], qf[ks], s[kt], 0, 0, 0);
    }
    float bfar = bfar_in;
    float lm = -INFINITY;
    if (!fast) {
        float bv[16];
#pragma unroll
        for (int kt = 0; kt < 4; ++kt)
#pragma unroll
            for (int i = 0; i < 4; ++i) { const int d = t_row - (key0 + 16 * kt + 4 * gl + i); const int dd = d < 0 ? 0 : (d > 127 ? 127 : d); bv[4 * kt + i] = brow2[dd]; }
        asm volatile("" ::: "memory");
#pragma unroll
        for (int kt = 0; kt < 4; ++kt)
#pragma unroll
            for (int i = 0; i < 4; ++i) { const int key = key0 + 16 * kt + 4 * gl + i; const int d = t_row - key;
                const bool valid = rowsel && key < kend && d >= 0;
                const float v = valid ? fmaf(s[kt][i], c1, bv[4 * kt + i]) : -INFINITY; s[kt][i] = v; lm = fmaxf(lm, v); }
    }
    asm volatile("s_waitcnt lgkmcnt(0)" : "+v"(bfar) :: "memory");
    const int q4 = r16 >> 2, p4 = r16 & 3;
    v4i16_t lo0[8], hi0[8];
#pragma unroll
    for (int d4 = 0; d4 < 4; ++d4)
#pragma unroll
        for (int s2 = 0; s2 < 2; ++s2) { const int row = 32 * s2 + 4 * gl + q4, ch = 2 * d4 + (p4 >> 1);
            lo0[2 * d4 + s2] = __builtin_amdgcn_ds_read_tr16_b64_v4i16((LAS v4i16_t*)(Vl + v_off<128>(row, ch) + 8 * (p4 & 1)));
            hi0[2 * d4 + s2] = __builtin_amdgcn_ds_read_tr16_b64_v4i16((LAS v4i16_t*)(Vl + v_off<128>(row + 16, ch) + 8 * (p4 & 1))); }
    asm volatile("" ::: "memory");
    if (fast) {
#pragma unroll
        for (int kt = 0; kt < 4; ++kt)
#pragma unroll
            for (int i = 0; i < 4; ++i) lm = fmaxf(lm, s[kt][i]);
        lm = rowsel ? fmaf(lm, c1, bfar) : -INFINITY;
    }
    lm = max_xor32(max_xor16(lm));
    if (!__all(lm <= m_run + AT_THR)) {
        const float mn = fmaxf(m_run, lm); const float ms = (mn == -INFINITY) ? 0.f : mn;
        const float alpha = __builtin_amdgcn_exp2f(m_run - ms); m_run = mn; l_run *= alpha;
#pragma unroll
        for (int dt = 0; dt < 8; ++dt)
#pragma unroll
            for (int i = 0; i < 4; ++i) o[dt][i] *= alpha;
    }
    const float sub = (m_run == -INFINITY) ? 0.f : m_run;
    float ps = 0.f;
    if (fast) { const float bb = rowsel ? (bfar - sub) : -INFINITY;
#pragma unroll
        for (int kt = 0; kt < 4; ++kt)
#pragma unroll
            for (int i = 0; i < 4; ++i) { const float p = __builtin_amdgcn_exp2f(fmaf(s[kt][i], c1, bb)); s[kt][i] = p; ps += p; }
    } else {
#pragma unroll
        for (int kt = 0; kt < 4; ++kt)
#pragma unroll
            for (int i = 0; i < 4; ++i) { const float p = __builtin_amdgcn_exp2f(s[kt][i] - sub); s[kt][i] = p; ps += p; }
    }
    l_run += ps;
    bf16x8 pb[2];
#pragma unroll
    for (int s2 = 0; s2 < 2; ++s2) { u4 w; w.x = pg8::cvt_pk_bf16(s[2 * s2][0], s[2 * s2][1]); w.y = pg8::cvt_pk_bf16(s[2 * s2][2], s[2 * s2][3]);
        w.z = pg8::cvt_pk_bf16(s[2 * s2 + 1][0], s[2 * s2 + 1][1]); w.w = pg8::cvt_pk_bf16(s[2 * s2 + 1][2], s[2 * s2 + 1][3]); pb[s2] = __builtin_bit_cast(bf16x8, w); }
    asm volatile("s_waitcnt lgkmcnt(0)" : "+v"(lo0[0]), "+v"(lo0[1]), "+v"(lo0[2]), "+v"(lo0[3]), "+v"(lo0[4]), "+v"(lo0[5]), "+v"(lo0[6]), "+v"(lo0[7]),
                 "+v"(hi0[0]), "+v"(hi0[1]), "+v"(hi0[2]), "+v"(hi0[3]), "+v"(hi0[4]), "+v"(hi0[5]), "+v"(hi0[6]), "+v"(hi0[7]) :: "memory");
    v4i16_t lo1[8], hi1[8];
#pragma unroll
    for (int d4 = 0; d4 < 4; ++d4)
#pragma unroll
        for (int s2 = 0; s2 < 2; ++s2) { const int row = 32 * s2 + 4 * gl + q4, ch = 2 * (4 + d4) + (p4 >> 1);
            lo1[2 * d4 + s2] = __builtin_amdgcn_ds_read_tr16_b64_v4i16((LAS v4i16_t*)(Vl + v_off<128>(row, ch) + 8 * (p4 & 1)));
            hi1[2 * d4 + s2] = __builtin_amdgcn_ds_read_tr16_b64_v4i16((LAS v4i16_t*)(Vl + v_off<128>(row + 16, ch) + 8 * (p4 & 1))); }
    asm volatile("" ::: "memory");
#pragma unroll
    for (int s2 = 0; s2 < 2; ++s2)
#pragma unroll
        for (int d4 = 0; d4 < 4; ++d4) { const v4i16_t l_ = lo0[2 * d4 + s2], h_ = hi0[2 * d4 + s2];
            const bf16x8 a = {l_[0], l_[1], l_[2], l_[3], h_[0], h_[1], h_[2], h_[3]};
            o[d4] = __builtin_amdgcn_mfma_f32_16x16x32_bf16(a, pb[s2], o[d4], 0, 0, 0); }
    asm volatile("s_waitcnt lgkmcnt(0)" : "+v"(lo1[0]), "+v"(lo1[1]), "+v"(lo1[2]), "+v"(lo1[3]), "+v"(lo1[4]), "+v"(lo1[5]), "+v"(lo1[6]), "+v"(lo1[7]),
                 "+v"(hi1[0]), "+v"(hi1[1]), "+v"(hi1[2]), "+v"(hi1[3]), "+v"(hi1[4]), "+v"(hi1[5]), "+v"(hi1[6]), "+v"(hi1[7]) :: "memory");
#pragma unroll
    for (int s2 = 0; s2 < 2; ++s2)
#pragma unroll
        for (int d4 = 0; d4 < 4; ++d4) { const v4i16_t l_ = lo1[2 * d4 + s2], h_ = hi1[2 * d4 + s2];
            const bf16x8 a = {l_[0], l_[1], l_[2], l_[3], h_[0], h_[1], h_[2], h_[3]};
            o[4 + d4] = __builtin_amdgcn_mfma_f32_16x16x32_bf16(a, pb[s2], o[4 + d4], 0, 0, 0); }
}
__device__ __forceinline__ void l1_sel16(const Params& P, LAS unsigned char* lds, int tid, int lane, int wave, int wg, int G) {
    unsigned char* ws = P.ws; const float* ocw = (const float*)(ws + WS_OCW); const unsigned* selmask = (const unsigned*)(ws + WS_SELMASK);
    bf16* attnout = (bf16*)(ws + WS_XN);
    constexpr int TILE = AT<128>::TILE;
    LAS unsigned* selm = (LAS unsigned*)(lds + AT_BT_OFF + 4096);
    at_load_bt2(ws, lds, AT_BT_OFF, tid);
    const int r16 = lane & 15, gl = lane >> 4;
    for (int u = wg; u < 512; u += G) {
        const int g = u & 1, k = u >> 1, c = k < 128 ? k : 383 - k, t0 = 64 * c;
        const int head = 4 * g + (r16 & 3);
        const int ql0 = 8 * wave + (r16 >> 2), ql1 = ql0 + 4;
        const bf16* Kg = l1_tensor(ws, 12 + g); const bf16* Vg = l1_tensor(ws, 14 + g);
        bf16x8 qf0[4], qf1[4];
        { const bf16* q0 = l1_tensor(ws, head) + (size_t)(t0 + ql0) * 128 + 8 * gl; const bf16* q1 = l1_tensor(ws, head) + (size_t)(t0 + ql1) * 128 + 8 * gl;
#pragma unroll
          for (int ks = 0; ks < 4; ++ks) { qf0[ks] = *(const bf16x8*)(q0 + 32 * ks); qf1[ks] = *(const bf16x8*)(q1 + 32 * ks); } }
        const LAS float* brow = (const LAS float*)(lds + AT_BT_OFF) + head * 128;
        f32x4v o0[8], o1[8];
#pragma unroll
        for (int dt = 0; dt < 8; ++dt) { o0[dt] = (f32x4v){0.f, 0.f, 0.f, 0.f}; o1[dt] = (f32x4v){0.f, 0.f, 0.f, 0.f}; }
        float m0 = -INFINITY, l0 = 0.f, m1 = -INFINITY, l1 = 0.f;
        u4 kra[2], vra[2];
        at_load<128>(Kg, Vg, 128, 0, T - 1, kra, vra, tid);
        __syncthreads();
        selm[tid] = selmask[((size_t)(t0 + (tid >> 3)) * 2 + g) * 8 + (tid & 7)];
        const float bfar_u = brow[127];
#define SEL16_STEP(KR, VR, BUF, J) do { const int j_ = (J); LAS unsigned char* Kl = lds + (BUF) * 2 * TILE; LAS unsigned char* Vl = Kl + TILE; \
            at_store<128>(Kl, Vl, KR, VR, tid); __syncthreads(); \
            if (j_ + 1 <= c) at_load<128>(Kg, Vg, 128, 64 * (j_ + 1), T - 1, KR, VR, tid); \
            const bool rs0 = (selm[ql0 * 8 + (j_ >> 5)] >> (j_ & 31)) & 1u, rs1 = (selm[ql1 * 8 + (j_ >> 5)] >> (j_ & 31)) & 1u; \
            const bool fast_ = t0 + 8 * wave - (64 * j_ + 63) >= 113; \
            if (__any(rs0)) at16_step(Kl, Vl, qf0, o0, m0, l0, fast_, 64 * j_, T, t0 + ql0, rs0, brow, bfar_u, SCALE_C * LOG2E, lane); \
            if (__any(rs1)) at16_step(Kl, Vl, qf1, o1, m1, l1, fast_, 64 * j_, T, t0 + ql1, rs1, brow, bfar_u, SCALE_C * LOG2E, lane); } while (0)
        for (int j = 0; j <= c; j += 2) {
            SEL16_STEP(kra, vra, 0, j);
            if (j + 1 <= c) SEL16_STEP(kra, vra, 1, j + 1);
        }
#undef SEL16_STEP
#pragma unroll
        for (int sb = 0; sb < 2; ++sb) {
            const int t_row = t0 + (sb ? ql1 : ql0); float lr = sb ? l1 : l0;
            lr += __shfl_xor(lr, 16); lr += __shfl_xor(lr, 32);
            const float f = l1_gate(ws, t_row, head, 1) / fmaxf(lr, 1e-30f);
            const size_t ob = (size_t)t_row * 1024 + head * 128 + 4 * gl;
#pragma unroll
            for (int dt = 0; dt < 8; ++dt) { const f32x4v ov = sb ? o1[dt] : o0[dt]; const float4 b = *(const float4*)(ocw + ob + 16 * dt);
                uint2 w; w.x = pk2(b.x + ov[0] * f, b.y + ov[1] * f); w.y = pk2(b.z + ov[2] * f, b.w + ov[3] * f);
                *(uint2*)(attnout + ob + 16 * dt) = w; }
        }
    }
}

constexpr int NPH = 21;
__global__ void __launch_bounds__(NTHR, 2) fwd(Params P) {
    extern __shared__ __attribute__((aligned(16))) unsigned char lds_raw[];
    LAS unsigned char* lds = (LAS unsigned char*)lds_raw;
    volatile LAS unsigned* MISC = (volatile LAS unsigned*)(lds + MISC_OFF);
    const int tid = threadIdx.x, lane = tid & 63, wave = __builtin_amdgcn_readfirstlane(tid >> 6), wg = blockIdx.x, G = gridDim.x;
    unsigned char* ws = P.ws;
    for (int u = tid; u < (LDS_BYTES - SCR_BYTES) / 4; u += NTHR) ((LAS unsigned*)(lds + SCR_BYTES))[u] = 0u;
    __syncthreads();
    const int lo = P.ph_lo, hi = P.ph_hi;
    XcdBarrier bar; bar.bar = (unsigned*)(ws + WS_CTL) + CW_BAR; bar.x = 0; bar.st = nullptr;
    if (hi - lo > 1) bar = xcd_barrier_post((unsigned*)(ws + WS_CTL) + CW_BAR, MISC + 8);
#ifndef PH_MASK
#define PH_MASK 0xFFFFFFFFu
#endif
#define IN(k) (lo <= (k) && (k) < hi && ((PH_MASK >> (k)) & 1u))
#ifndef REP_MASK
#define REP_MASK 0u
#endif
#define RPT(k) for (int rep_ = 0; rep_ < ((((REP_MASK) >> (k)) & 1u) ? 2 : 1); ++rep_)
#define RPTBAR do { if (rep_) xcd_barrier(bar); } while (0)
#define SEAM(k) do { if (IN(k) && IN((k) + 1)) xcd_barrier(bar); } while (0)
    const int gw = wg * NWAVES + wave, NGW = G * NWAVES;
    bf16* xn = (bf16*)(ws + WS_XN); bf16* proj = (bf16*)(ws + WS_PROJ); bf16* mb = (bf16*)(ws + WS_MB); bf16* ub = (bf16*)(ws + WS_U);

    if (IN(0)) { p0_prologue(P, lds, tid, lane, wave, wg, G); } SEAM(0);
    if (IN(1)) { run_gemm<0>(lds, xn, (const bf16*)(ws + WS_W0IN), T, N0IN, D, proj, 512, (size_t)T * 512, G, wg); } SEAM(1);
    if (IN(2)) { l0_stage_a(P, lds, tid, lane, wave, wg, G); } SEAM(2);
    if (IN(3)) { RPT(3) { RPTBAR; l0_stage_c(P, lds, tid, lane, wave, wg, G); l0_route(P, lds, tid, lane, wave, wg, G); } } SEAM(3);
    if (IN(4)) { l0_moba_gather(P, lds, tid, lane, wave, wg, G); } SEAM(4);
    if (IN(5)) { RPT(5) { RPTBAR; l0_moba_merge(P, tid, wg, G); } } SEAM(5);
    if (IN(6)) { run_gemm<0>(lds, xn, (const bf16*)(ws + WS_W0OUT), T, D, D, mb, 1024, 0, G, wg); } SEAM(6);
    if (IN(7)) { post_norm<0, 1>(P.in[I_X], P.out, mb, P.in[I_NMIXPOST], P.in[I_NMLPPRE], xn, lane, gw, NGW); } SEAM(7);
    if (IN(8)) { run_gemm<1>(lds, xn, (const bf16*)(ws + WS_W0UP), T, FF, D, ub, 4096, 0, G, wg); } SEAM(8);
    if (IN(9)) { run_gemm<0>(lds, ub, (const bf16*)(ws + WS_W0DN), T, D, FF, mb, 1024, 0, G, wg); } SEAM(9);
    if (IN(10)) { post_norm<1, 1>(P.out, P.out, mb, P.in[I_NMLPPOST], P.in[I_NMIXPRE] + D, xn, lane, gw, NGW); } SEAM(10);
    if (IN(11)) { run_gemm<0>(lds, xn, (const bf16*)(ws + WS_W1IN), T, N1IN, D, proj, 128, (size_t)T * 128, G, wg); } SEAM(11);
    if (IN(12)) { RPT(12) { RPTBAR; l1_compress_gemm(P, lds, tid, wg); __syncthreads(); l1_window_mfma(P, lds, tid, lane, wave, wg, G); } } SEAM(12);
    if (IN(13)) { l1_compress_out(P, lds, tid, wg, G); } SEAM(13);
    if (IN(14)) { l1_cmp_mfma(P, lds, tid, lane, wave, wg, G); } SEAM(14);
    if (IN(15)) { RPT(15) { RPTBAR; l1_sel16(P, lds, tid, lane, wave, wg, G); } } SEAM(15);
    if (IN(16)) { run_gemm<0>(lds, xn, (const bf16*)(ws + WS_W1OUT), T, D, D, mb, 1024, 0, G, wg); } SEAM(16);
    if (IN(17)) { post_norm<1, 1>(P.out, ws + WS_X3, mb, P.in[I_NMIXPOST] + D, P.in[I_NMLPPRE] + D, xn, lane, gw, NGW); } SEAM(17);
    if (IN(18)) { run_gemm<1>(lds, xn, (const bf16*)(ws + WS_W1UP), T, FF, D, ub, 4096, 0, G, wg); } SEAM(18);
    if (IN(19)) { run_gemm<0>(lds, ub, (const bf16*)(ws + WS_W1DN), T, D, FF, mb, 1024, 0, G, wg); } SEAM(19);
    if (IN(20)) { post_norm<1, 0>(ws + WS_X3, P.out, mb, P.in[I_NMLPPOST] + D, nullptr, xn, lane, gw, NGW); }
#undef IN
#undef SEAM
}

extern "C" void kernel_launch(void* const* d_in, const int* in_sizes, int n_in, void* d_out, int out_size, void* d_ws, size_t ws_size, hipStream_t stream) {
    static int grid = 0;
    if (grid == 0) {
        if (n_in != N_IN || in_sizes[0] != T * D || out_size != T * D || ws_size < WS_END) { fprintf(stderr, "kernel_launch: unexpected shapes (n_in %d, in0 %d, out %d, ws %zu); nothing launched\n", n_in, n_in > 0 ? in_sizes[0] : -1, out_size, ws_size); grid = -1; return; }
        int dev = 0, cus = 0, per_cu = 0;
        if (hipGetDevice(&dev) != hipSuccess || hipDeviceGetAttribute(&cus, hipDeviceAttributeMultiprocessorCount, dev) != hipSuccess) { grid = -1; return; }
        if (hipFuncSetAttribute((const void*)fwd, hipFuncAttributeMaxDynamicSharedMemorySize, LDS_BYTES) != hipSuccess) { fprintf(stderr, "kernel_launch: hipFuncSetAttribute failed\n"); grid = -1; return; }
        if (hipOccupancyMaxActiveBlocksPerMultiprocessor(&per_cu, (const void*)fwd, NTHR, LDS_BYTES) != hipSuccess || per_cu < 1) fprintf(stderr, "kernel_launch: occupancy query reports %d workgroups per CU\n", per_cu);
        (void)hipGetLastError();
        grid = cus;
        if (grid < 96) { fprintf(stderr, "kernel_launch: needs >= 96 CUs\n"); grid = -1; return; }
    }
    if (grid < 0) return;
    if (hipMemsetAsync((char*)d_ws + WS_CTL, 0, CTL_ZERO_BYTES, stream) != hipSuccess) return;
    Params p{};
    for (int i = 0; i < N_IN; ++i) p.in[i] = (const float*)d_in[i];
    p.out = (float*)d_out; p.ws = (unsigned char*)d_ws;
#if MK_ONE_LAUNCH
    p.ph_lo = 0; p.ph_hi = NPH;
    hipLaunchKernelGGL(fwd, dim3(grid), dim3(NTHR), LDS_BYTES, stream, p);
#else
    for (int k = 0; k < NPH; ++k) { p.ph_lo = k; p.ph_hi = k + 1; hipLaunchKernelGGL(fwd, dim3(grid), dim3(NTHR), LDS_BYTES, stream, p); }
#endif
}
```

```cpp
#include <hip/hip_runtime.h>
#include <cstdio>
#include <cstdint>
#ifndef MK_ONE_LAUNCH
#define MK_ONE_LAUNCH 1
#endif
#define GAS __attribute__((address_space(1)))
#define LAS __attribute__((address_space(3)))
namespace pg8 {
#define PG8_LAS __attribute__((address_space(3)))
typedef unsigned short bf16_t;
typedef short bf16x8 __attribute__((ext_vector_type(8)));
typedef float f32x4 __attribute__((ext_vector_type(4)));
typedef unsigned u32x4 __attribute__((ext_vector_type(4)));
constexpr int BM = 256, BK = 64, HALF = 128, HTB = HALF * BK * 2  , STAGE_BYTES = 8 * HTB, NXCD = 8, WGM = 8;

__host__ __device__ __forceinline__ int lds_byte(int r, int c) { const int st = (r >> 4) * 2 + (c >> 5), rr = r & 15, cc = c & 31, ob = rr * 64 + cc * 2; return st * 1024 + (ob ^ (((ob >> 9) & 1) << 5)); }
__host__ __device__ __forceinline__ void stage_rc(int b, int& R, int& C) { const int st = b / 1024, sb = b % 1024, swz = sb ^ (((sb >> 9) & 1) << 5); R = (st >> 1) * 16 + swz / 64; C = (st & 1) * 32 + (swz % 64) / 2; }
__host__ __device__ __forceinline__ int perm32(int rho) { const int n = rho >> 4, i = rho & 15; return 8 * (i >> 2) + 4 * n + (i & 3); }

struct Unit { int pm, pn; };
struct Gemm { const bf16_t* A; const bf16_t* Bt; int M, N, K, lda, ldb; };

struct StaticOrder {
    int nM, nN, nwg, G, c;
    __host__ __device__ void init(int M, int N, int G_, int c_) { nM = M / BM; nN = N / BM; nwg = nM * nN; G = G_; c = c_; }
    __host__ __device__ bool next(int i, Unit& u) const {
        const long L = (long)i * G + c; if (L >= nwg) return false;
        int wgid = (int)L; { const int q = nwg / NXCD, r = nwg % NXCD, xcd = wgid % NXCD, off = wgid / NXCD; wgid = (xcd < r ? xcd * (q + 1) : r * (q + 1) + (xcd - r) * q) + off; }
        const int nig = WGM * nN, gid = wgid / nig, fm = gid * WGM, gsz = (nM - fm) < WGM ? (nM - fm) : WGM;
        u.pm = fm + ((wgid % nig) % gsz); u.pn = (wgid % nig) / gsz; return true;
    }
    __device__ __forceinline__ void a_ready(const Unit&) const {}
    __device__ __forceinline__ void done(const Unit&) const {}
};

__device__ __forceinline__ unsigned cvt_pk_bf16(float lo, float hi) { unsigned r; asm volatile("v_cvt_pk_bf16_f32 %0, %1, %2" : "=v"(r) : "v"(lo), "v"(hi)); return r; }
template <class Epi, class Sched, bool ALIGN_EPI = false, bool SP2 = false>
__device__ __forceinline__ void gemm_phase(PG8_LAS unsigned char* lds, const Gemm g, const Sched& S, const Epi& E) {
    const int tid = threadIdx.x, wid = __builtin_amdgcn_readfirstlane(tid >> 6), lane = tid & 63, wr = wid >> 2, wc = wid & 3, fr = lane & 15, fq = lane >> 4;
    const int K = g.K, nt = K / BK;
    unsigned voffA[2], voffB[2];
#pragma unroll
    for (int i = 0; i < 2; ++i) { int R, C; stage_rc(tid * 16 + i * 8192, R, C); const int Rb = Epi::PERM ? ((R & ~31) + perm32(R & 31)) : R;
        voffA[i] = (unsigned)(R * g.lda + C) * 2u; voffB[i] = (unsigned)(Rb * g.ldb + C) * 2u; }
    const size_t kstep = (size_t)(BK * 2);
    const size_t hstepA = (size_t)HALF * g.lda * 2, hstepB = (size_t)HALF * g.ldb * 2;
    const size_t tstepA = 2 * hstepA, tstepB = 2 * hstepB;
    const unsigned ldsw = (unsigned)wid * 1024u;
    const int aoff = lds_byte(wr * 64 + fr, fq * 8), boff = lds_byte(wc * 32 + fr, fq * 8);
#define PG8_SA(b, h) (((b) * 2 + (h)) * HTB)
#define PG8_SB(b, h) ((4 + (b) * 2 + (h)) * HTB)
#define PG8_STAGE(bufoff, gbase, voff) do { _Pragma("unroll") for (int _i = 0; _i < 2; ++_i) \
        __builtin_amdgcn_global_load_lds((const unsigned*)((const char*)(gbase) + (voff)[_i]), (PG8_LAS unsigned*)(lds + (bufoff) + ldsw + _i * 8192), 16, 0, 0); } while (0)
#define PG8_LDA(dst, b, h) do { _Pragma("unroll") for (int m = 0; m < 4; ++m) _Pragma("unroll") for (int k = 0; k < 2; ++k) dst[m][k] = *(const PG8_LAS bf16x8*)(lds + PG8_SA(b, h) + aoff + m * 2048 + k * 1024); } while (0)
#define PG8_LDB(dst, b, h) do { _Pragma("unroll") for (int n = 0; n < 2; ++n) _Pragma("unroll") for (int k = 0; k < 2; ++k) dst[n][k] = *(const PG8_LAS bf16x8*)(lds + PG8_SB(b, h) + boff + n * 2048 + k * 1024); } while (0)
#define PG8_MMA(ai, bj, At, Bt) do { __builtin_amdgcn_s_setprio(1); _Pragma("unroll") for (int m = 0; m < 4; ++m) _Pragma("unroll") for (int n = 0; n < 2; ++n) _Pragma("unroll") for (int k = 0; k < 2; ++k) \
        acc[ai][bj][m][n] = __builtin_amdgcn_mfma_f32_16x16x32_bf16(Bt[n][k], At[m][k], acc[ai][bj][m][n], 0, 0, 0); __builtin_amdgcn_s_setprio(0); } while (0)
#define PG8_WAIT_V(n) asm volatile("s_waitcnt vmcnt(" #n ")" ::: "memory")
#define PG8_WAIT_L(n) asm volatile("s_waitcnt lgkmcnt(" #n ")" ::: "memory")
#define PG8_BAR __builtin_amdgcn_s_barrier()
#define PG8_SCHED __builtin_amdgcn_sched_barrier(0)
    Unit cur, nxt; int ui = 0;
    if (!S.next(0, cur)) return;
    f32x4 acc[2][2][4][2];
#pragma unroll
    for (int a = 0; a < 2; ++a)
#pragma unroll
        for (int b = 0; b < 2; ++b)
#pragma unroll
            for (int m = 0; m < 4; ++m)
#pragma unroll
                for (int n = 0; n < 2; ++n) acc[a][b][m][n] = (f32x4){0.f, 0.f, 0.f, 0.f};
    bf16x8 At[4][2], B0[2][2], B1[2][2];
    const char* cA = (const char*)g.A + (size_t)cur.pm * tstepA; const char* cB = (const char*)g.Bt + (size_t)cur.pn * tstepB;
    S.a_ready(cur);
    if constexpr (SP2) {
        PG8_STAGE(PG8_SB(0, 0), cB, voffB); PG8_STAGE(PG8_SB(0, 1), cB + hstepB, voffB); PG8_STAGE(PG8_SA(0, 0), cA, voffA); PG8_STAGE(PG8_SA(0, 1), cA + hstepA, voffA);
        if (wr == 1) PG8_BAR;
        PG8_WAIT_V(2); PG8_BAR;
        PG8_STAGE(PG8_SB(1, 0), cB + kstep, voffB); PG8_STAGE(PG8_SA(1, 0), cA + kstep, voffA); PG8_STAGE(PG8_SB(1, 1), cB + hstepB + kstep, voffB);
        PG8_WAIT_V(6); PG8_BAR;
    } else {
        PG8_STAGE(PG8_SB(0, 0), cB, voffB); PG8_STAGE(PG8_SA(0, 0), cA, voffA); PG8_STAGE(PG8_SB(0, 1), cB + hstepB, voffB); PG8_STAGE(PG8_SA(0, 1), cA + hstepA, voffA);
        if (wr == 1) PG8_BAR;
        PG8_WAIT_V(4); PG8_BAR;
        PG8_STAGE(PG8_SB(1, 0), cB + kstep, voffB); PG8_STAGE(PG8_SA(1, 0), cA + kstep, voffA); PG8_STAGE(PG8_SB(1, 1), cB + hstepB + kstep, voffB);
        PG8_WAIT_V(6); PG8_BAR;
    }
    for (;;) {
        const bool has_next = S.next(ui + 1, nxt);
        const char* nA = has_next ? (const char*)g.A + (size_t)nxt.pm * tstepA : cA; const char* nB = has_next ? (const char*)g.Bt + (size_t)nxt.pn * tstepB : cB;
        for (int t = 0; t < nt; t += 2) {
            const bool last = (t == nt - 2);
            const char* a1 = cA + (size_t)(t + 1) * kstep;
            const char* a2 = last ? nA : cA + (size_t)(t + 2) * kstep; const char* b2 = last ? nB : cB + (size_t)(t + 2) * kstep;
            const char* a3 = a2 + kstep; const char* b3 = b2 + kstep;
            if (last && has_next) S.a_ready(nxt);
            if constexpr (SP2) {
            PG8_LDB(B0, 0, 0); PG8_LDB(B1, 0, 1); PG8_SCHED; PG8_LDA(At, 0, 0); PG8_STAGE(PG8_SA(1, 1), a1 + hstepA, voffA);
            PG8_WAIT_V(8); PG8_WAIT_L(0); PG8_BAR; PG8_MMA(0, 0, At, B0); PG8_MMA(0, 1, At, B1); PG8_BAR; PG8_SCHED;
            PG8_LDA(At, 0, 1); PG8_STAGE(PG8_SB(0, 0), b2, voffB); PG8_STAGE(PG8_SB(0, 1), b2 + hstepB, voffB); PG8_STAGE(PG8_SA(0, 0), a2, voffA);
            PG8_WAIT_V(8); PG8_WAIT_L(0); PG8_BAR; PG8_MMA(1, 0, At, B0); PG8_MMA(1, 1, At, B1); PG8_BAR; PG8_SCHED;
            PG8_LDB(B0, 1, 0); PG8_LDB(B1, 1, 1); PG8_SCHED; PG8_LDA(At, 1, 0); PG8_STAGE(PG8_SA(0, 1), a2 + hstepA, voffA);
            PG8_WAIT_V(8); PG8_WAIT_L(0); PG8_BAR; PG8_MMA(0, 0, At, B0); PG8_MMA(0, 1, At, B1); PG8_BAR; PG8_SCHED;
            PG8_LDA(At, 1, 1); PG8_STAGE(PG8_SB(1, 0), b3, voffB); PG8_STAGE(PG8_SB(1, 1), b3 + hstepB, voffB); PG8_STAGE(PG8_SA(1, 0), a3, voffA);
            PG8_WAIT_V(8); PG8_WAIT_L(0); PG8_BAR; PG8_MMA(1, 0, At, B0); PG8_MMA(1, 1, At, B1); PG8_BAR; PG8_SCHED;
            } else {
            PG8_LDB(B0, 0, 0); PG8_SCHED; PG8_LDA(At, 0, 0); PG8_STAGE(PG8_SA(1, 1), a1 + hstepA, voffA);
            PG8_WAIT_L(8); PG8_BAR; PG8_WAIT_L(0); PG8_MMA(0, 0, At, B0); PG8_BAR; PG8_SCHED;
            PG8_LDB(B1, 0, 1); PG8_STAGE(PG8_SB(0, 0), b2, voffB);
            PG8_BAR; PG8_WAIT_L(0); PG8_MMA(0, 1, At, B1); PG8_BAR;
            PG8_LDA(At, 0, 1); PG8_STAGE(PG8_SA(0, 0), a2, voffA);
            PG8_BAR; PG8_WAIT_L(0); PG8_MMA(1, 0, At, B0); PG8_BAR; PG8_SCHED;
            PG8_STAGE(PG8_SB(0, 1), b2 + hstepB, voffB);
            PG8_WAIT_V(6); PG8_BAR; PG8_MMA(1, 1, At, B1); PG8_BAR;
            PG8_LDB(B0, 1, 0); PG8_SCHED; PG8_LDA(At, 1, 0); PG8_STAGE(PG8_SA(0, 1), a2 + hstepA, voffA);
            PG8_WAIT_L(8); PG8_BAR; PG8_WAIT_L(0); PG8_MMA(0, 0, At, B0); PG8_BAR; PG8_SCHED;
            PG8_LDB(B1, 1, 1); PG8_STAGE(PG8_SB(1, 0), b3, voffB);
            PG8_BAR; PG8_WAIT_L(0); PG8_MMA(0, 1, At, B1); PG8_BAR;
            PG8_LDA(At, 1, 1); PG8_STAGE(PG8_SA(1, 0), a3, voffA);
            PG8_BAR; PG8_WAIT_L(0); PG8_MMA(1, 0, At, B0); PG8_BAR; PG8_SCHED;
            PG8_STAGE(PG8_SB(1, 1), b3 + hstepB, voffB);
            PG8_WAIT_V(6); PG8_BAR; PG8_MMA(1, 1, At, B1); PG8_BAR;
            }
        }
        if constexpr (ALIGN_EPI) { if (wr == 0) PG8_BAR; }
        if constexpr (!Epi::AFTER_DRAIN) { E(acc, cur, wr, wc, fr, fq); S.done(cur); }
        if (!has_next) break;
#pragma unroll
        for (int a = 0; a < 2; ++a)
#pragma unroll
            for (int b = 0; b < 2; ++b)
#pragma unroll
                for (int m = 0; m < 4; ++m)
#pragma unroll
                    for (int n = 0; n < 2; ++n) acc[a][b][m][n] = (f32x4){0.f, 0.f, 0.f, 0.f};
        cur = nxt; cA = nA; cB = nB; ++ui;
        if constexpr (ALIGN_EPI) { if (wr == 1) PG8_BAR; }
    }
    PG8_WAIT_V(0);
    if constexpr (!ALIGN_EPI) { if (wr == 0) PG8_BAR; }
    PG8_BAR;
    if constexpr (Epi::AFTER_DRAIN) { E.fused(acc, cur, wr, wc, fr, fq, lds, wid, lane); S.done(cur); }
#undef PG8_SA
#undef PG8_SB
#undef PG8_STAGE
#undef PG8_LDA
#undef PG8_LDB
#undef PG8_MMA
#undef PG8_WAIT_V
#undef PG8_WAIT_L
#undef PG8_BAR
#undef PG8_SCHED
}
}
#define XB_TMO      128
#define XB_XCNT(j)  (256  + 64 * (j))
#define XB_XSUB(j)  (1280 + 64 * (j))
#define XB_XGEN(j)  (2304 + 64 * (j))
#define XB_TOP      3328
#define XB_TOPGEN   3392
#define XCD_BAR_WORDS 3456
#define XB_SPIN_CAP (1u << 22)

__device__ __forceinline__ unsigned xb_ld(unsigned* p)              { return __hip_atomic_load(p, __ATOMIC_RELAXED, __HIP_MEMORY_SCOPE_AGENT); }
__device__ __forceinline__ unsigned xb_add(unsigned* p, unsigned v) { return __hip_atomic_fetch_add(p, v, __ATOMIC_RELAXED, __HIP_MEMORY_SCOPE_AGENT); }
__device__ __forceinline__ unsigned xb_xcc_id() { return (unsigned)__builtin_amdgcn_s_getreg((3 << 11) | 20) & 0xFu; }
#define XB_SPIN(cond, bar) do { unsigned _sp = 0; while (cond) { __builtin_amdgcn_s_sleep(1); \
    if ((++_sp & 255u) == 0u) { if (xb_ld(&(bar)[XB_TMO])) break; if (_sp > XB_SPIN_CAP) { atomicAdd(&(bar)[XB_TMO], 1u); break; } } } } while (0)

struct XcdBarrier {
    unsigned* bar; unsigned x;
    volatile LAS unsigned* st;
};

__device__ __forceinline__ XcdBarrier xcd_barrier_post(unsigned* bar, volatile LAS unsigned* st) {
    XcdBarrier b; b.bar = bar; b.x = xb_xcc_id(); b.st = st;
    if (threadIdx.x == 0) (void)xb_add(&bar[XB_XCNT(b.x)], 1u);
    return b;
}
__device__ __forceinline__ void xcd_barrier_complete(unsigned* bar, unsigned x, unsigned& nloc, unsigned& nx) {
    const unsigned G = gridDim.x * gridDim.y * gridDim.z;
    unsigned sum, cnt, mine, sp = 0u;
    for (;;) {
        sum = 0u; cnt = 0u; mine = 0u;
#pragma unroll
        for (unsigned j = 0; j < 16; ++j) { const unsigned c = xb_ld(&bar[XB_XCNT(j)]); sum += c; cnt += (c > 0u) ? 1u : 0u; mine = (j == x) ? c : mine; }
        if (sum == G) break;
        __builtin_amdgcn_s_sleep(1);
        if ((++sp & 255u) == 0u) { if (xb_ld(&bar[XB_TMO])) break; if (sp > XB_SPIN_CAP) { atomicAdd(&bar[XB_TMO], 1u); break; } }
    }
    nloc = mine > 0u ? mine : 1u; nx = cnt > 0u ? cnt : 1u;
}

template <bool FLUSH = true> __device__ __forceinline__ void xcd_barrier(const XcdBarrier& b) {
    asm volatile("s_waitcnt vmcnt(0)" ::: "memory");
    __syncthreads();
    if (threadIdx.x == 0) {
        unsigned* bar = b.bar;
        __builtin_amdgcn_s_waitcnt(0);
        unsigned nloc = b.st[0], nx = b.st[1];
        if (nloc == 0u) { xcd_barrier_complete(bar, b.x, nloc, nx); b.st[0] = nloc; b.st[1] = nx; }
        const unsigned bidx = b.st[2]; b.st[2] = bidx + 1u;
        const unsigned old = xb_add(&bar[XB_XSUB(b.x)], 1u);
        const unsigned gen = old / nloc;
        if (old + 1u == (gen + 1u) * nloc) {
            if (FLUSH) __builtin_amdgcn_fence(__ATOMIC_RELEASE, "agent");
            asm volatile("s_waitcnt vmcnt(0)" ::: "memory");
            const unsigned og = xb_add(&bar[XB_TOP], 1u);
            const unsigned tg = og / nx;
            if (og + 1u == (tg + 1u) * nx) xb_add(&bar[XB_TOPGEN], 1u);
            else XB_SPIN(xb_ld(&bar[XB_TOPGEN]) == tg, bar);
            __builtin_amdgcn_fence(__ATOMIC_ACQUIRE, "agent");
            asm volatile("s_waitcnt vmcnt(0)" ::: "memory");
        } else {
            (void)gen; XB_SPIN(xb_ld(&bar[XB_TOPGEN]) == bidx, bar);
            __builtin_amdgcn_fence(__ATOMIC_ACQUIRE, "agent");
            asm volatile("s_waitcnt vmcnt(0)" ::: "memory");
        }
    }
    __syncthreads();
}

constexpr int T = 16384, D = 1024, FF = 4096;
constexpr int NWAVES = 8, NTHR = 512;
constexpr float EPS = 1e-6f;
constexpr int N0IN = 2560, N1IN = 2816, C_IN = 2584;
enum { I_X = 0, I_RELB, I_ABWIN, I_CONVW, I_CONVB, I_WRG, I_BRG, I_WIG, I_BIG, I_LAM, I_ABWOUT, I_CWIN, I_POSK, I_POSV, I_K1, I_K2, I_V1, I_V2, I_CWOUT,
       I_NMIXPRE, I_NMIXPOST, I_NMLPPRE, I_NMLPPOST, I_WUP, I_WDN, N_IN };

constexpr size_t MiB = 1u << 20;
constexpr size_t WS_CTL = 0, CTL_ZERO_BYTES = 384 * 1024;
constexpr size_t WS_BT = 1 * MiB;
constexpr size_t WS_KMEAN = 256 * 1024;
constexpr size_t WS_CARRY = 2 * MiB;
constexpr size_t WS_SELMASK = 3 * MiB;
constexpr size_t WS_SELQ = 4 * MiB;
constexpr size_t WS_SELT = 5 * MiB;
constexpr size_t WS_PO = 172 * MiB;
constexpr size_t WS_PML = 236 * MiB;
constexpr int CW_QUEUE = 8192;
constexpr size_t WS_W0IN = 8 * MiB, WS_W0OUT = 13 * MiB, WS_W0UP = 15 * MiB, WS_W0DN = 23 * MiB;
constexpr size_t WS_W1IN = 31 * MiB, WS_W1OUT = 37 * MiB, WS_W1UP = 39 * MiB, WS_W1DN = 47 * MiB;
constexpr size_t WS_CW1K = 55 * MiB, WS_CW1V = 57 * MiB;
constexpr size_t WS_CPART = 60 * MiB;
constexpr size_t WS_POSP = 76 * MiB;
constexpr size_t WS_XN = 60 * MiB;
constexpr size_t WS_PROJ = 92 * MiB;
constexpr size_t WS_HLOC = 172 * MiB;
constexpr size_t WS_OCW = 180 * MiB;
constexpr size_t WS_HID = 244 * MiB;
constexpr size_t WS_KCMP = 250 * MiB;
constexpr size_t WS_MB = 92 * MiB;
constexpr size_t WS_U = 124 * MiB;
constexpr size_t WS_X3 = 1 * MiB;
constexpr size_t WS_RROW = 512 * 1024;
constexpr size_t WS_END = 256 * MiB;
constexpr int CW_BAR = 4096;

constexpr int SCR_BYTES = 147456;
constexpr int MISC_OFF = SCR_BYTES + 320;
constexpr int LDS_BYTES = 151552;

typedef unsigned short bf16;
typedef float f4 __attribute__((ext_vector_type(4)));
#define LDS_WAIT() asm volatile("s_waitcnt lgkmcnt(0)" ::: "memory")
#define VM_WAIT() asm volatile("s_waitcnt vmcnt(0)" ::: "memory")
__device__ __forceinline__ unsigned f2bf(float f) { unsigned u = __builtin_bit_cast(unsigned, f); return (u + 0x7fffu + ((u >> 16) & 1u)) >> 16; }
__device__ __forceinline__ unsigned pk2(float lo, float hi) { return f2bf(lo) | (f2bf(hi) << 16); }
__device__ __forceinline__ float bf2f(bf16 b) { return __builtin_bit_cast(float, ((unsigned)b) << 16); }
__device__ __forceinline__ float bflo(unsigned w) { return __builtin_bit_cast(float, w << 16); }
__device__ __forceinline__ float bfhi(unsigned w) { return __builtin_bit_cast(float, w & 0xffff0000u); }
__device__ __forceinline__ float wave_sum(float v) {
#pragma unroll
    for (int o = 1; o < 64; o <<= 1) v += __shfl_xor(v, o);
    return v;
}
__device__ __forceinline__ float wave_max(float v) {
#pragma unroll
    for (int o = 1; o < 64; o <<= 1) v = fmaxf(v, __shfl_xor(v, o));
    return v;
}
__device__ __forceinline__ void wave_argmax(float& v, int& i) {
#pragma unroll
    for (int o = 1; o < 64; o <<= 1) { const float ov = __shfl_xor(v, o); const int oi = __shfl_xor(i, o); if (ov > v || (ov == v && oi < i)) { v = ov; i = oi; } }
}
__device__ __forceinline__ float gelu_tanh(float x) { return 0.5f * x * (1.f + tanhf(0.7978845608028654f * (x + 0.044715f * x * x * x))); }
__device__ __forceinline__ float sigmoidf_(float x) { return 1.f / (1.f + __expf(-x)); }
__device__ __forceinline__ int t5_bucket(int d) {
    if (d < 16) return d;
    return 16 + (d >= 19) + (d >= 21) + (d >= 24) + (d >= 27) + (d >= 31) + (d >= 35) + (d >= 40) + (d >= 46) + (d >= 52) + (d >= 59) + (d >= 67) + (d >= 77) + (d >= 87) + (d >= 99) + (d >= 113);
}

#ifndef MOBA_MFMA
#define MOBA_MFMA 1
#endif
struct Params { const float* in[N_IN]; float* out; unsigned char* ws; int ph_lo, ph_hi; };

typedef unsigned v4u_t __attribute__((ext_vector_type(4)));
template <int ACT  > struct EpiT {
    static constexpr bool PERM = true, AFTER_DRAIN = false;
    bf16* O; int tcols; size_t tstride;
    const float* rowsc;
    float* kmsum;
    __device__ __forceinline__ void operator()(const pg8::f32x4 (&acc)[2][2][4][2], const pg8::Unit& u, int wr, int wc, int fr, int fq) const {
        const int row0 = u.pm * 256 + wr * 64 + fr;
        float r8[2][4];
#pragma unroll
        for (int ai = 0; ai < 2; ++ai)
#pragma unroll
            for (int m = 0; m < 4; ++m) r8[ai][m] = rowsc ? rowsc[row0 + ai * 128 + m * 16] : 1.f;
        const bool km = kmsum != nullptr && (u.pn == 2 || u.pn == 3);
        const __amdgpu_buffer_rsrc_t rs = __builtin_amdgcn_make_buffer_rsrc((void*)O, 0, 0x7FFFFFF0, 0x00020000);
#pragma unroll
        for (int bj = 0; bj < 2; ++bj) {
            const int c0 = u.pn * 256 + bj * 128; const int tt = c0 / tcols; const int cw = c0 - tt * tcols;
            const unsigned base = (unsigned)(((size_t)tt * tstride + cw + wc * 32 + 8 * fq) * 2);
            pg8::f32x4 cs0 = {0.f, 0.f, 0.f, 0.f}, cs1 = {0.f, 0.f, 0.f, 0.f};
#pragma unroll
            for (int ai = 0; ai < 2; ++ai)
#pragma unroll
                for (int m = 0; m < 4; ++m) {
                    pg8::f32x4 v0 = acc[ai][bj][m][0], v1 = acc[ai][bj][m][1];
                    if (rowsc) { v0 *= r8[ai][m]; v1 *= r8[ai][m]; }
                    if (km) { cs0 += v0; cs1 += v1; }
                    if (ACT == 1) {
#pragma unroll
                        for (int j = 0; j < 4; ++j) { const float a = fmaxf(v0[j], 0.f), b = fmaxf(v1[j], 0.f); v0[j] = a * a; v1[j] = b * b; } }
                    pg8::u32x4 w; w.x = pg8::cvt_pk_bf16(v0[0], v0[1]); w.y = pg8::cvt_pk_bf16(v0[2], v0[3]); w.z = pg8::cvt_pk_bf16(v1[0], v1[1]); w.w = pg8::cvt_pk_bf16(v1[2], v1[3]);
                    __builtin_amdgcn_raw_buffer_store_b128(__builtin_bit_cast(v4u_t, w), rs, base + (unsigned)((row0 + ai * 128 + m * 16) * tcols * 2), 0, 16);
                }
            if (km) {
#pragma unroll
                for (int j = 0; j < 4; ++j) {
#pragma unroll
                    for (int sh = 1; sh < 16; sh <<= 1) { cs0[j] += __shfl_xor(cs0[j], sh); cs1[j] += __shfl_xor(cs1[j], sh); } }
                if (fr == 0) { const int kc = (u.pn - 2) * 256 + bj * 128 + wc * 32 + 8 * fq; float* kp = kmsum + ((size_t)(kc >> 6) * 64 + u.pm) * 64 + (kc & 63);
#pragma unroll
                    for (int j = 0; j < 4; ++j) { atomicAdd(kp + j, cs0[j] * (1.f / 256.f)); atomicAdd(kp + 4 + j, cs1[j] * (1.f / 256.f)); } }
            }
        }
    }
};
template <int ACT> __device__ __forceinline__ void run_gemm(LAS unsigned char* lds, const bf16* A, const bf16* Bt, int M, int N, int K, bf16* O, int tcols, size_t tstride, int G, int wg, const float* rs = nullptr, float* kmsum = nullptr) {
    pg8::Gemm g{A, Bt, M, N, K, K, K}; pg8::StaticOrder S; S.init(M, N, G, wg); EpiT<ACT> E{O, tcols, tstride, rs, kmsum};
    pg8::gemm_phase<EpiT<ACT>, pg8::StaticOrder, true, true>((PG8_LAS unsigned char*)lds, g, S, E);
}

__device__ __forceinline__ void tr_load(const float* __restrict__ W, const float* __restrict__ gk  , int K, int N, int item, int nblk, float (&wv)[32], int lane) {
    const int kb = item / nblk, nb = item % nblk, k0 = 64 * kb, n0 = 32 * nb;
    const int nn = n0 + (lane & 31); const bool ok = nn < N;
#pragma unroll
    for (int i = 0; i < 32; ++i) { const int kk = 2 * i + (lane >> 5); wv[i] = ok ? W[(size_t)(k0 + kk) * N + nn] : 0.f; }
    if (gk) {
#pragma unroll
        for (int i = 0; i < 32; ++i) wv[i] *= gk[k0 + 2 * i + (lane >> 5)]; }
}
__device__ __forceinline__ void tr_finish(int K, bf16* __restrict__ WT, int item, int nblk, const float (&wv)[32], LAS float* scr, int lane) {
    const int kb = item / nblk, nb = item % nblk, k0 = 64 * kb, n0 = 32 * nb;
#pragma unroll
    for (int i = 0; i < 32; ++i) { const int kk = 2 * i + (lane >> 5); scr[kk * 33 + (lane & 31)] = wv[i]; }
    LDS_WAIT(); asm volatile("" ::: "memory");
    const int c = lane & 7;
#pragma unroll
    for (int j = 0; j < 4; ++j) { const int n = (lane >> 3) + 8 * j; const LAS float* s = scr + (8 * c) * 33 + n;
        uint4 o; o.x = pk2(s[0 * 33], s[1 * 33]); o.y = pk2(s[2 * 33], s[3 * 33]); o.z = pk2(s[4 * 33], s[5 * 33]); o.w = pk2(s[6 * 33], s[7 * 33]);
        *(uint4*)(WT + (size_t)(n0 + n) * K + k0 + 8 * c) = o; }
    LDS_WAIT(); asm volatile("" ::: "memory");
}
struct WSel { const float* src; const float* gk; bf16* dst; int K, N, nblk, r; };
__device__ __forceinline__ WSel w_select(const Params& P, unsigned char* ws, int it) {
    WSel w; int r = it;
#define TRY_W(src_, gk_, K_, N_, NP_, dst_) { constexpr int cnt = ((K_) / 64) * ((NP_) / 32); if (r < cnt) { w.src = (src_); w.gk = (gk_); w.dst = (bf16*)(ws + (dst_)); w.K = (K_); w.N = (N_); w.nblk = (NP_) / 32; w.r = r; return w; } r -= cnt; }
    TRY_W(P.in[I_ABWIN], P.in[I_NMIXPRE], 1024, 2560, 2560, WS_W0IN)
    TRY_W(P.in[I_ABWOUT], nullptr, 1024, 1024, 1024, WS_W0OUT)
    TRY_W(P.in[I_WUP], P.in[I_NMLPPRE], 1024, 4096, 4096, WS_W0UP)
    TRY_W(P.in[I_WDN], nullptr, 4096, 1024, 1024, WS_W0DN)
    TRY_W(P.in[I_CWIN], P.in[I_NMIXPRE] + D, 1024, C_IN, N1IN, WS_W1IN)
    TRY_W(P.in[I_CWOUT], nullptr, 1024, 1024, 1024, WS_W1OUT)
    TRY_W(P.in[I_WUP] + (size_t)1024 * 4096, P.in[I_NMLPPRE] + D, 1024, 4096, 4096, WS_W1UP)
    TRY_W(P.in[I_WDN] + (size_t)4096 * 1024, nullptr, 4096, 1024, 1024, WS_W1DN)
    TRY_W(P.in[I_K1], nullptr, 4096, 256, 256, WS_CW1K)
#undef TRY_W
    w.src = P.in[I_V1]; w.gk = nullptr; w.dst = (bf16*)(ws + WS_CW1V); w.K = 4096; w.N = 256; w.nblk = 8; w.r = r; return w;
}
__device__ __forceinline__ void rms_to_bf16(const float4 (&v)[4], const float* __restrict__ g, bf16* __restrict__ orow, int lane) {
    float ss = 0.f;
#pragma unroll
    for (int j = 0; j < 4; ++j) ss += (v[j].x * v[j].x + v[j].y * v[j].y) + (v[j].z * v[j].z + v[j].w * v[j].w);
    const float r = 1.f / sqrtf(wave_sum(ss) * (1.f / D) + EPS);
#pragma unroll
    for (int j = 0; j < 4; ++j) { const float4 gg = ((const float4*)g)[lane + 64 * j];
        uint2 o; o.x = pk2(v[j].x * r * gg.x, v[j].y * r * gg.y); o.y = pk2(v[j].z * r * gg.z, v[j].w * r * gg.w);
        ((uint2*)orow)[lane + 64 * j] = o; }
}
__device__ __forceinline__ void row_to_bf16_r(const float4 (&v)[4], bf16* __restrict__ orow, float* __restrict__ rptr, int lane) {
    float ss = 0.f;
#pragma unroll
    for (int j = 0; j < 4; ++j) ss += (v[j].x * v[j].x + v[j].y * v[j].y) + (v[j].z * v[j].z + v[j].w * v[j].w);
    const float r = 1.f / sqrtf(wave_sum(ss) * (1.f / D) + EPS);
    if (lane == 0) *rptr = r;
#pragma unroll
    for (int j = 0; j < 4; ++j) { uint2 o; o.x = pk2(v[j].x, v[j].y); o.y = pk2(v[j].z, v[j].w); ((uint2*)orow)[lane + 64 * j] = o; }
}
__device__ __forceinline__ void p0_prologue(const Params& P, LAS unsigned char* lds, int tid, int lane, int wave, int wg, int G) {
    unsigned char* ws = P.ws;
    LAS float* scr = (LAS float*)(lds + wave * 16384);
    const int gw = wg * NWAVES + wave, NGW = G * NWAVES;
    constexpr int NITEMS = 16 * 80 + 16 * 32 + 16 * 128 + 64 * 32 + 16 * 88 + 16 * 32 + 16 * 128 + 64 * 32 + 2 * 64 * 8;
    {
        float wa[32], wb[32];
        int it = gw;
        WSel cur = w_select(P, ws, it < NITEMS ? it : 0);
        if (it < NITEMS) tr_load(cur.src, cur.gk, cur.K, cur.N, cur.r, cur.nblk, wa, lane);
        while (it < NITEMS) {
            const int itn = it + NGW; WSel nx = w_select(P, ws, itn < NITEMS ? itn : 0);
            if (itn < NITEMS) tr_load(nx.src, nx.gk, nx.K, nx.N, nx.r, nx.nblk, wb, lane);
            tr_finish(cur.K, cur.dst, cur.r, cur.nblk, wa, scr, lane);
            if (itn >= NITEMS) break;
            const int it2 = itn + NGW; cur = w_select(P, ws, it2 < NITEMS ? it2 : 0);
            if (it2 < NITEMS) tr_load(cur.src, cur.gk, cur.K, cur.N, cur.r, cur.nblk, wa, lane);
            tr_finish(nx.K, nx.dst, nx.r, nx.nblk, wb, scr, lane);
            it = it2;
        }
    }
    if (wg == 0) { float* bt = (float*)(ws + WS_BT); for (int i = tid; i < 1024; i += NTHR) { const int h = i >> 7, d = i & 127; bt[i] = P.in[I_RELB][t5_bucket(d) * 8 + h]; } }
    for (int m = gw; m < T; m += 2 * NGW) {
        const float4* xr0 = (const float4*)(P.in[I_X] + (size_t)m * D); const float4* xr1 = (const float4*)(P.in[I_X] + (size_t)((m + NGW < T) ? (m + NGW) : m) * D); float4 v0[4], v1[4];
#pragma unroll
        for (int j = 0; j < 4; ++j) { v0[j] = xr0[lane + 64 * j]; v1[j] = xr1[lane + 64 * j]; }
        row_to_bf16_r(v0, (bf16*)(ws + WS_XN) + (size_t)m * D, (float*)(ws + WS_RROW) + m, lane);
        if (m + NGW < T) row_to_bf16_r(v1, (bf16*)(ws + WS_XN) + (size_t)(m + NGW) * D, (float*)(ws + WS_RROW) + m + NGW, lane);
    }
}

template <int XIN, int XOUT, bool YSC = false>
__device__ __forceinline__ void post_norm(const void* xin_, void* xout_, const bf16* __restrict__ y, const float* __restrict__ g1, float* rrow  ,
                                          int lane, int gw, int NGW, const float* ysc = nullptr) {
    for (int m0 = gw; m0 < T; m0 += 2 * NGW) {
        const int m1 = (m0 + NGW < T) ? (m0 + NGW) : m0; const bool two = (m0 + NGW < T);
        const uint2* yr0 = (const uint2*)(y + (size_t)m0 * D); const uint2* yr1 = (const uint2*)(y + (size_t)m1 * D);
        uint2 yw0[4], yw1[4]; float4 xv0[4], xv1[4];
        if (XIN == 0) {
            const float4* xr0 = (const float4*)((const float*)xin_ + (size_t)m0 * D); const float4* xr1 = (const float4*)((const float*)xin_ + (size_t)m1 * D);
#pragma unroll
            for (int j = 0; j < 4; ++j) { yw0[j] = yr0[lane + 64 * j]; yw1[j] = yr1[lane + 64 * j]; xv0[j] = xr0[lane + 64 * j]; xv1[j] = xr1[lane + 64 * j]; }
        } else {
            const uint2* xr0 = (const uint2*)((const bf16*)xin_ + (size_t)m0 * D); const uint2* xr1 = (const uint2*)((const bf16*)xin_ + (size_t)m1 * D);
            uint2 xw0[4], xw1[4];
#pragma unroll
            for (int j = 0; j < 4; ++j) { yw0[j] = yr0[lane + 64 * j]; yw1[j] = yr1[lane + 64 * j]; xw0[j] = xr0[lane + 64 * j]; xw1[j] = xr1[lane + 64 * j]; }
#pragma unroll
            for (int j = 0; j < 4; ++j) { xv0[j] = make_float4(bflo(xw0[j].x), bfhi(xw0[j].x), bflo(xw0[j].y), bfhi(xw0[j].y)); xv1[j] = make_float4(bflo(xw1[j].x), bfhi(xw1[j].x), bflo(xw1[j].y), bfhi(xw1[j].y)); }
        }
#pragma unroll
        for (int rr = 0; rr < 2; ++rr) {
            if (rr == 1 && !two) break;
            const int m = rr ? m1 : m0; float4 yv[4]; float ss = 0.f;
#pragma unroll
            for (int j = 0; j < 4; ++j) { const uint2 w = rr ? yw1[j] : yw0[j]; yv[j] = make_float4(bflo(w.x), bfhi(w.x), bflo(w.y), bfhi(w.y));
                ss += (yv[j].x * yv[j].x + yv[j].y * yv[j].y) + (yv[j].z * yv[j].z + yv[j].w * yv[j].w); }
            float eps_ = EPS;
            if (YSC) { const float q_ = ysc[m]; const float q2_ = q_ * q_; eps_ = EPS / (q2_ * q2_); }
            const float r = 1.f / sqrtf(wave_sum(ss) * (1.f / D) + eps_);
            float4 v[4];
#pragma unroll
            for (int j = 0; j < 4; ++j) { const float4 xv = rr ? xv1[j] : xv0[j]; const float4 gg = ((const float4*)g1)[lane + 64 * j];
                v[j] = make_float4(xv.x + yv[j].x * r * gg.x, xv.y + yv[j].y * r * gg.y, xv.z + yv[j].z * r * gg.z, xv.w + yv[j].w * r * gg.w);
                if (XOUT == 0) ((float4*)((float*)xout_ + (size_t)m * D))[lane + 64 * j] = v[j];
                else { uint2 o; o.x = pk2(v[j].x, v[j].y); o.y = pk2(v[j].z, v[j].w); ((uint2*)((bf16*)xout_ + (size_t)m * D))[lane + 64 * j] = o; } }
            if (rrow) { float s2 = 0.f;
#pragma unroll
                for (int j = 0; j < 4; ++j) s2 += (v[j].x * v[j].x + v[j].y * v[j].y) + (v[j].z * v[j].z + v[j].w * v[j].w);
                const float r2 = 1.f / sqrtf(wave_sum(s2) * (1.f / D) + EPS);
                if (lane == 0) rrow[m] = r2; }
        }
    }
}

template <int DH, int NP, int MODE>
__device__ __forceinline__ void wattn_tile(const bf16* __restrict__ Kt, const bf16* __restrict__ Vt, int ldk, int key0, int kend, int t, int posmul, int posadd, int dmax,
                                           const LAS float* qs, const float* __restrict__ btab, int h0, float scale,
                                           float (&m)[NP], float (&l)[NP], float (&o)[NP][DH / 64], LAS float* cs, int lane) {
    const int k = key0 + lane; const bool inb = k < kend; const int kc = inb ? k : (kend - 1);
    const int d = t - (posmul * kc + posadd);
    const bool valid = inb && d >= 0 && d < dmax;
    float s[NP];
#pragma unroll
    for (int p = 0; p < NP; ++p) s[p] = 0.f;
    const uint4* krow = (const uint4*)(Kt + (size_t)kc * ldk);
    uint4 kr[DH / 8];
#pragma unroll
    for (int c = 0; c < DH / 8; ++c) kr[c] = krow[c];
#pragma unroll
    for (int c = 0; c < DH / 8; ++c) {
        asm volatile("" ::: "memory");
        const uint4 kv = kr[c];
        const float k0 = bflo(kv.x), k1 = bfhi(kv.x), k2 = bflo(kv.y), k3 = bfhi(kv.y), k4 = bflo(kv.z), k5 = bfhi(kv.z), k6 = bflo(kv.w), k7 = bfhi(kv.w);
#pragma unroll
        for (int p = 0; p < NP; ++p) { const f4 qa = *(const volatile LAS f4*)(qs + p * DH + 8 * c), qb = *(const volatile LAS f4*)(qs + p * DH + 8 * c + 4);
            s[p] += (k0 * qa.x + k1 * qa.y) + (k2 * qa.z + k3 * qa.w) + (k4 * qb.x + k5 * qb.y) + (k6 * qb.z + k7 * qb.w);
            asm volatile("" : "+v"(s[p]) :: "memory"); }
    }
    const int dd = d < 0 ? 0 : (d > 127 ? 127 : d);
    float pe[NP];
#pragma unroll
    for (int p = 0; p < NP; ++p) {
        const float sc = valid ? s[p] * scale + btab[(h0 + p) * 128 + dd] : -INFINITY;
        if (MODE == 2) { pe[p] = valid ? __expf(sc - m[p]) * l[p] : 0.f; }
        else {
            const float tm = wave_max(sc); const float mn = fmaxf(m[p], tm);
            float alpha = 1.f; pe[p] = 0.f;
            if (mn != -INFINITY) { alpha = __expf(m[p] - mn); pe[p] = valid ? __expf(sc - mn) : 0.f; }
            l[p] = l[p] * alpha + wave_sum(pe[p]); m[p] = mn;
            if (MODE == 0) {
#pragma unroll
                for (int i = 0; i < DH / 64; ++i) o[p][i] *= alpha; }
        }
    }
    if (MODE == 2) { float csum = 0.f;
#pragma unroll
        for (int p = 0; p < NP; ++p) csum += pe[p];
        if (inb) cs[k] = csum; }
    if (MODE != 1) {
        const int nk = (kend - key0) < 64 ? (kend - key0) : 64;
        for (int kk = 0; kk < nk; ++kk) {
            const bf16* vrow = Vt + (size_t)(key0 + kk) * ldk;
            float v0, v1 = 0.f;
            if (DH == 128) { const unsigned w = ((const unsigned*)vrow)[lane]; v0 = bflo(w); v1 = bfhi(w); } else { v0 = bf2f(vrow[lane]); }
#pragma unroll
            for (int p = 0; p < NP; ++p) { const float pk = __builtin_bit_cast(float, __builtin_amdgcn_readlane(__builtin_bit_cast(int, pe[p]), kk));
                o[p][0] += pk * v0; if (DH == 128) o[p][DH / 64 - 1] += pk * v1; }
        }
    }
}

__device__ __forceinline__ void l0_stage_a(const Params& P, LAS unsigned char* lds, int tid, int lane, int wave, int wg, int G) {
    unsigned char* ws = P.ws;
    const bf16* proj = (const bf16*)(ws + WS_PROJ);
    const bf16* xr = proj + (size_t)3 * T * 512;
    LAS float* xc = (LAS float*)lds;
    unsigned* hp = (unsigned*)P.out;
    const int c = tid, b = c >> 6;
    LAS bf16* rp = (LAS bf16*)(lds + 65536); LAS bf16* ip = (LAS bf16*)(lds + 98304);
    const int r16 = lane & 15, gl = lane >> 4;
    pg8::bf16x8 wfr[4][2], wfi[4][2];
    {
        const float* Wr = P.in[I_WRG] + (size_t)b * 4096; const float* Wi = P.in[I_WIG] + (size_t)b * 4096;
#pragma unroll
        for (int nt = 0; nt < 4; ++nt)
#pragma unroll
            for (int ks = 0; ks < 2; ++ks) { float fr[8], fi[8];
#pragma unroll
                for (int j = 0; j < 8; ++j) { const int idx = (32 * ks + 8 * gl + j) * 64 + 16 * nt + r16; fr[j] = Wr[idx]; fi[j] = Wi[idx]; }
                pg8::u32x4 wr4, wi4; wr4.x = pk2(fr[0], fr[1]); wr4.y = pk2(fr[2], fr[3]); wr4.z = pk2(fr[4], fr[5]); wr4.w = pk2(fr[6], fr[7]);
                wi4.x = pk2(fi[0], fi[1]); wi4.y = pk2(fi[2], fi[3]); wi4.z = pk2(fi[4], fi[5]); wi4.w = pk2(fi[6], fi[7]);
                wfr[nt][ks] = __builtin_bit_cast(pg8::bf16x8, wr4); wfi[nt][ks] = __builtin_bit_cast(pg8::bf16x8, wi4); }
    }
    float brg4[4], big4[4];
#pragma unroll
    for (int nt = 0; nt < 4; ++nt) { brg4[nt] = P.in[I_BRG][64 * b + 16 * nt + r16]; big4[nt] = P.in[I_BIG][64 * b + 16 * nt + r16]; }
    const float sp = log1pf(expf(-P.in[I_LAM][c]));
    const float* cw = P.in[I_CONVW]; const float w0 = cw[c], w1 = cw[512 + c], w2 = cw[1024 + c], w3 = cw[1536 + c], cb = P.in[I_CONVB][c];
    for (int ch = wg; ch < T / 64; ch += G) {
        const int t0 = ch * 64;
        float xm3 = (t0 >= 3) ? bf2f(xr[(size_t)(t0 - 3) * 512 + c]) : 0.f, xm2 = (t0 >= 2) ? bf2f(xr[(size_t)(t0 - 2) * 512 + c]) : 0.f, xm1 = (t0 >= 1) ? bf2f(xr[(size_t)(t0 - 1) * 512 + c]) : 0.f;
        float h = 0.f, Pc = 1.f;
#pragma unroll 1
        for (int hf = 0; hf < 2; ++hf) {
            const int ts = t0 + 32 * hf;
            for (int t16 = 0; t16 < 32; t16 += 16) { bf16 xv[16];
#pragma unroll
                for (int i = 0; i < 16; ++i) xv[i] = xr[(size_t)(ts + t16 + i) * 512 + c];
#pragma unroll
                for (int i = 0; i < 16; ++i) { const float x0 = bf2f(xv[i]); xc[(t16 + i) * 512 + c] = cb + w0 * xm3 + w1 * xm2 + w2 * xm1 + w3 * x0; xm3 = xm2; xm2 = xm1; xm1 = x0; } }
            __syncthreads();
#pragma unroll
            for (int mt = 0; mt < 2; ++mt) {
                pg8::bf16x8 af[2];
#pragma unroll
                for (int ks = 0; ks < 2; ++ks) { const LAS f4* xp = (const LAS f4*)(xc + (16 * mt + r16) * 512 + 64 * b + 32 * ks + 8 * gl); const f4 x0 = xp[0], x1 = xp[1];
                    pg8::u32x4 w; w.x = pk2(x0.x, x0.y); w.y = pk2(x0.z, x0.w); w.z = pk2(x1.x, x1.y); w.w = pk2(x1.z, x1.w); af[ks] = __builtin_bit_cast(pg8::bf16x8, w); }
#pragma unroll
                for (int nt = 0; nt < 4; ++nt) {
                    pg8::f32x4 ar = {0.f, 0.f, 0.f, 0.f}, ai = {0.f, 0.f, 0.f, 0.f};
                    ar = __builtin_amdgcn_mfma_f32_16x16x32_bf16(af[0], wfr[nt][0], ar, 0, 0, 0); ar = __builtin_amdgcn_mfma_f32_16x16x32_bf16(af[1], wfr[nt][1], ar, 0, 0, 0);
                    ai = __builtin_amdgcn_mfma_f32_16x16x32_bf16(af[0], wfi[nt][0], ai, 0, 0, 0); ai = __builtin_amdgcn_mfma_f32_16x16x32_bf16(af[1], wfi[nt][1], ai, 0, 0, 0);
#pragma unroll
                    for (int i = 0; i < 4; ++i) { const int o_ = (16 * mt + 4 * gl + i) * 512 + 64 * b + 16 * nt + r16; rp[o_] = (bf16)f2bf(ar[i] + brg4[nt]); ip[o_] = (bf16)f2bf(ai[i] + big4[nt]); }
                }
            }
            __syncthreads();
#pragma unroll 4
            for (int t = 0; t < 32; ++t) {
                const float r = __builtin_amdgcn_rcpf(1.f + __builtin_amdgcn_exp2f(-1.4426950408889634f * bf2f(rp[t * 512 + c]))), ig = __builtin_amdgcn_rcpf(1.f + __builtin_amdgcn_exp2f(-1.4426950408889634f * bf2f(ip[t * 512 + c])));
                const float la = -8.f * r * sp; const float a = __builtin_amdgcn_exp2f(1.4426950408889634f * la); const float x2 = 2.f * la;
                const float em_s = -x2 * (1.f + x2 * 0.5f * (1.f + x2 * (1.f / 3.f) * (1.f + x2 * 0.25f * (1.f + x2 * 0.2f * (1.f + x2 * (1.f / 6.f))))));
                const float em = (x2 > -0.25f) ? em_s : 1.f - a * a;
                const float bb = __builtin_amdgcn_sqrtf(em) * ig * xc[t * 512 + c];
                h = a * h + bb; Pc *= a;
                hp[(size_t)(ts + t) * 512 + c] = pk2(h, Pc);
            }
            __syncthreads();
        }
        float* car = (float*)(ws + WS_CARRY) + (size_t)ch * 1024; car[c] = Pc; car[512 + c] = h;
    }
}

__device__ __forceinline__ void l0_stage_c(const Params& P, LAS unsigned char* lds, int tid, int lane, int wave, int wg, int G) {
    unsigned char* ws = P.ws;
    const bf16* proj = (const bf16*)(ws + WS_PROJ);
    bf16* attnout = (bf16*)(ws + WS_XN);
    {
        const unsigned* hp = (const unsigned*)P.out; const float* car = (const float*)(ws + WS_CARRY);
        const bf16* gr = proj + (size_t)4 * T * 512;
        for (int ch = wg; ch < T / 64; ch += G) {
            const int c = tid, t0 = ch * 64; float H = 0.f;
            int cc = 0;
            for (; cc + 16 <= ch; cc += 16) {
                float a_[16], b_[16];
#pragma unroll
                for (int i = 0; i < 16; ++i) { a_[i] = car[(size_t)(cc + i) * 1024 + c]; b_[i] = car[(size_t)(cc + i) * 1024 + 512 + c]; }
#pragma unroll
                for (int i = 0; i < 16; ++i) H = a_[i] * H + b_[i];
            }
            for (; cc < ch; ++cc) H = car[(size_t)cc * 1024 + c] * H + car[(size_t)cc * 1024 + 512 + c];
            for (int t8 = 0; t8 < 64; t8 += 16) {
                unsigned hw[16]; bf16 gv[16];
#pragma unroll
                for (int i = 0; i < 16; ++i) { const size_t ix = (size_t)(t0 + t8 + i) * 512 + c; hw[i] = hp[ix]; gv[i] = gr[ix]; }
#pragma unroll
                for (int i = 0; i < 16; ++i) attnout[(size_t)(t0 + t8 + i) * 1024 + 512 + c] = (bf16)f2bf((bflo(hw[i]) + bfhi(hw[i]) * H) * gelu_tanh(bf2f(gv[i])));
            }
        }
    }
#if !MOBA_MFMA
    const bf16* qt = proj; const bf16* kt = proj + (size_t)1 * T * 512; const bf16* vt = proj + (size_t)2 * T * 512;
    const float* kmean = (const float*)(ws + WS_KMEAN); const float* btab = (const float*)(ws + WS_BT);
    LAS float* qs = (LAS float*)(lds + wave * 8192);
    for (int task = wg * NWAVES + wave; task < T * 8; task += G * NWAVES) {
        const int t = task >> 3, h = task & 7, own = t >> 8;
        qs[lane] = bf2f(qt[(size_t)t * 512 + 64 * h + lane]);
        LDS_WAIT(); asm volatile("" ::: "memory");
        float rv = -1e30f;
        if (lane < own) { const float4* km = (const float4*)(kmean + (size_t)(h * 64 + lane) * 64); float s = 0.f;
#pragma unroll
            for (int i = 0; i < 16; ++i) { const float4 kv = km[i]; const f4 qv = *(const LAS f4*)(qs + 4 * i); s += (kv.x * qv.x + kv.y * qv.y) + (kv.z * qv.z + kv.w * qv.w); }
            rv = s; }
        int sel[3];
#pragma unroll
        for (int r = 0; r < 3; ++r) { float bv = rv; int bi = lane; wave_argmax(bv, bi); bi = __builtin_amdgcn_readfirstlane(bi); sel[r] = (bv > -5e29f) ? bi : -1; if (lane == bi) rv = -INFINITY; }
        float m[1] = {-INFINITY}, l[1] = {0.f}, o[1][1] = {{0.f}};
#pragma unroll
        for (int r = 0; r < 3; ++r) if (sel[r] >= 0) for (int tile = 0; tile < 4; ++tile) { const int key0 = sel[r] * 256 + 64 * tile;
            wattn_tile<64, 1, 0>(kt + 64 * h, vt + 64 * h, 512, key0, key0 + 64, t, 1, 0, 0x7fffffff, qs, btab, h, 0.125f, m, l, o, nullptr, lane); }
        for (int key0 = own * 256; key0 <= t; key0 += 64)
            wattn_tile<64, 1, 0>(kt + 64 * h, vt + 64 * h, 512, key0, t + 1, t, 1, 0, 0x7fffffff, qs, btab, h, 0.125f, m, l, o, nullptr, lane);
        attnout[(size_t)t * 1024 + 64 * h + lane] = (bf16)f2bf(o[0][0] / fmaxf(l[0], 1e-30f));
        asm volatile("" ::: "memory");
    }
#endif
}

__device__ __forceinline__ const bf16* l1_tensor(const unsigned char* ws, int i) { return (const bf16*)(ws + WS_PROJ) + (size_t)i * T * 128; }
__device__ __forceinline__ void l1_load_q(const unsigned char* ws, int t, int g, LAS float* qs, int lane) {
#pragma unroll
    for (int p = 0; p < 4; ++p) { const unsigned w = ((const unsigned*)(l1_tensor(ws, 4 * g + p) + (size_t)t * 128))[lane]; qs[p * 128 + 2 * lane] = bflo(w); qs[p * 128 + 2 * lane + 1] = bfhi(w); }
    LDS_WAIT(); asm volatile("" ::: "memory");
}
__device__ __forceinline__ bf16 l1_gate_raw(const unsigned char* ws, int t, int h, int i) { return l1_tensor(ws, 20)[(size_t)t * 128 + 3 * h + i]; }
__device__ __forceinline__ float l1_gate(const unsigned char* ws, int t, int h, int i) { return sigmoidf_(bf2f(l1_tensor(ws, 20)[(size_t)t * 128 + 3 * h + i])); }
constexpr float SCALE_C = 0.08838834764831845f;
#ifndef WIN_MFMA
#define WIN_MFMA 1
#endif
#ifndef COMPRESS_MFMA
#define COMPRESS_MFMA 1
#endif

__device__ __forceinline__ void l1_stage_a(const Params& P, LAS unsigned char* lds, int tid, int lane, int wave, int wg, int G) {
    unsigned char* ws = P.ws;
#if !COMPRESS_MFMA
    {
        LAS float* kts = (LAS float*)lds;
        LAS float* pos_s = (LAS float*)(lds + 73728);
        LAS float* red = (LAS float*)(lds + 90112);
        float* hid = (float*)(ws + WS_HID);
        for (int task = wg; task < 512; task += G) {
            const int kv = task >> 8, g = (task >> 7) & 1, n0 = (task & 127) * 8;
            const bf16* src = l1_tensor(ws, (kv ? 10 : 8) + g); const float* pos = P.in[kv ? I_POSV : I_POSK]; const float* w1 = P.in[kv ? I_V1 : I_K1];
            for (int i = tid; i < 144 * 128; i += NTHR) { const int tok = 16 * n0 + (i >> 7); kts[i] = tok < T ? bf2f(src[(size_t)tok * 128 + (i & 127)]) : 0.f; }
            for (int i = tid; i < 32 * 128; i += NTHR) pos_s[i] = pos[i];
            __syncthreads();
            const int j = tid & 255, half = tid >> 8;
            float acc[8];
#pragma unroll
            for (int i = 0; i < 8; ++i) acc[i] = 0.f;
            for (int l = half * 16; l < half * 16 + 16; ++l)
                for (int d4 = 0; d4 < 32; ++d4) {
                    const float* wp = w1 + (size_t)(l * 128 + 4 * d4) * 256 + j; const float wa = wp[0], wb = wp[256], wc_ = wp[512], wd = wp[768];
                    const f4 pv = *(const LAS f4*)(pos_s + l * 128 + 4 * d4);
#pragma unroll
                    for (int i = 0; i < 8; ++i) { const f4 kk = *(const LAS f4*)(kts + (16 * i + l) * 128 + 4 * d4);
                        acc[i] += ((kk.x + pv.x) * wa + (kk.y + pv.y) * wb) + ((kk.z + pv.z) * wc_ + (kk.w + pv.w) * wd); }
                }
            if (half == 1) {
#pragma unroll
                for (int i = 0; i < 8; ++i) red[i * 256 + j] = acc[i]; }
            __syncthreads();
            if (half == 0) {
#pragma unroll
                for (int i = 0; i < 8; ++i) { const int n = n0 + i; if (n < 1023) hid[((size_t)(kv * 1024 + n) * 2 + g) * 256 + j] = gelu_tanh(acc[i] + red[i * 256 + j]); } }
            __syncthreads();
        }
    }
#endif
#if !WIN_MFMA
    const float* btab = (const float*)(ws + WS_BT); float* ocw = (float*)(ws + WS_OCW);
    LAS float* qs = (LAS float*)(lds + wave * 8192);
    for (int task = wg * NWAVES + wave; task < T * 2; task += G * NWAVES) {
        const int t = task >> 1, g = task & 1;
        l1_load_q(ws, t, g, qs, lane);
        float m[4], l[4], o[4][2];
#pragma unroll
        for (int p = 0; p < 4; ++p) { m[p] = -INFINITY; l[p] = 0.f; o[p][0] = 0.f; o[p][1] = 0.f; }
        const int lo = t >= 511 ? t - 511 : 0;
        for (int key0 = lo; key0 <= t; key0 += 64)
            wattn_tile<128, 4, 0>(l1_tensor(ws, 16 + g), l1_tensor(ws, 18 + g), 128, key0, t + 1, t, 1, 0, 512, qs, btab, 4 * g, SCALE_C, m, l, o, nullptr, lane);
#pragma unroll
        for (int p = 0; p < 4; ++p) { const float gt = l1_gate(ws, t, 4 * g + p, 2) / fmaxf(l[p], 1e-30f);
            *(float2*)(ocw + (size_t)t * 1024 + (4 * g + p) * 128 + 2 * lane) = make_float2(gt * o[p][0], gt * o[p][1]); }
        asm volatile("" ::: "memory");
    }
#endif
}
__device__ __forceinline__ void l1_stage_b(const Params& P, int tid, int wg, int G) {
    unsigned char* ws = P.ws; const float* hid = (const float*)(ws + WS_HID); bf16* kc = (bf16*)(ws + WS_KCMP);
    for (int idx = wg * NTHR + tid; idx < 2 * 2 * 1023 * 128; idx += G * NTHR) {
        const int d = idx & 127; int r = idx >> 7; const int n = r % 1023; r /= 1023; const int g = r & 1, kv = r >> 1;
        const float* hp = hid + ((size_t)(kv * 1024 + n) * 2 + g) * 256; const float* w2 = P.in[kv ? I_V2 : I_K2] + d; float s = 0.f;
#pragma unroll 8
        for (int j = 0; j < 256; ++j) s += hp[j] * w2[(size_t)j * 128];
        kc[((size_t)(kv * 2 + g) * 1024 + n) * 128 + d] = (bf16)f2bf(s);
    }
}
__device__ __forceinline__ void l1_stage_c(const Params& P, LAS unsigned char* lds, int tid, int lane, int wave, int wg, int G) {
    unsigned char* ws = P.ws;
    const float* btab = (const float*)(ws + WS_BT); float* ocw = (float*)(ws + WS_OCW); unsigned* selmask = (unsigned*)(ws + WS_SELMASK);
    LAS float* qs = (LAS float*)(lds + wave * 8192); LAS float* cs = qs + 512 + 8;
    for (int task = wg * NWAVES + wave; task < T * 2; task += G * NWAVES) {
        const int t = task >> 1, g = task & 1, cur = t >> 6;
        l1_load_q(ws, t, g, qs, lane);
        for (int i = lane; i < 1040; i += 64) cs[i - 4] = 0.f;
        LDS_WAIT(); asm volatile("" ::: "memory");
        const bf16* kc = (const bf16*)(ws + WS_KCMP) + (size_t)(0 * 2 + g) * 1024 * 128; const bf16* vc = (const bf16*)(ws + WS_KCMP) + (size_t)(1 * 2 + g) * 1024 * 128;
        int nvalid = t >= 31 ? ((t - 31) >> 4) + 1 : 0; if (nvalid > 1023) nvalid = 1023;
        float m[4], l[4], o[4][2];
#pragma unroll
        for (int p = 0; p < 4; ++p) { m[p] = -INFINITY; l[p] = 0.f; o[p][0] = 0.f; o[p][1] = 0.f; }
        for (int key0 = 0; key0 < nvalid; key0 += 64)
            wattn_tile<128, 4, 1>(kc, vc, 128, key0, nvalid, t, 16, 31, 0x7fffffff, qs, btab, 4 * g, SCALE_C, m, l, o, cs, lane);
#pragma unroll
        for (int p = 0; p < 4; ++p) l[p] = 1.f / fmaxf(l[p], 1e-30f);
        for (int key0 = 0; key0 < nvalid; key0 += 64)
            wattn_tile<128, 4, 2>(kc, vc, 128, key0, nvalid, t, 16, 31, 0x7fffffff, qs, btab, 4 * g, SCALE_C, m, l, o, cs, lane);
#pragma unroll
        for (int p = 0; p < 4; ++p) { const float gt = l1_gate(ws, t, 4 * g + p, 0); float2* op = (float2*)(ocw + (size_t)t * 1024 + (4 * g + p) * 128 + 2 * lane);
            float2 v = *op; v.x += gt * o[p][0]; v.y += gt * o[p][1]; *op = v; }
        LDS_WAIT(); asm volatile("" ::: "memory");
        float iv[4];
#pragma unroll
        for (int i = 0; i < 4; ++i) { const int j = lane + 64 * i; float v = cs[4 * j - 1] + cs[4 * j] + cs[4 * j + 1] + cs[4 * j + 2] + cs[4 * j + 3];
            if (j == 0 || j == cur || j == cur - 1) v += 1e4f;
            if (j > cur) v = -1e30f;
            iv[i] = v; }
        unsigned mk[4] = {0u, 0u, 0u, 0u};
        for (int r = 0; r < 16; ++r) {
            float bv = iv[0]; int bi = lane;
#pragma unroll
            for (int i = 1; i < 4; ++i) if (iv[i] > bv) { bv = iv[i]; bi = lane + 64 * i; }
            wave_argmax(bv, bi); bi = __builtin_amdgcn_readfirstlane(bi);
            if (!(bv > -5e29f)) break;
#pragma unroll
            for (int i = 0; i < 4; ++i) if (lane + 64 * i == bi) { iv[i] = -INFINITY; mk[i] = 1u; }
        }
#pragma unroll
        for (int i = 0; i < 4; ++i) { const unsigned long long bal = __ballot(mk[i] != 0u);
            if (lane == 0) { selmask[((size_t)t * 2 + g) * 8 + 2 * i] = (unsigned)bal; selmask[((size_t)t * 2 + g) * 8 + 2 * i + 1] = (unsigned)(bal >> 32); } }
        asm volatile("" ::: "memory");
    }
}
__device__ __forceinline__ void l1_stage_d(const Params& P, LAS unsigned char* lds, int tid, int lane, int wave, int wg, int G) {
    unsigned char* ws = P.ws;
    const float* btab = (const float*)(ws + WS_BT); const float* ocw = (const float*)(ws + WS_OCW); const unsigned* selmask = (const unsigned*)(ws + WS_SELMASK);
    bf16* attnout = (bf16*)(ws + WS_XN);
    LAS float* qs = (LAS float*)(lds + wave * 8192);
    for (int task = wg * NWAVES + wave; task < T * 2; task += G * NWAVES) {
        const int t = task >> 1, g = task & 1;
        l1_load_q(ws, t, g, qs, lane);
        float m[4], l[4], o[4][2];
#pragma unroll
        for (int p = 0; p < 4; ++p) { m[p] = -INFINITY; l[p] = 0.f; o[p][0] = 0.f; o[p][1] = 0.f; }
        for (int w = 0; w < 8; ++w) {
            unsigned bits = __builtin_amdgcn_readfirstlane(selmask[((size_t)t * 2 + g) * 8 + w]);
            while (bits) { const int b = __builtin_ctz(bits); bits &= bits - 1u; const int key0 = (32 * w + b) * 64; const int kend = (key0 + 64) < (t + 1) ? (key0 + 64) : (t + 1);
                wattn_tile<128, 4, 0>(l1_tensor(ws, 12 + g), l1_tensor(ws, 14 + g), 128, key0, kend, t, 1, 0, 0x7fffffff, qs, btab, 4 * g, SCALE_C, m, l, o, nullptr, lane); }
        }
#pragma unroll
        for (int p = 0; p < 4; ++p) { const float gt = l1_gate(ws, t, 4 * g + p, 1) / fmaxf(l[p], 1e-30f); const float2 base = *(const float2*)(ocw + (size_t)t * 1024 + (4 * g + p) * 128 + 2 * lane);
            *(unsigned*)(attnout + (size_t)t * 1024 + (4 * g + p) * 128 + 2 * lane) = pk2(base.x + gt * o[p][0], base.y + gt * o[p][1]); }
        asm volatile("" ::: "memory");
    }
}

typedef short bf16x8 __attribute__((ext_vector_type(8)));
typedef short v4i16_t __attribute__((ext_vector_type(4)));
typedef float f32x16 __attribute__((ext_vector_type(16)));
typedef unsigned u4 __attribute__((ext_vector_type(4)));
template <int DH> struct AT { static constexpr int PK = DH * 2 + 16, TILE = 64 * PK, NKS = DH / 16, NDT = DH / 32, CPT = DH / 64; };
template <int DH> __device__ __forceinline__ int v_off(int row, int ch) {
    if (DH == 128) return 256 * row + 16 * (ch ^ (((row & 3) << 2) | ((row >> 2) & 3)));
    else return 128 * row + 16 * (ch ^ ((((row >> 1) & 1) << 2) | (((row >> 2) & 1) << 1) | ((row >> 3) & 1)));
}
constexpr int AT_BT_OFF = 4 * AT<128>::TILE;

template <int DH> __device__ __forceinline__ void at_load(const bf16* __restrict__ Kg, const bf16* __restrict__ Vg, int ldk, int key0, int kmax, u4 (&kr)[AT<DH>::CPT], u4 (&vr)[AT<DH>::CPT], int tid) {
#pragma unroll
    for (int i = 0; i < AT<DH>::CPT; ++i) { const int cid = tid + 512 * i, key = cid / (DH / 8), cc = cid % (DH / 8); int row = key0 + key; row = row < kmax ? row : kmax;
        kr[i] = *(const u4*)(Kg + (size_t)row * ldk + cc * 8); vr[i] = *(const u4*)(Vg + (size_t)row * ldk + cc * 8); }
}
template <int DH> __device__ __forceinline__ void at_load_k(const bf16* __restrict__ Kg, int ldk, int key0, int kmax, u4 (&kr)[AT<DH>::CPT], int tid) {
#pragma unroll
    for (int i = 0; i < AT<DH>::CPT; ++i) { const int cid = tid + 512 * i, key = cid / (DH / 8), cc = cid % (DH / 8); int row = key0 + key; row = row < kmax ? row : kmax;
        kr[i] = *(const u4*)(Kg + (size_t)row * ldk + cc * 8); }
}
template <int DH> __device__ __forceinline__ void at_store_k(LAS unsigned char* Kl, const u4 (&kr)[AT<DH>::CPT], int tid) {
#pragma unroll
    for (int i = 0; i < AT<DH>::CPT; ++i) { const int cid = tid + 512 * i, key = cid / (DH / 8), cc = cid % (DH / 8); *(LAS u4*)(Kl + key * AT<DH>::PK + cc * 16) = kr[i]; }
}
template <int DH> __device__ __forceinline__ void at_store(LAS unsigned char* Kl, LAS unsigned char* Vl, const u4 (&kr)[AT<DH>::CPT], const u4 (&vr)[AT<DH>::CPT], int tid) {
#pragma unroll
    for (int i = 0; i < AT<DH>::CPT; ++i) { const int cid = tid + 512 * i, key = cid / (DH / 8), cc = cid % (DH / 8);
        *(LAS u4*)(Kl + key * AT<DH>::PK + cc * 16) = kr[i]; *(LAS u4*)(Vl + v_off<DH>(key, cc)) = vr[i]; }
}
template <int DH, int KB = AT<DH>::NKS> __device__ __forceinline__ void at_qk(const LAS unsigned char* Kl, const bf16x8 (&qf)[AT<DH>::NKS], f32x16 (&s)[2], int r, int h) {
#pragma unroll
    for (int kt = 0; kt < 2; ++kt) {
        f32x16 a0;
#pragma unroll
        for (int i = 0; i < 16; ++i) a0[i] = 0.f;
#pragma unroll
        for (int k0 = 0; k0 < AT<DH>::NKS; k0 += KB) {
            bf16x8 kf[KB];
#pragma unroll
            for (int ks = 0; ks < KB; ++ks) kf[ks] = *(const LAS bf16x8*)(Kl + (32 * kt + r) * AT<DH>::PK + (16 * (k0 + ks) + 8 * h) * 2);
            asm volatile("" ::: "memory");
#pragma unroll
            for (int ks = 0; ks < KB; ++ks) a0 = __builtin_amdgcn_mfma_f32_32x32x16_bf16(kf[ks], qf[k0 + ks], a0, 0, 0, 0);
        }
        s[kt] = a0; }
}
template <int POSMUL, int POSADD, int DMAX> __device__ __forceinline__ float at_mask(f32x16 (&s)[2], int key0, int kend, int t_row, bool rowsel, const LAS float* brow, float scale, int h) {
    float lm = -INFINITY;
#pragma unroll
    for (int kt = 0; kt < 2; ++kt)
#pragma unroll
        for (int i4 = 0; i4 < 16; i4 += 4) {
            float bv[4];
#pragma unroll
            for (int i = i4; i < i4 + 4; ++i) { const int key = key0 + 32 * kt + (i & 3) + 8 * (i >> 2) + 4 * h; const int d = t_row - (POSMUL * key + POSADD); const int dd = d < 0 ? 0 : (d > 127 ? 127 : d); bv[i - i4] = brow[dd]; }
            asm volatile("" ::: "memory");
#pragma unroll
            for (int i = i4; i < i4 + 4; ++i) { const int key = key0 + 32 * kt + (i & 3) + 8 * (i >> 2) + 4 * h; const int d = t_row - (POSMUL * key + POSADD);
                const bool valid = rowsel && key < kend && (unsigned)d < (unsigned)DMAX;
                const float v = valid ? s[kt][i] * scale + bv[i - i4] : -INFINITY; s[kt][i] = v; lm = fmaxf(lm, v); }
        }
    return lm;
}
template <int OFF> __device__ __forceinline__ v4i16_t tr16_asm(unsigned addr) { v4i16_t r; asm volatile("ds_read_b64_tr_b16 %0, %1 offset:%2" : "=v"(r) : "v"(addr), "n"(OFF) : "memory"); return r; }
__device__ __forceinline__ void at_pv_asm128(const LAS unsigned char* Vl, const f32x16 (&s)[2], f32x16 (&o)[4], int lane) {
    bf16x8 pb[4];
#pragma unroll
    for (int kt = 0; kt < 2; ++kt)
#pragma unroll
        for (int s2 = 0; s2 < 2; ++s2) { u4 w; w.x = pg8::cvt_pk_bf16(s[kt][8 * s2 + 0], s[kt][8 * s2 + 1]); w.y = pg8::cvt_pk_bf16(s[kt][8 * s2 + 2], s[kt][8 * s2 + 3]);
            w.z = pg8::cvt_pk_bf16(s[kt][8 * s2 + 4], s[kt][8 * s2 + 5]); w.w = pg8::cvt_pk_bf16(s[kt][8 * s2 + 6], s[kt][8 * s2 + 7]); pb[2 * kt + s2] = __builtin_bit_cast(bf16x8, w); }
    const int i16 = lane & 15, q4 = i16 >> 2, p4 = i16 & 3, half = (lane >> 4) & 1, h = lane >> 5;
    const unsigned vb = (unsigned)(size_t)Vl + 8u * (unsigned)(p4 & 1);
#pragma unroll
    for (int dp = 0; dp < 4; dp += 2) {
        v4i16_t lo[8], hi[8];
#pragma unroll
        for (int d2 = 0; d2 < 2; ++d2) { const int ch = 4 * (dp + d2) + 2 * half + (p4 >> 1);
            const unsigned al = vb + (unsigned)v_off<128>(4 * h + q4, ch), ah = vb + (unsigned)v_off<128>(4 * h + q4 + 8, ch);
            lo[4 * d2 + 0] = tr16_asm<0>(al); lo[4 * d2 + 1] = tr16_asm<4096>(al); lo[4 * d2 + 2] = tr16_asm<8192>(al); lo[4 * d2 + 3] = tr16_asm<12288>(al);
            hi[4 * d2 + 0] = tr16_asm<0>(ah); hi[4 * d2 + 1] = tr16_asm<4096>(ah); hi[4 * d2 + 2] = tr16_asm<8192>(ah); hi[4 * d2 + 3] = tr16_asm<12288>(ah); }
        asm volatile("s_waitcnt lgkmcnt(0)" : "+v"(lo[0]), "+v"(lo[1]), "+v"(lo[2]), "+v"(lo[3]), "+v"(lo[4]), "+v"(lo[5]), "+v"(lo[6]), "+v"(lo[7]),
                                  "+v"(hi[0]), "+v"(hi[1]), "+v"(hi[2]), "+v"(hi[3]), "+v"(hi[4]), "+v"(hi[5]), "+v"(hi[6]), "+v"(hi[7]) :: "memory");
#pragma unroll
        for (int ks4 = 0; ks4 < 4; ++ks4)
#pragma unroll
            for (int d2 = 0; d2 < 2; ++d2) { const v4i16_t l_ = lo[4 * d2 + ks4], h_ = hi[4 * d2 + ks4];
                const bf16x8 a = {l_[0], l_[1], l_[2], l_[3], h_[0], h_[1], h_[2], h_[3]};
                o[dp + d2] = __builtin_amdgcn_mfma_f32_32x32x16_bf16(a, pb[ks4], o[dp + d2], 0, 0, 0); }
#pragma unroll
        for (int d2 = 0; d2 < 2; ++d2) asm volatile("" : "+v"(o[dp + d2]) :: "memory");
    }
}
template <int DH, int DB = ((DH == 128) ? 1 : 2)> __device__ __forceinline__ void at_pv(const LAS unsigned char* Vl, const f32x16 (&s)[2], f32x16 (&o)[AT<DH>::NDT], int lane) {
    bf16x8 pb[4];
#pragma unroll
    for (int kt = 0; kt < 2; ++kt)
#pragma unroll
        for (int s2 = 0; s2 < 2; ++s2) { u4 w; w.x = pg8::cvt_pk_bf16(s[kt][8 * s2 + 0], s[kt][8 * s2 + 1]); w.y = pg8::cvt_pk_bf16(s[kt][8 * s2 + 2], s[kt][8 * s2 + 3]);
            w.z = pg8::cvt_pk_bf16(s[kt][8 * s2 + 4], s[kt][8 * s2 + 5]); w.w = pg8::cvt_pk_bf16(s[kt][8 * s2 + 6], s[kt][8 * s2 + 7]); pb[2 * kt + s2] = __builtin_bit_cast(bf16x8, w); }
    const int i16 = lane & 15, q4 = i16 >> 2, p4 = i16 & 3, half = (lane >> 4) & 1, h = lane >> 5;
#pragma unroll
    for (int dp = 0; dp < AT<DH>::NDT; dp += DB) {
        v4i16_t lo[4 * DB], hi[4 * DB];
#pragma unroll
        for (int d2 = 0; d2 < DB; ++d2)
#pragma unroll
            for (int ks4 = 0; ks4 < 4; ++ks4) {
                const int row = 16 * ks4 + 4 * h + q4, ch = 4 * (dp + d2) + 2 * half + (p4 >> 1);
                lo[4 * d2 + ks4] = __builtin_amdgcn_ds_read_tr16_b64_v4i16((LAS v4i16_t*)(Vl + v_off<DH>(row, ch) + 8 * (p4 & 1)));
                hi[4 * d2 + ks4] = __builtin_amdgcn_ds_read_tr16_b64_v4i16((LAS v4i16_t*)(Vl + v_off<DH>(row + 8, ch) + 8 * (p4 & 1))); }
        if (DB == 2) asm volatile("s_waitcnt lgkmcnt(0)" : "+v"(lo[0]), "+v"(lo[1]), "+v"(lo[2]), "+v"(lo[3]), "+v"(lo[4 * (DB - 1)]), "+v"(lo[4 * (DB - 1) + 1]), "+v"(lo[4 * (DB - 1) + 2]), "+v"(lo[4 * (DB - 1) + 3]),
                                  "+v"(hi[0]), "+v"(hi[1]), "+v"(hi[2]), "+v"(hi[3]), "+v"(hi[4 * (DB - 1)]), "+v"(hi[4 * (DB - 1) + 1]), "+v"(hi[4 * (DB - 1) + 2]), "+v"(hi[4 * (DB - 1) + 3]) :: "memory");
        else asm volatile("s_waitcnt lgkmcnt(0)" : "+v"(lo[0]), "+v"(lo[1]), "+v"(lo[2]), "+v"(lo[3]), "+v"(hi[0]), "+v"(hi[1]), "+v"(hi[2]), "+v"(hi[3]) :: "memory");
#pragma unroll
        for (int ks4 = 0; ks4 < 4; ++ks4)
#pragma unroll
            for (int d2 = 0; d2 < DB; ++d2) { const v4i16_t l_ = lo[4 * d2 + ks4], h_ = hi[4 * d2 + ks4];
                const bf16x8 a = {l_[0], l_[1], l_[2], l_[3], h_[0], h_[1], h_[2], h_[3]};
                o[dp + d2] = __builtin_amdgcn_mfma_f32_32x32x16_bf16(a, pb[ks4], o[dp + d2], 0, 0, 0); }
#pragma unroll
        for (int d2 = 0; d2 < DB; ++d2) asm volatile("" : "+v"(o[dp + d2]) :: "memory");
    }
}
template <int DH> __device__ __forceinline__ void at_softmax(f32x16 (&s)[2], float lm, float& m_run, float& l_run, f32x16 (&o)[AT<DH>::NDT]) {
    lm = fmaxf(lm, __shfl_xor(lm, 32));
    const float mn = fmaxf(m_run, lm); const float ms = (mn == -INFINITY) ? 0.f : mn;
    const float alpha = __expf(m_run - ms); m_run = mn;
    float ps = 0.f;
#pragma unroll
    for (int kt = 0; kt < 2; ++kt)
#pragma unroll
        for (int i = 0; i < 16; ++i) { const float p = __expf(s[kt][i] - ms); s[kt][i] = p; ps += p; }
    l_run = l_run * alpha + ps;
#pragma unroll
    for (int dt = 0; dt < AT<DH>::NDT; ++dt)
#pragma unroll
        for (int i = 0; i < 16; ++i) o[dt][i] *= alpha;
}
__device__ __forceinline__ void at_load_bt(const unsigned char* ws, LAS unsigned char* lds, int tid) {
    const float* bt = (const float*)(ws + WS_BT); LAS float* d = (LAS float*)(lds + AT_BT_OFF);
    for (int i = tid; i < 1024; i += NTHR) d[i] = bt[i];
}

constexpr float LOG2E = 1.4426950408889634f;
__device__ __forceinline__ float dpp_quad_xor1(float v) { return __builtin_bit_cast(float, __builtin_amdgcn_update_dpp(0, __builtin_bit_cast(int, v), 0xB1, 0xf, 0xf, false)); }
__device__ __forceinline__ float dpp_quad_xor2(float v) { return __builtin_bit_cast(float, __builtin_amdgcn_update_dpp(0, __builtin_bit_cast(int, v), 0x4E, 0xf, 0xf, false)); }
__device__ __forceinline__ unsigned wave_max_u32(unsigned v) {
    v = max(v, (unsigned)__builtin_amdgcn_update_dpp(0, (int)v, 0x128, 0xf, 0xf, false));
    v = max(v, (unsigned)__builtin_amdgcn_update_dpp(0, (int)v, 0x124, 0xf, 0xf, false));
    v = max(v, (unsigned)__builtin_amdgcn_update_dpp(0, (int)v, 0x122, 0xf, 0xf, false));
    v = max(v, (unsigned)__builtin_amdgcn_update_dpp(0, (int)v, 0x121, 0xf, 0xf, false));
    const auto a = __builtin_amdgcn_permlane16_swap(v, v, false, false); v = max(a[0], a[1]);
    const auto b = __builtin_amdgcn_permlane32_swap(v, v, false, false); v = max(b[0], b[1]);
    return v; }
__device__ __forceinline__ float max_xor32(float v) { const auto rr = __builtin_amdgcn_permlane32_swap(__builtin_bit_cast(unsigned, v), __builtin_bit_cast(unsigned, v), false, false);
    return fmaxf(__builtin_bit_cast(float, rr[0]), __builtin_bit_cast(float, rr[1])); }
__device__ __forceinline__ float max_xor16(float v) { const auto rr = __builtin_amdgcn_permlane16_swap(__builtin_bit_cast(unsigned, v), __builtin_bit_cast(unsigned, v), false, false);
    return fmaxf(__builtin_bit_cast(float, rr[0]), __builtin_bit_cast(float, rr[1])); }
constexpr float AT_THR = 8.f;
__device__ __forceinline__ void at_load_bt2(const unsigned char* ws, LAS unsigned char* lds, int off, int tid) {
    const float* bt = (const float*)(ws + WS_BT); LAS float* d = (LAS float*)(lds + off);
    for (int i = tid; i < 1024; i += NTHR) d[i] = bt[i] * LOG2E;
}
template <int POSMUL, int POSADD, int DMAX> __device__ __forceinline__ float at_scores(f32x16 (&s)[2], bool fast, int key0, int kend, int t_row, bool rowsel, const LAS float* brow2, float c1, int h) {
    float lm = -INFINITY;
    if (fast) {
#pragma unroll
        for (int kt = 0; kt < 2; ++kt)
#pragma unroll
            for (int i = 0; i < 16; ++i) lm = fmaxf(lm, s[kt][i]);
        lm = rowsel ? fmaf(lm, c1, brow2[127]) : -INFINITY;
    } else {
#pragma unroll
        for (int kt = 0; kt < 2; ++kt)
#pragma unroll
            for (int i4 = 0; i4 < 16; i4 += 4) {
                float bv[4];
#pragma unroll
                for (int i = i4; i < i4 + 4; ++i) { const int key = key0 + 32 * kt + (i & 3) + 8 * (i >> 2) + 4 * h; const int d = t_row - (POSMUL * key + POSADD); const int dd = d < 0 ? 0 : (d > 127 ? 127 : d); bv[i - i4] = brow2[dd]; }
                asm volatile("" ::: "memory");
#pragma unroll
                for (int i = i4; i < i4 + 4; ++i) { const int key = key0 + 32 * kt + (i & 3) + 8 * (i >> 2) + 4 * h; const int d = t_row - (POSMUL * key + POSADD);
                    const bool valid = rowsel && key < kend && (unsigned)d < (unsigned)DMAX;
                    const float v = valid ? fmaf(s[kt][i], c1, bv[i - i4]) : -INFINITY; s[kt][i] = v; lm = fmaxf(lm, v); }
            }
    }
    return max_xor32(lm);
}
__device__ __forceinline__ float at_probs(f32x16 (&s)[2], bool fast, bool rowsel, float bfar2, float c1, float sub) {
    float ps = 0.f;
    if (fast) { const float bb = rowsel ? (bfar2 - sub) : -INFINITY;
#pragma unroll
        for (int kt = 0; kt < 2; ++kt)
#pragma unroll
            for (int i = 0; i < 16; ++i) { const float p = __builtin_amdgcn_exp2f(fmaf(s[kt][i], c1, bb)); s[kt][i] = p; ps += p; }
    } else {
#pragma unroll
        for (int kt = 0; kt < 2; ++kt)
#pragma unroll
            for (int i = 0; i < 16; ++i) { const float p = __builtin_amdgcn_exp2f(s[kt][i] - sub); s[kt][i] = p; ps += p; }
    }
    return ps;
}
template <int DH, int POSMUL, int POSADD, int DMAX, int DB = ((DH == 128) ? 1 : 2), int KB = AT<DH>::NKS>
__device__ __forceinline__ void at_step(const LAS unsigned char* Kl, const LAS unsigned char* Vl, const bf16x8 (&qf)[AT<DH>::NKS], f32x16 (&o)[AT<DH>::NDT], float& m_run, float& l_run,
                                        bool fast, int key0, int kend, int t_row, bool rowsel, const LAS float* brow2, float c1, int r, int h, int lane) {
    f32x16 s[2];
    at_qk<DH, KB>(Kl, qf, s, r, h);
    const float lm = at_scores<POSMUL, POSADD, DMAX>(s, fast, key0, kend, t_row, rowsel, brow2, c1, h);
    if (!__all(lm <= m_run + AT_THR)) {
        const float mn = fmaxf(m_run, lm); const float ms = (mn == -INFINITY) ? 0.f : mn;
        const float alpha = __builtin_amdgcn_exp2f(m_run - ms); m_run = mn; l_run *= alpha;
#pragma unroll
        for (int dt = 0; dt < AT<DH>::NDT; ++dt)
#pragma unroll
            for (int i = 0; i < 16; ++i) o[dt][i] *= alpha;
    }
    const float sub = (m_run == -INFINITY) ? 0.f : m_run;
    l_run += at_probs(s, fast, rowsel, brow2[127], c1, sub);
    if constexpr (DB == -1) at_pv_asm128(Vl, s, o, lane); else at_pv<DH, DB>(Vl, s, o, lane);
}

__device__ __forceinline__ void l1_window_mfma(const Params& P, LAS unsigned char* lds, int tid, int lane, int wave, int wg, int G) {
    unsigned char* ws = P.ws; float* ocw = (float*)(ws + WS_OCW);
    constexpr int TILE = AT<128>::TILE;
    constexpr int WIN_BT = 8 * TILE;
    at_load_bt2(ws, lds, WIN_BT, tid);
    const int r = lane & 31, h = lane >> 5;
    for (int unit = wg; unit < 512; unit += G) {
        const int g = unit & 1, c = unit >> 1, t0 = 64 * c;
        const int t_row = t0 + 8 * wave + (r >> 2), head = 4 * g + (r & 3);
        const bf16* Kg = l1_tensor(ws, 16 + g); const bf16* Vg = l1_tensor(ws, 18 + g);
        bf16x8 qf[8];
        { const bf16* qrow = l1_tensor(ws, head) + (size_t)t_row * 128 + 8 * h;
#pragma unroll
          for (int ks = 0; ks < 8; ++ks) qf[ks] = *(const bf16x8*)(qrow + 16 * ks); }
        const bf16 graw = l1_gate_raw(ws, t_row, head, 2);
        const LAS float* brow = (const LAS float*)(lds + WIN_BT) + head * 128;
        f32x16 o[4];
#pragma unroll
        for (int dt = 0; dt < 4; ++dt)
#pragma unroll
            for (int i = 0; i < 16; ++i) o[dt][i] = 0.f;
        float m_run = -INFINITY, l_run = 0.f;
        const int jlo = c >= 8 ? c - 8 : 0;
        int ksrc[3], vsrc[2];
#pragma unroll
        for (int q3 = 0; q3 < 3; ++q3) { const int off = 1024 * (wave + 8 * q3) + 16 * lane, row = off / 272, cb = off - row * 272; ksrc[q3] = (row < 64 ? row : 63) * 128 + (cb < 256 ? cb >> 1 : 0); }
#pragma unroll
        for (int q2 = 0; q2 < 2; ++q2) { const int row = 4 * (2 * wave + q2) + (lane >> 4), ph = lane & 15, ch = ph ^ (((row & 3) << 2) | ((row >> 2) & 3)); vsrc[q2] = row * 128 + 8 * ch; }
#define WIN_DMA(SLOT, J) do { LAS unsigned char* kd_ = (SLOT); LAS unsigned char* vd_ = kd_ + TILE; const bf16* kg_ = Kg + (size_t)(64 * (J)) * 128; const bf16* vg_ = Vg + (size_t)(64 * (J)) * 128; \
            __builtin_amdgcn_global_load_lds((const unsigned*)(kg_ + ksrc[0]), (LAS unsigned*)(kd_ + 1024 * wave), 16, 0, 0); \
            __builtin_amdgcn_global_load_lds((const unsigned*)(kg_ + ksrc[1]), (LAS unsigned*)(kd_ + 1024 * (wave + 8)), 16, 0, 0); \
            if (wave == 0) __builtin_amdgcn_global_load_lds((const unsigned*)(kg_ + ksrc[2]), (LAS unsigned*)(kd_ + 1024 * 16), 16, 0, 0); \
            __builtin_amdgcn_global_load_lds((const unsigned*)(vg_ + vsrc[0]), (LAS unsigned*)(vd_ + 1024 * (2 * wave)), 16, 0, 0); \
            __builtin_amdgcn_global_load_lds((const unsigned*)(vg_ + vsrc[1]), (LAS unsigned*)(vd_ + 1024 * (2 * wave + 1)), 16, 0, 0); } while (0)
#define WIN_STEP(KL, J) do { const int j_ = (J); const int dmin = t0 + 8 * wave - (64 * j_ + 63), dmax = t0 + 8 * wave + 7 - 64 * j_; \
            at_step<128, 1, 0, 512, -1>((KL), (KL) + TILE, qf, o, m_run, l_run, dmin >= 113 && dmax < 512, 64 * j_, T, t_row, true, brow, SCALE_C * LOG2E, r, h, lane); } while (0)
        __syncthreads();
        WIN_DMA(lds, jlo);
        if (jlo + 1 <= c) WIN_DMA(lds + 2 * TILE, jlo + 1);
#pragma unroll 1
        for (int i = 0; jlo + 2 * i <= c; ++i) {
            const int ja = jlo + 2 * i, jb = ja + 1;
            LAS unsigned char* pc = lds + (i & 1) * 4 * TILE; LAS unsigned char* pn = lds + ((i + 1) & 1) * 4 * TILE;
            asm volatile("s_waitcnt vmcnt(0)" ::: "memory");
            __syncthreads();
            if (ja + 2 <= c) WIN_DMA(pn, ja + 2);
            if (ja + 3 <= c) WIN_DMA(pn + 2 * TILE, ja + 3);
            WIN_STEP(pc, ja);
            if (jb <= c) WIN_STEP(pc + 2 * TILE, jb);
        }
#undef WIN_DMA
#undef WIN_STEP
        const float lt = l_run + __shfl_xor(l_run, 32);
        const float f = sigmoidf_(bf2f(graw)) / fmaxf(lt, 1e-30f);
        float* orow = ocw + (size_t)t_row * 1024 + head * 128 + 4 * h;
#pragma unroll
        for (int dt = 0; dt < 4; ++dt)
#pragma unroll
            for (int gq = 0; gq < 4; ++gq)
                *(float4*)(orow + 32 * dt + 8 * gq) = make_float4(o[dt][4 * gq] * f, o[dt][4 * gq + 1] * f, o[dt][4 * gq + 2] * f, o[dt][4 * gq + 3] * f);
    }
}

__device__ __forceinline__ void l1_sel_mfma(const Params& P, LAS unsigned char* lds, int tid, int lane, int wave, int wg, int G) {
    unsigned char* ws = P.ws; const float* ocw = (const float*)(ws + WS_OCW); const unsigned* selmask = (const unsigned*)(ws + WS_SELMASK);
    bf16* attnout = (bf16*)(ws + WS_XN);
    constexpr int TILE = AT<128>::TILE;
    LAS unsigned* selm = (LAS unsigned*)(lds + AT_BT_OFF + 4096);
    at_load_bt2(ws, lds, AT_BT_OFF, tid);
    const int r = lane & 31, h = lane >> 5;
    for (int u = wg; u < 512; u += G) {
        const int g = u & 1, k = u >> 1, c = k < 128 ? k : 383 - k, t0 = 64 * c;
        const int ql = 8 * wave + (r >> 2), t_row = t0 + ql, head = 4 * g + (r & 3);
        const bf16* Kg = l1_tensor(ws, 12 + g); const bf16* Vg = l1_tensor(ws, 14 + g);
        bf16x8 qf[8];
        { const bf16* qrow = l1_tensor(ws, head) + (size_t)t_row * 128 + 8 * h;
#pragma unroll
          for (int ks = 0; ks < 8; ++ks) qf[ks] = *(const bf16x8*)(qrow + 16 * ks); }
        const LAS float* brow = (const LAS float*)(lds + AT_BT_OFF) + head * 128;
        f32x16 o[4];
#pragma unroll
        for (int dt = 0; dt < 4; ++dt)
#pragma unroll
            for (int i = 0; i < 16; ++i) o[dt][i] = 0.f;
        float m_run = -INFINITY, l_run = 0.f;
        u4 kra[2], vra[2], krb[2], vrb[2];
        at_load<128>(Kg, Vg, 128, 0, T - 1, kra, vra, tid);
        if (c >= 1) at_load<128>(Kg, Vg, 128, 64, T - 1, krb, vrb, tid);
        __syncthreads();
        selm[tid] = selmask[((size_t)(t0 + (tid >> 3)) * 2 + g) * 8 + (tid & 7)];
#define SEL_STEP(KR, VR, BUF, J) do { const int j_ = (J); LAS unsigned char* Kl = lds + (BUF) * 2 * TILE; LAS unsigned char* Vl = Kl + TILE; \
            at_store<128>(Kl, Vl, KR, VR, tid); __syncthreads(); \
            if (j_ + 2 <= c) at_load<128>(Kg, Vg, 128, 64 * (j_ + 2), T - 1, KR, VR, tid); \
            const bool rowsel = (selm[ql * 8 + (j_ >> 5)] >> (j_ & 31)) & 1u; \
            if (__any(rowsel)) at_step<128, 1, 0, 0x7fffffff>(Kl, Vl, qf, o, m_run, l_run, t0 + 8 * wave - (64 * j_ + 63) >= 113, 64 * j_, T, t_row, rowsel, brow, SCALE_C * LOG2E, r, h, lane); } while (0)
        for (int j = 0; j <= c; j += 2) {
            SEL_STEP(kra, vra, 0, j);
            if (j + 1 <= c) SEL_STEP(krb, vrb, 1, j + 1);
        }
#undef SEL_STEP
        const float lt = l_run + __shfl_xor(l_run, 32);
        const float f = l1_gate(ws, t_row, head, 1) / fmaxf(lt, 1e-30f);
        const size_t ob = (size_t)t_row * 1024 + head * 128 + 4 * h;
#pragma unroll
        for (int dt = 0; dt < 4; ++dt)
#pragma unroll
            for (int gq = 0; gq < 4; ++gq) { const float4 b = *(const float4*)(ocw + ob + 32 * dt + 8 * gq);
                uint2 w; w.x = pk2(b.x + o[dt][4 * gq] * f, b.y + o[dt][4 * gq + 1] * f); w.y = pk2(b.z + o[dt][4 * gq + 2] * f, b.w + o[dt][4 * gq + 3] * f);
                *(uint2*)(attnout + ob + 32 * dt + 8 * gq) = w; }
    }
}

#define MOBA_INSERT(v_, idx_) do { const float v__ = (v_); const int x__ = (idx_); \
    const bool g0 = v__ > b0 || (v__ == b0 && x__ < i0), g1 = v__ > b1 || (v__ == b1 && x__ < i1), g2 = v__ > b2 || (v__ == b2 && x__ < i2); \
    const float nb2 = g1 ? b1 : (g2 ? v__ : b2); const int ni2 = g1 ? i1 : (g2 ? x__ : i2); \
    const float nb1 = g0 ? b0 : (g1 ? v__ : b1); const int ni1 = g0 ? i0 : (g1 ? x__ : i1); \
    const float nb0 = g0 ? v__ : b0; const int ni0 = g0 ? x__ : i0; \
    b0 = nb0; b1 = nb1; b2 = nb2; i0 = ni0; i1 = ni1; i2 = ni2; } while (0)
__device__ __forceinline__ void l0_moba_mfma(const Params& P, LAS unsigned char* lds, int tid, int lane, int wave, int wg, int G) {
    unsigned char* ws = P.ws; const bf16* proj = (const bf16*)(ws + WS_PROJ); bf16* attnout = (bf16*)(ws + WS_XN);
    const float* kmean = (const float*)(ws + WS_KMEAN);
    constexpr int TILE = AT<64>::TILE;
    LAS float* kml = (LAS float*)(lds + 81920);
    LAS unsigned* uni = (LAS unsigned*)(lds + 98304);
    at_load_bt2(ws, lds, AT_BT_OFF, tid);
    const int r = lane & 31, h = lane >> 5;
    for (int u = wg; u < 512; u += G) {
        const int head = u & 7, k = u >> 3, ob = k < 32 ? k : 95 - k, t0 = 256 * ob;
        const int t_row = t0 + 32 * wave + r;
        const bf16* Kg = proj + (size_t)1 * T * 512 + 64 * head; const bf16* Vg = proj + (size_t)2 * T * 512 + 64 * head;
        const bf16* qrow = proj + (size_t)t_row * 512 + 64 * head;
        __syncthreads();
        for (int i = tid; i < 64 * 64; i += NTHR) kml[i] = kmean[(size_t)head * 4096 + i];
        __syncthreads();
        unsigned mlo = 0u, mhi = 0u;
        {
            float qv[64];
#pragma unroll
            for (int i = 0; i < 8; ++i) { const u4 w = ((const u4*)qrow)[i]; qv[8 * i] = bflo(w.x); qv[8 * i + 1] = bfhi(w.x); qv[8 * i + 2] = bflo(w.y); qv[8 * i + 3] = bfhi(w.y);
                qv[8 * i + 4] = bflo(w.z); qv[8 * i + 5] = bfhi(w.z); qv[8 * i + 6] = bflo(w.w); qv[8 * i + 7] = bfhi(w.w); }
            float b0 = -INFINITY, b1 = -INFINITY, b2 = -INFINITY; int i0 = 0x7fffffff, i1 = 0x7fffffff, i2 = 0x7fffffff;
            for (int j = h; j < ob; j += 2) { const LAS f4* km = (const LAS f4*)(kml + j * 64); float sc = 0.f;
#pragma unroll
                for (int d4 = 0; d4 < 16; ++d4) { const f4 kv = km[d4]; sc += (kv.x * qv[4 * d4] + kv.y * qv[4 * d4 + 1]) + (kv.z * qv[4 * d4 + 2] + kv.w * qv[4 * d4 + 3]); }
                MOBA_INSERT(sc, j); }
            const float p0 = __shfl_xor(b0, 32), p1 = __shfl_xor(b1, 32), p2 = __shfl_xor(b2, 32); const int j0 = __shfl_xor(i0, 32), j1 = __shfl_xor(i1, 32), j2 = __shfl_xor(i2, 32);
            MOBA_INSERT(p0, j0); MOBA_INSERT(p1, j1); MOBA_INSERT(p2, j2);
            if (b0 > -INFINITY) { if (i0 < 32) mlo |= 1u << i0; else mhi |= 1u << (i0 - 32); }
            if (b1 > -INFINITY) { if (i1 < 32) mlo |= 1u << i1; else mhi |= 1u << (i1 - 32); }
            if (b2 > -INFINITY) { if (i2 < 32) mlo |= 1u << i2; else mhi |= 1u << (i2 - 32); }
        }
        {
            unsigned ulo = mlo, uhi = mhi;
#pragma unroll
            for (int o = 1; o < 64; o <<= 1) { ulo |= __shfl_xor(ulo, o); uhi |= __shfl_xor(uhi, o); }
            if (lane == 0) { uni[2 * wave] = ulo; uni[2 * wave + 1] = uhi; }
        }
        __syncthreads();
        unsigned long long un = 0ull;
#pragma unroll
        for (int w = 0; w < 8; ++w) un |= (unsigned long long)uni[2 * w] | ((unsigned long long)uni[2 * w + 1] << 32);
        un = ((unsigned long long)__builtin_amdgcn_readfirstlane((unsigned)(un >> 32)) << 32) | (unsigned long long)__builtin_amdgcn_readfirstlane((unsigned)un);
        un |= 1ull << ob;
        bf16x8 qf[4];
#pragma unroll
        for (int ks = 0; ks < 4; ++ks) qf[ks] = *(const bf16x8*)(qrow + 16 * ks + 8 * h);
        const LAS float* brow = (const LAS float*)(lds + AT_BT_OFF) + head * 128;
        f32x16 o[2];
#pragma unroll
        for (int dt = 0; dt < 2; ++dt)
#pragma unroll
            for (int i = 0; i < 16; ++i) o[dt][i] = 0.f;
        float m_run = -INFINITY, l_run = 0.f;
        LAS int* tl = (LAS int*)(lds + 98304 + 64);
        if (tid < 64 && ((un >> tid) & 1ull)) { const int pos = __builtin_popcountll(un & ((1ull << tid) - 1ull));
#pragma unroll
            for (int tt = 0; tt < 4; ++tt) tl[4 * pos + tt] = 256 * tid + 64 * tt; }
        const int nt = 4 * __builtin_popcountll(un);
        __syncthreads();
        u4 kra[1], vra[1], krb[1], vrb[1];
        at_load<64>(Kg, Vg, 512, tl[0], T - 1, kra, vra, tid);
        at_load<64>(Kg, Vg, 512, tl[1], T - 1, krb, vrb, tid);
#define MOBA_STEP(KR, VR, BUF, I) do { const int i_ = (I); LAS unsigned char* Kl = lds + (BUF) * 2 * TILE; LAS unsigned char* Vl = Kl + TILE; \
            at_store<64>(Kl, Vl, KR, VR, tid); __syncthreads(); \
            if (i_ + 2 < nt) at_load<64>(Kg, Vg, 512, tl[i_ + 2], T - 1, KR, VR, tid); \
            const int key0 = tl[i_], j = key0 >> 8, tt = (key0 >> 6) & 3; const bool own = (j == ob); \
            const bool rowsel = own ? true : (bool)(((j < 32 ? mlo >> j : mhi >> (j - 32)) & 1u) != 0u); \
            const bool wave_on = own ? (32 * wave + 31 >= 64 * tt) : (__any(rowsel) != 0); \
            if (wave_on) at_step<64, 1, 0, 0x7fffffff>(Kl, Vl, qf, o, m_run, l_run, t0 + 32 * wave - (key0 + 63) >= 113, key0, T, t_row, rowsel, brow, 0.125f * LOG2E, r, h, lane); } while (0)
        for (int i = 0; i < nt; i += 2) { MOBA_STEP(kra, vra, 0, i); MOBA_STEP(krb, vrb, 1, i + 1); }
#undef MOBA_STEP
        const float lt = l_run + __shfl_xor(l_run, 32);
        const float f = 1.f / fmaxf(lt, 1e-30f);
        bf16* orow = attnout + (size_t)t_row * 1024 + 64 * head + 4 * h;
#pragma unroll
        for (int dt = 0; dt < 2; ++dt)
#pragma unroll
            for (int gq = 0; gq < 4; ++gq) { uint2 w; w.x = pk2(o[dt][4 * gq] * f, o[dt][4 * gq + 1] * f); w.y = pk2(o[dt][4 * gq + 2] * f, o[dt][4 * gq + 3] * f);
                *(uint2*)(orow + 32 * dt + 8 * gq) = w; }
    }
}

__device__ __forceinline__ void l1_cmp_mfma(const Params& P, LAS unsigned char* lds, int tid, int lane, int wave, int wg, int G) {
    unsigned char* ws = P.ws; float* ocw = (float*)(ws + WS_OCW); unsigned* selmask = (unsigned*)(ws + WS_SELMASK);
    constexpr int TILE = AT<128>::TILE, BT_OFF = 4 * TILE, MT_OFF = BT_OFF + 4096;
    LAS float* imp = (LAS float*)lds;
    LAS float* mt = (LAS float*)(lds + MT_OFF);
    float4* scr = (float4*)(ws + (wg < 116 ? (size_t)8 * MiB + (size_t)wg * 262144 : wg < 128 ? (size_t)244 * MiB + (size_t)(wg - 116) * 262144
                                  : wg < 192 ? (size_t)124 * MiB + (size_t)(wg - 128) * 262144 : (size_t)156 * MiB + (size_t)(wg - 192) * 262144));
    at_load_bt2(ws, lds, BT_OFF, tid);
    const int r = lane & 31, h = lane >> 5;
    const float c1 = SCALE_C * LOG2E;
    for (int u = wg; u < 512; u += G) {
        const int g = u & 1, k = u >> 1, c = k < 128 ? k : 383 - k, t0 = 64 * c;
        const int ql = 8 * wave + (r >> 2), t_row = t0 + ql, head = 4 * g + (r & 3);
        const bf16* Kg = (const bf16*)(ws + WS_KCMP) + (size_t)(0 * 2 + g) * 1024 * 128; const bf16* Vg = (const bf16*)(ws + WS_KCMP) + (size_t)(1 * 2 + g) * 1024 * 128;
        const int NV = (4 * c + 3) < 1023 ? (4 * c + 3) : 1023, ntiles = (NV + 63) >> 6;
        const LAS float* brow = (const LAS float*)(lds + BT_OFF) + head * 128;
        float m_run = -INFINITY, l_run = 0.f;
        u4 kr[2], vr[2];
        at_load<128>(Kg, Vg, 128, 0, 1022, kr, vr, tid);
        f32x16 o[4];
#pragma unroll
        for (int dt = 0; dt < 4; ++dt)
#pragma unroll
            for (int i = 0; i < 16; ++i) o[dt][i] = 0.f;
        float y_prev = 0.f;
        __syncthreads();
#pragma unroll 1
        for (int tl = 0; tl < ntiles; ++tl) {
            LAS unsigned char* Kl = lds + (tl & 1) * 2 * TILE; LAS unsigned char* Vl = Kl + TILE;
            at_store<128>(Kl, Vl, kr, vr, tid);
            __syncthreads();
            if (tl + 1 < ntiles) at_load<128>(Kg, Vg, 128, 64 * (tl + 1), 1022, kr, vr, tid);
            f32x16 s[2];
            {
                int zoff = 0; asm volatile("" : "+v"(zoff));
                const bf16* qrow2 = l1_tensor(ws, head) + (size_t)t_row * 128 + 8 * h + zoff; bf16x8 qf2[8];
#pragma unroll
                for (int ks = 0; ks < 8; ++ks) qf2[ks] = *(const bf16x8*)(qrow2 + 16 * ks);
                at_qk<128, 4>(Kl, qf2, s, r, h);
            }
            const bool fast = (64 * tl + 63 < NV) && (t0 + 8 * wave - (16 * (64 * tl + 63) + 31) >= 113);
            const float lm = at_scores<16, 31, 0x7fffffff>(s, fast, 64 * tl, NV, t_row, true, brow, c1, h);
            if (!__all(lm <= m_run + AT_THR)) {
                const float mn = fmaxf(m_run, lm); const float ms = (mn == -INFINITY) ? 0.f : mn;
                const float alpha = __builtin_amdgcn_exp2f(m_run - ms); m_run = mn; l_run *= alpha; y_prev *= alpha;
#pragma unroll
                for (int dt = 0; dt < 4; ++dt)
#pragma unroll
                    for (int i = 0; i < 16; ++i) o[dt][i] *= alpha;
            }
            const float sub = (m_run == -INFINITY) ? 0.f : m_run;
            l_run += at_probs(s, fast, true, brow[127], c1, sub);
            float vv[8];
#pragma unroll
            for (int idx = 0; idx < 8; ++idx) { const int kt = idx >> 2, gq = idx & 3;
                const float g4 = (s[kt][4 * gq] + s[kt][4 * gq + 1]) + (s[kt][4 * gq + 2] + s[kt][4 * gq + 3]); const float la = s[kt][4 * gq + 3];
                const auto sw = __builtin_amdgcn_permlane32_swap(__builtin_bit_cast(unsigned, la), __builtin_bit_cast(unsigned, la), false, false);
                const float y_cur = __builtin_bit_cast(float, h ? sw[0] : sw[1]);
                vv[idx] = g4 + (h ? y_cur : y_prev); y_prev = y_cur; }
            scr[(tl * 2 + 0) * 512 + tid] = make_float4(vv[0], vv[1], vv[2], vv[3]); scr[(tl * 2 + 1) * 512 + tid] = make_float4(vv[4], vv[5], vv[6], vv[7]);
            mt[tl * 512 + tid] = sub;
            at_pv<128>(Vl, s, o, lane);
        }
        const float ltot = fmaxf(l_run + __shfl_xor(l_run, 32), 1e-30f);
        const float mfin = (m_run == -INFINITY) ? 0.f : m_run;
        {
            const float f = l1_gate(ws, t_row, head, 0) / ltot;
            float* orow = ocw + (size_t)t_row * 1024 + head * 128 + 4 * h;
#pragma unroll
            for (int dt = 0; dt < 4; ++dt)
#pragma unroll
                for (int gq = 0; gq < 4; ++gq) { float4 b = *(float4*)(orow + 32 * dt + 8 * gq);
                    b.x += o[dt][4 * gq] * f; b.y += o[dt][4 * gq + 1] * f; b.z += o[dt][4 * gq + 2] * f; b.w += o[dt][4 * gq + 3] * f; *(float4*)(orow + 32 * dt + 8 * gq) = b; }
        }
        __syncthreads();
        const float invl = 1.f / ltot;
#pragma unroll 1
        for (int tb = 0; tb < ntiles; tb += 8) {
            float4 va[8], vb[8]; float fac[8];
#pragma unroll
            for (int i = 0; i < 8; ++i) { const int tl = (tb + i < ntiles) ? tb + i : ntiles - 1; va[i] = scr[(tl * 2 + 0) * 512 + tid]; vb[i] = scr[(tl * 2 + 1) * 512 + tid]; fac[i] = __builtin_amdgcn_exp2f(mt[tl * 512 + tid] - mfin) * invl; }
#pragma unroll
            for (int i = 0; i < 8; ++i) {
                if (tb + i < ntiles) {
                    float w8[8] = {va[i].x, va[i].y, va[i].z, va[i].w, vb[i].x, vb[i].y, vb[i].z, vb[i].w};
#pragma unroll
                    for (int idx = 0; idx < 8; ++idx) { float v = w8[idx] * fac[i]; v += dpp_quad_xor1(v); v += dpp_quad_xor2(v);
                        if ((r & 3) == 0) imp[ql * 256 + 16 * (tb + i) + 2 * idx + h] = v; }
                }
            }
        }
        __syncthreads();
        const int nsel = (c + 1) < 16 ? (c + 1) : 16;
#pragma unroll 1
        for (int qi = 0; qi < 8; ++qi) {
            const int q = 8 * wave + qi, t = t0 + q;
            unsigned key[4];
#pragma unroll
            for (int i = 0; i < 4; ++i) { const int j = lane + 64 * i; float v = imp[q * 256 + j];
                if (j == 0 || j == c || j == c - 1) v += 1e4f;
                key[i] = (j <= c) ? ((__builtin_bit_cast(unsigned, v) & 0xFFFFFF00u) | (unsigned)(255 - j)) : 0u; }
            unsigned mk[4] = {0u, 0u, 0u, 0u};
            for (int rr = 0; rr < nsel; ++rr) {
                const unsigned m = wave_max_u32(max(max(key[0], key[1]), max(key[2], key[3])));
#pragma unroll
                for (int i = 0; i < 4; ++i) if (m != 0u && key[i] == m) { key[i] = 0u; mk[i] = 1u; }
            }
#pragma unroll
            for (int i = 0; i < 4; ++i) { const unsigned long long bal = __ballot(mk[i] != 0u);
                if (lane == 0) { selmask[((size_t)t * 2 + g) * 8 + 2 * i] = (unsigned)bal; selmask[((size_t)t * 2 + g) * 8 + 2 * i + 1] = (unsigned)(bal >> 32); } }
        }
    }
}

struct EpiF32P {
    static constexpr bool PERM = false, AFTER_DRAIN = false;
    float* C; int ldc;
    __device__ __forceinline__ void operator()(const pg8::f32x4 (&acc)[2][2][4][2], const pg8::Unit& u, int wr, int wc, int fr, int fq) const {
        const int row0 = u.pm * 256 + wr * 64 + fr, col0 = u.pn * 256 + wc * 32 + 4 * fq;
#pragma unroll
        for (int ai = 0; ai < 2; ++ai)
#pragma unroll
            for (int m = 0; m < 4; ++m) { float* rowp = C + (size_t)(row0 + ai * 128 + m * 16) * ldc + col0;
#pragma unroll
                for (int bj = 0; bj < 2; ++bj)
#pragma unroll
                    for (int n = 0; n < 2; ++n) *(pg8::f32x4*)(rowp + bj * 128 + n * 16) = acc[ai][bj][m][n]; }
    }
};
struct OneUnit { int pm;
    __device__ __forceinline__ bool next(int i, pg8::Unit& u) const { if (i) return false; u.pm = pm; u.pn = 0; return true; }
    __device__ __forceinline__ void a_ready(const pg8::Unit&) const {}
    __device__ __forceinline__ void done(const pg8::Unit&) const {}
};
__device__ __forceinline__ void l1_compress_gemm(const Params& P, LAS unsigned char* lds, int tid, int wg) {
    unsigned char* ws = P.ws;
    if (wg < 64) {
        const int prob = wg >> 2, pm = wg & 3, kv = prob >> 3, g = (prob >> 2) & 1, sp = prob & 3;
        pg8::Gemm gm{l1_tensor(ws, (kv ? 10 : 8) + g) + sp * 1024, (const bf16*)(ws + (kv ? WS_CW1V : WS_CW1K)) + sp * 1024, 1024, 256, 1024, 2048, 4096};
        OneUnit S{pm}; EpiF32P E{(float*)(ws + WS_CPART) + (size_t)((sp * 2 + kv) * 2 + g) * 1024 * 256, 256};
        pg8::gemm_phase<EpiF32P, OneUnit, true, true>((PG8_LAS unsigned char*)lds, gm, S, E);
    } else if (wg < 96) {
        const int tq = wg - 64, kv = tq >> 4, l = 2 * (tq & 15) + (tid >> 8), j = tid & 255;
        const float* pos = P.in[kv ? I_POSV : I_POSK] + l * 128; const float* w1 = P.in[kv ? I_V1 : I_K1] + (size_t)l * 128 * 256 + j; float s = 0.f;
#pragma unroll 8
        for (int d = 0; d < 128; ++d) s += pos[d] * w1[(size_t)d * 256];
        ((float*)(ws + WS_POSP))[(kv * 32 + l) * 256 + j] = s;
    }
}
__device__ __forceinline__ void l1_compress_out(const Params& P, LAS unsigned char* lds, int tid, int wg, int G) {
    unsigned char* ws = P.ws; const float* part = (const float*)(ws + WS_CPART); const float* posp = (const float*)(ws + WS_POSP); bf16* kc = (bf16*)(ws + WS_KCMP);
    LAS float* pb = (LAS float*)lds; LAS float* hs = (LAS float*)(lds + 1024);
    for (int task = wg; task < 256; task += G) {
        const int kv = task >> 7, g = (task >> 6) & 1, n0 = (task & 63) * 16;
        __syncthreads();
        if (tid < 256) { float s = 0.f;
#pragma unroll 8
            for (int l = 0; l < 32; ++l) s += posp[(kv * 32 + l) * 256 + tid]; pb[tid] = s; }
        __syncthreads();
#pragma unroll
        for (int i = 0; i < 8; ++i) { const int e = tid + 512 * i, row = e >> 8, j = e & 255; float s = pb[j];
#pragma unroll
            for (int sp = 0; sp < 4; ++sp) s += part[((size_t)((sp * 2 + kv) * 2 + g) * 1024 + n0 + row) * 256 + j];
            hs[e] = gelu_tanh(s); }
        __syncthreads();
        const int d = tid & 127, rq = tid >> 7; const float* w2 = P.in[kv ? I_V2 : I_K2] + d; float acc[4] = {0.f, 0.f, 0.f, 0.f};
        for (int j = 0; j < 256; ++j) { const float w = w2[(size_t)j * 128];
#pragma unroll
            for (int i = 0; i < 4; ++i) acc[i] += hs[(rq + 4 * i) * 256 + j] * w; }
#pragma unroll
        for (int i = 0; i < 4; ++i) { const int n = n0 + rq + 4 * i; if (n < 1023) kc[((size_t)(kv * 2 + g) * 1024 + n) * 128 + d] = (bf16)f2bf(acc[i]); }
    }
}

__device__ __forceinline__ void l0_route(const Params& P, LAS unsigned char* lds, int tid, int lane, int wave, int wg, int G) {
    unsigned char* ws = P.ws; const bf16* proj = (const bf16*)(ws + WS_PROJ); const float* kmean = (const float*)(ws + WS_KMEAN);
    unsigned long long* selq = (unsigned long long*)(ws + WS_SELQ); unsigned* selT = (unsigned*)(ws + WS_SELT);
    LAS float* kml = (LAS float*)lds;
    const int r = lane & 31, h = lane >> 5;
    for (int u = wg; u < 512; u += G) {
        const int head = u & 7, k = u >> 3, ob = k < 32 ? k : 95 - k, t_row = 256 * ob + 32 * wave + r;
        const bf16* qrow = proj + (size_t)t_row * 512 + 64 * head;
        __syncthreads();
        for (int i = tid; i < 64 * 64; i += NTHR) kml[i] = kmean[(size_t)head * 4096 + i];
        __syncthreads();
        unsigned mlo = 0u, mhi = 0u;
        float qv[64];
#pragma unroll
        for (int i = 0; i < 8; ++i) { const u4 w = ((const u4*)qrow)[i]; qv[8 * i] = bflo(w.x); qv[8 * i + 1] = bfhi(w.x); qv[8 * i + 2] = bflo(w.y); qv[8 * i + 3] = bfhi(w.y);
            qv[8 * i + 4] = bflo(w.z); qv[8 * i + 5] = bfhi(w.z); qv[8 * i + 6] = bflo(w.w); qv[8 * i + 7] = bfhi(w.w); }
        float b0 = -INFINITY, b1 = -INFINITY, b2 = -INFINITY; int i0 = 0x7fffffff, i1 = 0x7fffffff, i2 = 0x7fffffff;
        for (int j = h; j < ob; j += 2) { const LAS f4* km = (const LAS f4*)(kml + j * 64); float sc = 0.f;
#pragma unroll
            for (int d4 = 0; d4 < 16; ++d4) { const f4 kv = km[d4]; sc += (kv.x * qv[4 * d4] + kv.y * qv[4 * d4 + 1]) + (kv.z * qv[4 * d4 + 2] + kv.w * qv[4 * d4 + 3]); }
            MOBA_INSERT(sc, j); }
        const float p0 = __shfl_xor(b0, 32), p1 = __shfl_xor(b1, 32), p2 = __shfl_xor(b2, 32); const int j0 = __shfl_xor(i0, 32), j1 = __shfl_xor(i1, 32), j2 = __shfl_xor(i2, 32);
        MOBA_INSERT(p0, j0); MOBA_INSERT(p1, j1); MOBA_INSERT(p2, j2);
        if (b0 > -INFINITY) { if (i0 < 32) mlo |= 1u << i0; else mhi |= 1u << (i0 - 32); }
        if (b1 > -INFINITY) { if (i1 < 32) mlo |= 1u << i1; else mhi |= 1u << (i1 - 32); }
        if (b2 > -INFINITY) { if (i2 < 32) mlo |= 1u << i2; else mhi |= 1u << (i2 - 32); }
        if (h == 0) selq[(size_t)t_row * 8 + head] = ((unsigned long long)mhi << 32) | (unsigned long long)mlo;
        for (int j = 0; j < ob; ++j) { const unsigned bit = ((j < 32 ? mlo >> j : mhi >> (j - 32)) & 1u); const unsigned long long bal = __ballot(bit != 0u);
            if (lane == 0) selT[((size_t)(head * 64 + j) * 64 + ob) * 8 + wave] = (unsigned)bal; }
    }
}
__device__ __forceinline__ void moba_write_partial(unsigned char* ws, const f32x16 (&o)[2], float m_run, float l_run, int tq, int head, int slot, bool valid_row, int h) {
    const float lt = l_run + __shfl_xor(l_run, 32); const float inv = 1.f / fmaxf(lt, 1e-30f);
    if (valid_row) { const size_t rec = ((size_t)tq * 8 + head) * 4 + slot; bf16* po = (bf16*)(ws + WS_PO) + rec * 64 + 4 * h;
#pragma unroll
        for (int dt = 0; dt < 2; ++dt)
#pragma unroll
            for (int gq = 0; gq < 4; ++gq) { uint2 w; w.x = pk2(o[dt][4 * gq] * inv, o[dt][4 * gq + 1] * inv); w.y = pk2(o[dt][4 * gq + 2] * inv, o[dt][4 * gq + 3] * inv);
                *(uint2*)(po + 32 * dt + 8 * gq) = w; }
        if (h == 0) ((float2*)(ws + WS_PML))[rec] = make_float2(m_run, lt); }
}
constexpr int MOBA_NB = 8 * (15 + 31 + 47 + 63);
constexpr int MOBA_NU = MOBA_NB + 512;
__device__ __forceinline__ void l0_moba_gather(const Params& P, LAS unsigned char* lds, int tid, int lane, int wave, int wg, int G) {
    unsigned char* ws = P.ws; const bf16* proj = (const bf16*)(ws + WS_PROJ);
    const unsigned long long* selq = (const unsigned long long*)(ws + WS_SELQ); const unsigned* selT = (const unsigned*)(ws + WS_SELT);
    unsigned* queue = (unsigned*)(ws + WS_CTL) + CW_QUEUE;
    constexpr int TILE = AT<64>::TILE, BTO = 8 * TILE;
    LAS int* rows = (LAS int*)(lds + BTO + 4096);
    LAS unsigned* wsum = (LAS unsigned*)(lds + BTO + 4096 + 16384);
    at_load_bt2(ws, lds, BTO, tid);
    const int r = lane & 31, h = lane >> 5;
    const float c1 = 0.125f * LOG2E;
    int unit = wg, it = 0;
    while (unit < MOBA_NU) {
        unsigned nxt_ = 0u; if (tid == 0) nxt_ = __hip_atomic_fetch_add(queue, 1u, __ATOMIC_RELAXED, __HIP_MEMORY_SCOPE_AGENT) + (unsigned)G;
        __syncthreads();
        if (unit < MOBA_NB) {
            int rg, rem; if (unit < 120) { rg = 0; rem = unit; } else if (unit < 368) { rg = 1; rem = unit - 120; } else if (unit < 744) { rg = 2; rem = unit - 368; } else { rg = 3; rem = unit - 744; }
            const int head = rem & 7, j = rem >> 3;
            const bf16* Kg = proj + (size_t)1 * T * 512 + 64 * head; const bf16* Vg = proj + (size_t)2 * T * 512 + 64 * head;
            const LAS float* brow = (const LAS float*)(lds + BTO) + head * 128;
            const int ob = 16 * rg + (tid >> 5), word = (tid & 31) >> 2, sh = 8 * (tid & 3);
            unsigned bits = (ob > j && ob <= 63) ? ((selT[((size_t)(head * 64 + j) * 64 + ob) * 8 + word] >> sh) & 0xffu) : 0u;
#pragma unroll
            for (int tt = 0; tt < 4; ++tt) { u4 kr[1], vr[1]; at_load<64>(Kg, Vg, 512, 256 * j + 64 * tt, T - 1, kr, vr, tid); at_store<64>(lds + tt * TILE, lds + (4 + tt) * TILE, kr, vr, tid); }
            const int cnt = __builtin_popcount(bits); int incl = cnt;
#pragma unroll
            for (int o_ = 1; o_ < 64; o_ <<= 1) { const int v = __shfl_up(incl, o_); if (lane >= o_) incl += v; }
            if (lane == 63) wsum[wave] = (unsigned)incl;
            __syncthreads();
            int base = 0, n = 0;
#pragma unroll
            for (int w = 0; w < 8; ++w) { const int x = (int)wsum[w]; if (w < wave) base += x; n += x; }
            int pos = base + incl - cnt;
            while (bits) { const int b = __builtin_ctz(bits); bits &= bits - 1u; rows[pos++] = 256 * ob + 8 * (tid & 31) + b; }
            __syncthreads();
            const int ntile = (n + 31) >> 5;
            for (int tile = wave; tile < ntile; tile += NWAVES) {
                const int idx = 32 * tile + r; const bool valid_row = idx < n; const int tq = rows[valid_row ? idx : (n - 1)];
                const int tmin = __builtin_amdgcn_readfirstlane(rows[32 * tile]);
                const bf16* qrow = proj + (size_t)tq * 512 + 64 * head;
                bf16x8 qf[4];
#pragma unroll
                for (int ks = 0; ks < 4; ++ks) qf[ks] = *(const bf16x8*)(qrow + 16 * ks + 8 * h);
                const unsigned long long sq = selq[(size_t)tq * 8 + head];
                f32x16 o[2];
#pragma unroll
                for (int dt = 0; dt < 2; ++dt)
#pragma unroll
                    for (int i = 0; i < 16; ++i) o[dt][i] = 0.f;
                float m_run = -INFINITY, l_run = 0.f;
#pragma unroll 1
                for (int tt = 0; tt < 4; ++tt) { const int key0 = 256 * j + 64 * tt;
                    at_step<64, 1, 0, 0x7fffffff>(lds + tt * TILE, lds + (4 + tt) * TILE, qf, o, m_run, l_run, tmin - (key0 + 63) >= 113, key0, T, tq, true, brow, c1, r, h, lane); }
                const int slot = __builtin_popcountll(sq & ((1ull << j) - 1ull));
                moba_write_partial(ws, o, m_run, l_run, tq, head, slot, valid_row, h);
            }
        } else {
            const int ua = unit - MOBA_NB, head = ua & 7, ob = 63 - (ua >> 3), t0 = 256 * ob, t_row = t0 + 32 * wave + r;
            const bf16* Kg = proj + (size_t)1 * T * 512 + 64 * head; const bf16* Vg = proj + (size_t)2 * T * 512 + 64 * head;
            const LAS float* brow = (const LAS float*)(lds + BTO) + head * 128;
            const bf16* qrow = proj + (size_t)t_row * 512 + 64 * head;
            bf16x8 qf[4];
#pragma unroll
            for (int ks = 0; ks < 4; ++ks) qf[ks] = *(const bf16x8*)(qrow + 16 * ks + 8 * h);
            f32x16 o[2];
#pragma unroll
            for (int dt = 0; dt < 2; ++dt)
#pragma unroll
                for (int i = 0; i < 16; ++i) o[dt][i] = 0.f;
            float m_run = -INFINITY, l_run = 0.f;
            u4 kr[1], vr[1];
            at_load<64>(Kg, Vg, 512, t0, T - 1, kr, vr, tid);
#pragma unroll 1
            for (int tt = 0; tt < 4; ++tt) {
                LAS unsigned char* Kl = lds + (tt & 1) * 2 * TILE; LAS unsigned char* Vl = Kl + TILE;
                at_store<64>(Kl, Vl, kr, vr, tid);
                __syncthreads();
                if (tt < 3) at_load<64>(Kg, Vg, 512, t0 + 64 * (tt + 1), T - 1, kr, vr, tid);
                if (32 * wave + 31 >= 64 * tt)
                    at_step<64, 1, 0, 0x7fffffff>(Kl, Vl, qf, o, m_run, l_run, false, t0 + 64 * tt, T, t_row, true, brow, c1, r, h, lane);
            }
            moba_write_partial(ws, o, m_run, l_run, t_row, head, 3, true, h);
        }
        if (tid == 0) wsum[16 + (it & 1)] = nxt_;
        __syncthreads();
        unit = (int)wsum[16 + (it & 1)]; ++it;
    }
}
__device__ __forceinline__ void l0_moba_merge(const Params& P, int tid, int wg, int G) {
    unsigned char* ws = P.ws; const unsigned long long* selq = (const unsigned long long*)(ws + WS_SELQ);
    const bf16* po = (const bf16*)(ws + WS_PO); const float2* pml = (const float2*)(ws + WS_PML); bf16* attnout = (bf16*)(ws + WS_XN);
    constexpr int NIT = T * 8 * 16;
    for (int idx0 = wg * NTHR + tid; idx0 < NIT; idx0 += 4 * G * NTHR) {
        unsigned long long sq[4]; float2 ml[4][4]; uint2 pv[4][4];
#pragma unroll
        for (int u = 0; u < 4; ++u) { const int idx = idx0 + u * G * NTHR; const int ic = idx < NIT ? idx : idx0; const int dq = ic & 15, th = ic >> 4;
            sq[u] = selq[th];
#pragma unroll
            for (int s_ = 0; s_ < 4; ++s_) { ml[u][s_] = pml[(size_t)th * 4 + s_]; pv[u][s_] = *(const uint2*)(po + ((size_t)th * 4 + s_) * 64 + 4 * dq); } }
#pragma unroll
        for (int u = 0; u < 4; ++u) { const int idx = idx0 + u * G * NTHR;
            if (idx < NIT) {
                const int dq = idx & 15, th = idx >> 4; const int cnt = __builtin_popcountll(sq[u]);
                float M = ml[u][3].x;
#pragma unroll
                for (int s_ = 0; s_ < 3; ++s_) { if (s_ >= cnt) { ml[u][s_] = make_float2(-INFINITY, 0.f); pv[u][s_] = make_uint2(0u, 0u); } M = fmaxf(M, ml[u][s_].x); }
                float a0 = 0.f, a1 = 0.f, a2 = 0.f, a3 = 0.f, den = 0.f;
#pragma unroll
                for (int s_ = 0; s_ < 4; ++s_) { const float w = ml[u][s_].y * __builtin_amdgcn_exp2f(ml[u][s_].x - M); const uint2 v = pv[u][s_];
                    a0 += w * bflo(v.x); a1 += w * bfhi(v.x); a2 += w * bflo(v.y); a3 += w * bfhi(v.y); den += w; }
                const float inv = 1.f / fmaxf(den, 1e-30f);
                uint2 o; o.x = pk2(a0 * inv, a1 * inv); o.y = pk2(a2 * inv, a3 * inv);
                *(uint2*)(attnout + (size_t)(th >> 3) * 1024 + 64 * (th & 7) + 4 * dq) = o;
            }
        }
    }
}

typedef float f32x4v __attribute__((ext_vector_type(4)));
__device__ __forceinline__ void at16_step(const LAS unsigned char* Kl, const LAS unsigned char* Vl, const bf16x8 (&qf)[4], f32x4v (&o)[8], float& m_run, float& l_run,
                                          bool fast, int key0, int kend, int t_row, bool rowsel, const LAS float* brow2, float bfar_in, float c1, int lane) {
    constexpr int PK = AT<128>::PK;
    const int r16 = lane & 15, gl = lane >> 4;
    f32x4v s[4];
    {
        bf16x8 kf[16];
#pragma unroll
        for (int kt = 0; kt < 4; ++kt)
#pragma unroll
            for (int ks = 0; ks < 4; ++ks) kf[4 * kt + ks] = *(const LAS bf16x8*)(Kl + (16 * kt + r16) * PK + (32 * ks + 8 * gl) * 2);
        asm volatile("" ::: "memory");
#pragma unroll
        for (int kt = 0; kt < 4; ++kt) s[kt] = (f32x4v){0.f, 0.f, 0.f, 0.f};
#pragma unroll
        for (int ks = 0; ks < 4; ++ks)
#pragma unroll
            for (int kt = 0; kt < 4; ++kt) s[kt] = __builtin_amdgcn_mfma_f32_16x16x32_bf16(kf[4 * kt + ks], qf[ks], s[kt], 0, 0, 0);
    }
    float bfar = bfar_in;
    float lm = -INFINITY;
    if (!fast) {
        float bv[16];
#pragma unroll
        for (int kt = 0; kt < 4; ++kt)
#pragma unroll
            for (int i = 0; i < 4; ++i) { const int d = t_row - (key0 + 16 * kt + 4 * gl + i); const int dd = d < 0 ? 0 : (d > 127 ? 127 : d); bv[4 * kt + i] = brow2[dd]; }
        asm volatile("" ::: "memory");
#pragma unroll
        for (int kt = 0; kt < 4; ++kt)
#pragma unroll
            for (int i = 0; i < 4; ++i) { const int key = key0 + 16 * kt + 4 * gl + i; const int d = t_row - key;
                const bool valid = rowsel && key < kend && d >= 0;
                const float v = valid ? fmaf(s[kt][i], c1, bv[4 * kt + i]) : -INFINITY; s[kt][i] = v; lm = fmaxf(lm, v); }
    }
    asm volatile("s_waitcnt lgkmcnt(0)" : "+v"(bfar) :: "memory");
    const int q4 = r16 >> 2, p4 = r16 & 3;
    v4i16_t lo0[8], hi0[8];
    const unsigned vbase = (unsigned)(size_t)Vl + 8u * (unsigned)(p4 & 1);
#pragma unroll
    for (int d4 = 0; d4 < 4; ++d4) { const unsigned va = vbase + (unsigned)v_off<128>(4 * gl + q4, 2 * d4 + (p4 >> 1));
        lo0[2 * d4] = tr16_asm<0>(va); hi0[2 * d4] = tr16_asm<4096>(va); lo0[2 * d4 + 1] = tr16_asm<8192>(va); hi0[2 * d4 + 1] = tr16_asm<12288>(va); }
    asm volatile("" ::: "memory");
    if (fast) {
#pragma unroll
        for (int kt = 0; kt < 4; ++kt)
#pragma unroll
            for (int i = 0; i < 4; ++i) lm = fmaxf(lm, s[kt][i]);
        lm = rowsel ? fmaf(lm, c1, bfar) : -INFINITY;
    }
    lm = max_xor32(max_xor16(lm));
    if (!__all(lm <= m_run + AT_THR)) {
        const float mn = fmaxf(m_run, lm); const float ms = (mn == -INFINITY) ? 0.f : mn;
        const float alpha = __builtin_amdgcn_exp2f(m_run - ms); m_run = mn; l_run *= alpha;
#pragma unroll
        for (int dt = 0; dt < 8; ++dt)
#pragma unroll
            for (int i = 0; i < 4; ++i) o[dt][i] *= alpha;
    }
    const float sub = (m_run == -INFINITY) ? 0.f : m_run;
    float ps = 0.f;
    if (fast) { const float bb = rowsel ? (bfar - sub) : -INFINITY;
#pragma unroll
        for (int kt = 0; kt < 4; ++kt)
#pragma unroll
            for (int i = 0; i < 4; ++i) { const float p = __builtin_amdgcn_exp2f(fmaf(s[kt][i], c1, bb)); s[kt][i] = p; ps += p; }
    } else {
#pragma unroll
        for (int kt = 0; kt < 4; ++kt)
#pragma unroll
            for (int i = 0; i < 4; ++i) { const float p = __builtin_amdgcn_exp2f(s[kt][i] - sub); s[kt][i] = p; ps += p; }
    }
    l_run += ps;
    bf16x8 pb[2];
#pragma unroll
    for (int s2 = 0; s2 < 2; ++s2) { u4 w; w.x = pg8::cvt_pk_bf16(s[2 * s2][0], s[2 * s2][1]); w.y = pg8::cvt_pk_bf16(s[2 * s2][2], s[2 * s2][3]);
        w.z = pg8::cvt_pk_bf16(s[2 * s2 + 1][0], s[2 * s2 + 1][1]); w.w = pg8::cvt_pk_bf16(s[2 * s2 + 1][2], s[2 * s2 + 1][3]); pb[s2] = __builtin_bit_cast(bf16x8, w); }
    asm volatile("s_waitcnt lgkmcnt(0)" : "+v"(lo0[0]), "+v"(lo0[1]), "+v"(lo0[2]), "+v"(lo0[3]), "+v"(lo0[4]), "+v"(lo0[5]), "+v"(lo0[6]), "+v"(lo0[7]),
                 "+v"(hi0[0]), "+v"(hi0[1]), "+v"(hi0[2]), "+v"(hi0[3]), "+v"(hi0[4]), "+v"(hi0[5]), "+v"(hi0[6]), "+v"(hi0[7]) :: "memory");
    v4i16_t lo1[8], hi1[8];
#pragma unroll
    for (int d4 = 0; d4 < 4; ++d4) { const unsigned va = vbase + (unsigned)v_off<128>(4 * gl + q4, 2 * (4 + d4) + (p4 >> 1));
        lo1[2 * d4] = tr16_asm<0>(va); hi1[2 * d4] = tr16_asm<4096>(va); lo1[2 * d4 + 1] = tr16_asm<8192>(va); hi1[2 * d4 + 1] = tr16_asm<12288>(va); }
    asm volatile("" ::: "memory");
#pragma unroll
    for (int s2 = 0; s2 < 2; ++s2)
#pragma unroll
        for (int d4 = 0; d4 < 4; ++d4) { const v4i16_t l_ = lo0[2 * d4 + s2], h_ = hi0[2 * d4 + s2];
            const bf16x8 a = {l_[0], l_[1], l_[2], l_[3], h_[0], h_[1], h_[2], h_[3]};
            o[d4] = __builtin_amdgcn_mfma_f32_16x16x32_bf16(a, pb[s2], o[d4], 0, 0, 0); }
    asm volatile("s_waitcnt lgkmcnt(0)" : "+v"(lo1[0]), "+v"(lo1[1]), "+v"(lo1[2]), "+v"(lo1[3]), "+v"(lo1[4]), "+v"(lo1[5]), "+v"(lo1[6]), "+v"(lo1[7]),
                 "+v"(hi1[0]), "+v"(hi1[1]), "+v"(hi1[2]), "+v"(hi1[3]), "+v"(hi1[4]), "+v"(hi1[5]), "+v"(hi1[6]), "+v"(hi1[7]) :: "memory");
#pragma unroll
    for (int s2 = 0; s2 < 2; ++s2)
#pragma unroll
        for (int d4 = 0; d4 < 4; ++d4) { const v4i16_t l_ = lo1[2 * d4 + s2], h_ = hi1[2 * d4 + s2];
            const bf16x8 a = {l_[0], l_[1], l_[2], l_[3], h_[0], h_[1], h_[2], h_[3]};
            o[4 + d4] = __builtin_amdgcn_mfma_f32_16x16x32_bf16(a, pb[s2], o[4 + d4], 0, 0, 0); }
}
__device__ __forceinline__ void at16_soft(f32x4v (&s)[4], float lm, float& m_run, float& l_run, f32x4v (&o)[8], bool fast, bool rowsel, float bfar, float c1, bf16x8 (&pb)[2]) {
    if (fast) {
#pragma unroll
        for (int kt = 0; kt < 4; ++kt)
#pragma unroll
            for (int i = 0; i < 4; ++i) lm = fmaxf(lm, s[kt][i]);
        lm = rowsel ? fmaf(lm, c1, bfar) : -INFINITY;
    }
    lm = max_xor32(max_xor16(lm));
    if (!__all(lm <= m_run + AT_THR)) {
        const float mn = fmaxf(m_run, lm); const float ms = (mn == -INFINITY) ? 0.f : mn;
        const float alpha = __builtin_amdgcn_exp2f(m_run - ms); m_run = mn; l_run *= alpha;
#pragma unroll
        for (int dt = 0; dt < 8; ++dt)
#pragma unroll
            for (int i = 0; i < 4; ++i) o[dt][i] *= alpha;
    }
    const float sub = (m_run == -INFINITY) ? 0.f : m_run;
    float ps = 0.f;
    if (fast) { const float bb = rowsel ? (bfar - sub) : -INFINITY;
#pragma unroll
        for (int kt = 0; kt < 4; ++kt)
#pragma unroll
            for (int i = 0; i < 4; ++i) { const float p = __builtin_amdgcn_exp2f(fmaf(s[kt][i], c1, bb)); s[kt][i] = p; ps += p; }
    } else {
#pragma unroll
        for (int kt = 0; kt < 4; ++kt)
#pragma unroll
            for (int i = 0; i < 4; ++i) { const float p = __builtin_amdgcn_exp2f(s[kt][i] - sub); s[kt][i] = p; ps += p; }
    }
    l_run += ps;
#pragma unroll
    for (int s2 = 0; s2 < 2; ++s2) { u4 w; w.x = pg8::cvt_pk_bf16(s[2 * s2][0], s[2 * s2][1]); w.y = pg8::cvt_pk_bf16(s[2 * s2][2], s[2 * s2][3]);
        w.z = pg8::cvt_pk_bf16(s[2 * s2 + 1][0], s[2 * s2 + 1][1]); w.w = pg8::cvt_pk_bf16(s[2 * s2 + 1][2], s[2 * s2 + 1][3]); pb[s2] = __builtin_bit_cast(bf16x8, w); }
}
__device__ __forceinline__ void at16_step2(const LAS unsigned char* Kl, const LAS unsigned char* Vl, const bf16x8 (&qfa)[4], const bf16x8 (&qfb)[4], f32x4v (&oa)[8], f32x4v (&ob)[8],
                                           float& m_a, float& l_a, float& m_b, float& l_b, bool fast, int key0, int kend, int t_rowa, int t_rowb, bool rsa, bool rsb,
                                           const LAS float* brow2, float bfar_in, float c1, int lane) {
    constexpr int PK = AT<128>::PK;
    const int r16 = lane & 15, gl = lane >> 4;
    f32x4v sa[4], sb[4];
    {
        bf16x8 kf[16];
#pragma unroll
        for (int kt = 0; kt < 4; ++kt)
#pragma unroll
            for (int ks = 0; ks < 4; ++ks) kf[4 * kt + ks] = *(const LAS bf16x8*)(Kl + (16 * kt + r16) * PK + (32 * ks + 8 * gl) * 2);
        asm volatile("" ::: "memory");
#pragma unroll
        for (int kt = 0; kt < 4; ++kt) { sa[kt] = (f32x4v){0.f, 0.f, 0.f, 0.f}; sb[kt] = (f32x4v){0.f, 0.f, 0.f, 0.f}; }
#pragma unroll
        for (int ks = 0; ks < 4; ++ks)
#pragma unroll
            for (int kt = 0; kt < 4; ++kt) { sa[kt] = __builtin_amdgcn_mfma_f32_16x16x32_bf16(kf[4 * kt + ks], qfa[ks], sa[kt], 0, 0, 0);
                sb[kt] = __builtin_amdgcn_mfma_f32_16x16x32_bf16(kf[4 * kt + ks], qfb[ks], sb[kt], 0, 0, 0); }
    }
    float bfar = bfar_in;
    float lma = -INFINITY, lmb = -INFINITY;
    if (!fast) {
#pragma unroll
        for (int sbi = 0; sbi < 2; ++sbi) {
            const int t_row = sbi ? t_rowb : t_rowa; const bool rowsel = sbi ? rsb : rsa; float bv[16];
#pragma unroll
            for (int kt = 0; kt < 4; ++kt)
#pragma unroll
                for (int i = 0; i < 4; ++i) { const int d = t_row - (key0 + 16 * kt + 4 * gl + i); const int dd = d < 0 ? 0 : (d > 127 ? 127 : d); bv[4 * kt + i] = brow2[dd]; }
            asm volatile("" ::: "memory");
            float lm = -INFINITY;
#pragma unroll
            for (int kt = 0; kt < 4; ++kt)
#pragma unroll
                for (int i = 0; i < 4; ++i) { const int key = key0 + 16 * kt + 4 * gl + i; const int d = t_row - key;
                    const bool valid = rowsel && key < kend && d >= 0;
                    const float sv = sbi ? sb[kt][i] : sa[kt][i];
                    const float v = valid ? fmaf(sv, c1, bv[4 * kt + i]) : -INFINITY; if (sbi) sb[kt][i] = v; else sa[kt][i] = v; lm = fmaxf(lm, v); }
            if (sbi) lmb = lm; else lma = lm;
        }
    }
    asm volatile("s_waitcnt lgkmcnt(0)" : "+v"(bfar) :: "memory");
    const int q4 = r16 >> 2, p4 = r16 & 3;
    const unsigned vbase = (unsigned)(size_t)Vl + 8u * (unsigned)(p4 & 1);
    v4i16_t lo0[8], hi0[8];
#pragma unroll
    for (int d4 = 0; d4 < 4; ++d4) { const unsigned va = vbase + (unsigned)v_off<128>(4 * gl + q4, 2 * d4 + (p4 >> 1));
        lo0[2 * d4] = tr16_asm<0>(va); hi0[2 * d4] = tr16_asm<4096>(va); lo0[2 * d4 + 1] = tr16_asm<8192>(va); hi0[2 * d4 + 1] = tr16_asm<12288>(va); }
    asm volatile("" ::: "memory");
    bf16x8 pba[2], pbb[2];
    at16_soft(sa, lma, m_a, l_a, oa, fast, rsa, bfar, c1, pba);
    at16_soft(sb, lmb, m_b, l_b, ob, fast, rsb, bfar, c1, pbb);
    asm volatile("s_waitcnt lgkmcnt(0)" : "+v"(lo0[0]), "+v"(lo0[1]), "+v"(lo0[2]), "+v"(lo0[3]), "+v"(lo0[4]), "+v"(lo0[5]), "+v"(lo0[6]), "+v"(lo0[7]),
                 "+v"(hi0[0]), "+v"(hi0[1]), "+v"(hi0[2]), "+v"(hi0[3]), "+v"(hi0[4]), "+v"(hi0[5]), "+v"(hi0[6]), "+v"(hi0[7]) :: "memory");
    v4i16_t lo1[8], hi1[8];
#pragma unroll
    for (int d4 = 0; d4 < 4; ++d4) { const unsigned va = vbase + (unsigned)v_off<128>(4 * gl + q4, 2 * (4 + d4) + (p4 >> 1));
        lo1[2 * d4] = tr16_asm<0>(va); hi1[2 * d4] = tr16_asm<4096>(va); lo1[2 * d4 + 1] = tr16_asm<8192>(va); hi1[2 * d4 + 1] = tr16_asm<12288>(va); }
    asm volatile("" ::: "memory");
#pragma unroll
    for (int s2 = 0; s2 < 2; ++s2)
#pragma unroll
        for (int d4 = 0; d4 < 4; ++d4) { const v4i16_t l_ = lo0[2 * d4 + s2], h_ = hi0[2 * d4 + s2];
            const bf16x8 a = {l_[0], l_[1], l_[2], l_[3], h_[0], h_[1], h_[2], h_[3]};
            oa[d4] = __builtin_amdgcn_mfma_f32_16x16x32_bf16(a, pba[s2], oa[d4], 0, 0, 0); ob[d4] = __builtin_amdgcn_mfma_f32_16x16x32_bf16(a, pbb[s2], ob[d4], 0, 0, 0); }
    asm volatile("s_waitcnt lgkmcnt(0)" : "+v"(lo1[0]), "+v"(lo1[1]), "+v"(lo1[2]), "+v"(lo1[3]), "+v"(lo1[4]), "+v"(lo1[5]), "+v"(lo1[6]), "+v"(lo1[7]),
                 "+v"(hi1[0]), "+v"(hi1[1]), "+v"(hi1[2]), "+v"(hi1[3]), "+v"(hi1[4]), "+v"(hi1[5]), "+v"(hi1[6]), "+v"(hi1[7]) :: "memory");
#pragma unroll
    for (int s2 = 0; s2 < 2; ++s2)
#pragma unroll
        for (int d4 = 0; d4 < 4; ++d4) { const v4i16_t l_ = lo1[2 * d4 + s2], h_ = hi1[2 * d4 + s2];
            const bf16x8 a = {l_[0], l_[1], l_[2], l_[3], h_[0], h_[1], h_[2], h_[3]};
            oa[4 + d4] = __builtin_amdgcn_mfma_f32_16x16x32_bf16(a, pba[s2], oa[4 + d4], 0, 0, 0); ob[4 + d4] = __builtin_amdgcn_mfma_f32_16x16x32_bf16(a, pbb[s2], ob[4 + d4], 0, 0, 0); }
}
__device__ __forceinline__ void l1_sel16(const Params& P, LAS unsigned char* lds, int tid, int lane, int wave, int wg, int G) {
    unsigned char* ws = P.ws; const float* ocw = (const float*)(ws + WS_OCW); const unsigned* selmask = (const unsigned*)(ws + WS_SELMASK);
    bf16* attnout = (bf16*)(ws + WS_XN);
    constexpr int TILE = AT<128>::TILE;
    constexpr int SEL_BT = 8 * TILE;
    LAS unsigned* selm = (LAS unsigned*)(lds + SEL_BT + 4096);
    at_load_bt2(ws, lds, SEL_BT, tid);
    const int r16 = lane & 15, gl = lane >> 4;
    for (int u = wg; u < 512; u += G) {
        const int g = u & 1, k = u >> 1, c = k < 128 ? k : 383 - k, t0 = 64 * c;
        const int head = 4 * g + (r16 & 3);
        const int ql0 = 8 * wave + (r16 >> 2), ql1 = ql0 + 4;
        const bf16* Kg = l1_tensor(ws, 12 + g); const bf16* Vg = l1_tensor(ws, 14 + g);
        bf16x8 qf0[4], qf1[4];
        { int lp = lane; asm volatile("" : "+v"(lp));
          const int r16p = lp & 15, glp = lp >> 4, headp = 4 * g + (r16p & 3), qlp = 8 * wave + (r16p >> 2);
          const bf16* q0 = l1_tensor(ws, headp) + (size_t)(t0 + qlp) * 128 + 8 * glp; const bf16* q1 = q0 + 4 * 128;
#pragma unroll
          for (int ks = 0; ks < 4; ++ks) { qf0[ks] = *(const bf16x8*)(q0 + 32 * ks); qf1[ks] = *(const bf16x8*)(q1 + 32 * ks); } }
        const LAS float* brow = (const LAS float*)(lds + SEL_BT) + head * 128;
        f32x4v o0[8], o1[8];
#pragma unroll
        for (int dt = 0; dt < 8; ++dt) { o0[dt] = (f32x4v){0.f, 0.f, 0.f, 0.f}; o1[dt] = (f32x4v){0.f, 0.f, 0.f, 0.f}; }
        float m0 = -INFINITY, l0 = 0.f, m1 = -INFINITY, l1 = 0.f;
        int ksrc[3], vsrc[2];
#pragma unroll
        for (int q3 = 0; q3 < 3; ++q3) { const int off = 1024 * (wave + 8 * q3) + 16 * lane, row = off / 272, cb = off - row * 272; ksrc[q3] = (row < 64 ? row : 63) * 128 + (cb < 256 ? cb >> 1 : 0); }
#pragma unroll
        for (int q2 = 0; q2 < 2; ++q2) { const int row = 4 * (2 * wave + q2) + (lane >> 4), ph = lane & 15, ch = ph ^ (((row & 3) << 2) | ((row >> 2) & 3)); vsrc[q2] = row * 128 + 8 * ch; }
#define SEL16_DMA(SLOT, J) do { LAS unsigned char* kd_ = (SLOT); LAS unsigned char* vd_ = kd_ + TILE; const bf16* kg_ = Kg + (size_t)(64 * (J)) * 128; const bf16* vg_ = Vg + (size_t)(64 * (J)) * 128; \
            __builtin_amdgcn_global_load_lds((const unsigned*)(kg_ + ksrc[0]), (LAS unsigned*)(kd_ + 1024 * wave), 16, 0, 0); \
            __builtin_amdgcn_global_load_lds((const unsigned*)(kg_ + ksrc[1]), (LAS unsigned*)(kd_ + 1024 * (wave + 8)), 16, 0, 0); \
            if (wave == 0) __builtin_amdgcn_global_load_lds((const unsigned*)(kg_ + ksrc[2]), (LAS unsigned*)(kd_ + 1024 * 16), 16, 0, 0); \
            __builtin_amdgcn_global_load_lds((const unsigned*)(vg_ + vsrc[0]), (LAS unsigned*)(vd_ + 1024 * (2 * wave)), 16, 0, 0); \
            __builtin_amdgcn_global_load_lds((const unsigned*)(vg_ + vsrc[1]), (LAS unsigned*)(vd_ + 1024 * (2 * wave + 1)), 16, 0, 0); } while (0)
        __syncthreads();
        selm[tid] = selmask[((size_t)(t0 + (tid >> 3)) * 2 + g) * 8 + (tid & 7)];
        const float bfar_u = brow[127];
        SEL16_DMA(lds, 0);
        if (1 <= c) SEL16_DMA(lds + 2 * TILE, 1);
#define SEL16_STEPS(KL, J) do { const int j_ = (J); LAS unsigned char* Kl = (KL); LAS unsigned char* Vl = Kl + TILE; \
            const bool rs0 = (selm[ql0 * 8 + (j_ >> 5)] >> (j_ & 31)) & 1u, rs1 = (selm[ql1 * 8 + (j_ >> 5)] >> (j_ & 31)) & 1u; \
            const bool fast_ = t0 + 8 * wave - (64 * j_ + 63) >= 113; \
            const bool a0_ = __any(rs0), a1_ = __any(rs1); \
            if (a0_ && a1_) at16_step2(Kl, Vl, qf0, qf1, o0, o1, m0, l0, m1, l1, fast_, 64 * j_, T, t0 + ql0, t0 + ql1, rs0, rs1, brow, bfar_u, SCALE_C * LOG2E, lane); \
            else if (a0_) at16_step(Kl, Vl, qf0, o0, m0, l0, fast_, 64 * j_, T, t0 + ql0, rs0, brow, bfar_u, SCALE_C * LOG2E, lane); \
            else if (a1_) at16_step(Kl, Vl, qf1, o1, m1, l1, fast_, 64 * j_, T, t0 + ql1, rs1, brow, bfar_u, SCALE_C * LOG2E, lane); } while (0)
#pragma unroll 1
        for (int i = 0; 2 * i <= c; ++i) {
            const int ja = 2 * i, jb = ja + 1;
            LAS unsigned char* pc = lds + (i & 1) * 4 * TILE; LAS unsigned char* pn = lds + ((i + 1) & 1) * 4 * TILE;
            asm volatile("s_waitcnt vmcnt(0)" ::: "memory");
            __syncthreads();
            if (ja + 2 <= c) SEL16_DMA(pn, ja + 2);
            if (ja + 3 <= c) SEL16_DMA(pn + 2 * TILE, ja + 3);
            SEL16_STEPS(pc, ja);
            if (jb <= c) SEL16_STEPS(pc + 2 * TILE, jb);
        }
#undef SEL16_DMA
#undef SEL16_STEPS
        int le = lane; asm volatile("" : "+v"(le));
        const int r16e = le & 15, gle = le >> 4, heade = 4 * g + (r16e & 3), qle = 8 * wave + (r16e >> 2);
#pragma unroll
        for (int sb = 0; sb < 2; ++sb) {
            const int t_row = t0 + qle + 4 * sb; float lr = sb ? l1 : l0;
            lr += __shfl_xor(lr, 16); lr += __shfl_xor(lr, 32);
            const float f = l1_gate(ws, t_row, heade, 1) / fmaxf(lr, 1e-30f);
            const size_t ob = (size_t)t_row * 1024 + heade * 128 + 4 * gle;
#pragma unroll
            for (int dt = 0; dt < 8; ++dt) { const f32x4v ov = sb ? o1[dt] : o0[dt]; const float4 b = *(const float4*)(ocw + ob + 16 * dt);
                uint2 w; w.x = pk2(b.x + ov[0] * f, b.y + ov[1] * f); w.y = pk2(b.z + ov[2] * f, b.w + ov[3] * f);
                *(uint2*)(attnout + ob + 16 * dt) = w; }
        }
    }
}

constexpr int NPH = 21;
__global__ void __launch_bounds__(NTHR, 2) fwd(Params P) {
    extern __shared__ __attribute__((aligned(16))) unsigned char lds_raw[];
    LAS unsigned char* lds = (LAS unsigned char*)lds_raw;
    volatile LAS unsigned* MISC = (volatile LAS unsigned*)(lds + MISC_OFF);
    const int tid = threadIdx.x, lane = tid & 63, wave = __builtin_amdgcn_readfirstlane(tid >> 6), wg = blockIdx.x, G = gridDim.x;
    unsigned char* ws = P.ws;
    for (int u = tid; u < (LDS_BYTES - SCR_BYTES) / 4; u += NTHR) ((LAS unsigned*)(lds + SCR_BYTES))[u] = 0u;
    __syncthreads();
    const int lo = P.ph_lo, hi = P.ph_hi;
    XcdBarrier bar; bar.bar = (unsigned*)(ws + WS_CTL) + CW_BAR; bar.x = 0; bar.st = nullptr;
    if (hi - lo > 1) bar = xcd_barrier_post((unsigned*)(ws + WS_CTL) + CW_BAR, MISC + 8);
#ifndef PH_MASK
#define PH_MASK 0xFFFFFFFFu
#endif
#define IN(k) (lo <= (k) && (k) < hi && ((PH_MASK >> (k)) & 1u))
#ifndef REP_MASK
#define REP_MASK 0u
#endif
#define RPT(k) for (int rep_ = 0; rep_ < ((((REP_MASK) >> (k)) & 1u) ? 2 : 1); ++rep_)
#define RPTBAR do { if (rep_) xcd_barrier(bar); } while (0)
#define SEAM(k) do { if (IN(k) && IN((k) + 1)) xcd_barrier(bar); } while (0)
#define SEAM_WT(k) do { if (IN(k) && IN((k) + 1)) xcd_barrier<false>(bar); } while (0)
    const int gw = wg * NWAVES + wave, NGW = G * NWAVES;
    bf16* xn = (bf16*)(ws + WS_XN); float* rrow = (float*)(ws + WS_RROW); bf16* proj = (bf16*)(ws + WS_PROJ); bf16* mb = (bf16*)(ws + WS_MB); bf16* ub = (bf16*)(ws + WS_U);

    if (IN(0)) { p0_prologue(P, lds, tid, lane, wave, wg, G); } SEAM(0);
    if (IN(1)) { run_gemm<0>(lds, xn, (const bf16*)(ws + WS_W0IN), T, N0IN, D, proj, 512, (size_t)T * 512, G, wg, rrow, (float*)(ws + WS_KMEAN)); } SEAM_WT(1);
    if (IN(2)) { l0_stage_a(P, lds, tid, lane, wave, wg, G); l0_route(P, lds, tid, lane, wave, wg, G); } SEAM(2);
    if (IN(4)) { l0_stage_c(P, lds, tid, lane, wave, wg, G); l0_moba_gather(P, lds, tid, lane, wave, wg, G); } SEAM(4);
    if (IN(5)) { RPT(5) { RPTBAR; l0_moba_merge(P, tid, wg, G); } } SEAM(5);
    if (IN(6)) { run_gemm<0>(lds, xn, (const bf16*)(ws + WS_W0OUT), T, D, D, mb, 1024, 0, G, wg); } SEAM_WT(6);
    if (IN(7)) { post_norm<0, 1>(P.in[I_X], P.out, mb, P.in[I_NMIXPOST], rrow, lane, gw, NGW); } SEAM(7);
    if (IN(8)) { run_gemm<1>(lds, (const bf16*)P.out, (const bf16*)(ws + WS_W0UP), T, FF, D, ub, 4096, 0, G, wg); } SEAM_WT(8);
    if (IN(9)) { run_gemm<0>(lds, ub, (const bf16*)(ws + WS_W0DN), T, D, FF, mb, 1024, 0, G, wg); } SEAM_WT(9);
    if (IN(10)) { post_norm<1, 1, true>(P.out, P.out, mb, P.in[I_NMLPPOST], rrow, lane, gw, NGW, rrow); } SEAM(10);
    if (IN(11)) { run_gemm<0>(lds, (const bf16*)P.out, (const bf16*)(ws + WS_W1IN), T, N1IN, D, proj, 128, (size_t)T * 128, G, wg, rrow); } SEAM_WT(11);
    if (IN(12)) { RPT(12) { RPTBAR; l1_compress_gemm(P, lds, tid, wg); __syncthreads(); l1_window_mfma(P, lds, tid, lane, wave, wg, G); } } SEAM(12);
    if (IN(13)) { l1_compress_out(P, lds, tid, wg, G); } SEAM(13);
    if (IN(14)) { l1_cmp_mfma(P, lds, tid, lane, wave, wg, G); }
    if (IN(14) && IN(15)) { asm volatile("s_waitcnt vmcnt(0)" ::: "memory"); __syncthreads(); }
    if (IN(15)) { RPT(15) { RPTBAR; l1_sel16(P, lds, tid, lane, wave, wg, G); } } SEAM(15);
    if (IN(16)) { run_gemm<0>(lds, xn, (const bf16*)(ws + WS_W1OUT), T, D, D, mb, 1024, 0, G, wg); } SEAM_WT(16);
    if (IN(17)) { post_norm<1, 1>(P.out, ws + WS_X3, mb, P.in[I_NMIXPOST] + D, rrow, lane, gw, NGW); } SEAM(17);
    if (IN(18)) { run_gemm<1>(lds, (const bf16*)(ws + WS_X3), (const bf16*)(ws + WS_W1UP), T, FF, D, ub, 4096, 0, G, wg); } SEAM_WT(18);
    if (IN(19)) { run_gemm<0>(lds, ub, (const bf16*)(ws + WS_W1DN), T, D, FF, mb, 1024, 0, G, wg); } SEAM_WT(19);
    if (IN(20)) { post_norm<1, 0, true>(ws + WS_X3, P.out, mb, P.in[I_NMLPPOST] + D, nullptr, lane, gw, NGW, rrow); }
#undef IN
#undef SEAM
}

extern "C" void kernel_launch(void* const* d_in, const int* in_sizes, int n_in, void* d_out, int out_size, void* d_ws, size_t ws_size, hipStream_t stream) {
    static int grid = 0;
    if (grid == 0) {
        if (n_in != N_IN || in_sizes[0] != T * D || out_size != T * D || ws_size < WS_END) { fprintf(stderr, "kernel_launch: unexpected shapes (n_in %d, in0 %d, out %d, ws %zu); nothing launched\n", n_in, n_in > 0 ? in_sizes[0] : -1, out_size, ws_size); grid = -1; return; }
        int dev = 0, cus = 0, per_cu = 0;
        if (hipGetDevice(&dev) != hipSuccess || hipDeviceGetAttribute(&cus, hipDeviceAttributeMultiprocessorCount, dev) != hipSuccess) { grid = -1; return; }
        if (hipFuncSetAttribute((const void*)fwd, hipFuncAttributeMaxDynamicSharedMemorySize, LDS_BYTES) != hipSuccess) { fprintf(stderr, "kernel_launch: hipFuncSetAttribute failed\n"); grid = -1; return; }
        if (hipOccupancyMaxActiveBlocksPerMultiprocessor(&per_cu, (const void*)fwd, NTHR, LDS_BYTES) != hipSuccess || per_cu < 1) fprintf(stderr, "kernel_launch: occupancy query reports %d workgroups per CU\n", per_cu);
        (void)hipGetLastError();
        grid = cus;
        if (grid < 96) { fprintf(stderr, "kernel_launch: needs >= 96 CUs\n"); grid = -1; return; }
    }
    if (grid < 0) return;
    if (hipMemsetAsync((char*)d_ws + WS_CTL, 0, CTL_ZERO_BYTES, stream) != hipSuccess) return;
    Params p{};
    for (int i = 0; i < N_IN; ++i) p.in[i] = (const float*)d_in[i];
    p.out = (float*)d_out; p.ws = (unsigned char*)d_ws;
#if MK_ONE_LAUNCH
    p.ph_lo = 0; p.ph_hi = NPH;
    hipLaunchKernelGGL(fwd, dim3(grid), dim3(NTHR), LDS_BYTES, stream, p);
#else
    for (int k = 0; k < NPH; ++k) { p.ph_lo = k; p.ph_hi = k + 1; hipLaunchKernelGGL(fwd, dim3(grid), dim3(NTHR), LDS_BYTES, stream, p); }
#endif
}
```
